# Optimizing an MI355X kernel written in HIP

```python
import jax, jax.numpy as jnp
from jax import lax
import numpy as np

D_MODEL = 1024
BATCH = 8
SEQ = 2048
DEPTH = 4

N_META = 16
BLOCK = 128
WINDOW = 128
RET_HEADS = 8
RET_QK_DIM = D_MODEL // 16
RET_V_DIM = D_MODEL // 8
ATT_Q_HEADS = 8
ATT_KV_HEADS = 2
ATT_GROUP = ATT_Q_HEADS // ATT_KV_HEADS
ATT_HEAD_DIM = D_MODEL // 16
ROPE_DIM = ATT_HEAD_DIM // 4
ROPE_THETA = 500000.0
XPOS_THETA = 10000.0
D_FF = 4 * D_MODEL
EPS = 1e-6
NEG_INF = -1e30

RET_QK = RET_HEADS * RET_QK_DIM
RET_V = RET_HEADS * RET_V_DIM
ATT_Q = ATT_Q_HEADS * ATT_HEAD_DIM
ATT_KV = ATT_KV_HEADS * ATT_HEAD_DIM
SPLITS = (RET_QK, RET_QK, RET_V, RET_V, ATT_Q, ATT_KV, ATT_KV, D_MODEL, D_MODEL)
D_IN = sum(SPLITS)

kernel_name = "hybrid_retention_swa_gated_encoder"


def rms_norm(x, g):
    xf = x.astype(jnp.float32)
    y = xf * lax.rsqrt(jnp.mean(xf * xf, axis=-1, keepdims=True) + EPS)
    return (y * g.astype(jnp.float32)).astype(x.dtype)


def rotate(x, pos, theta, rot_dim):
    half = rot_dim // 2
    freqs = jnp.power(jnp.float32(theta), -jnp.arange(0, rot_dim, 2, dtype=jnp.float32) / rot_dim)
    ang = pos.astype(jnp.float32)[:, None] * freqs[None, :]
    cos = jnp.cos(ang)[:, None, :]
    sin = jnp.sin(ang)[:, None, :]
    xf = x.astype(jnp.float32)
    x1, x2 = xf[..., :half], xf[..., half:rot_dim]
    out = jnp.concatenate([x1 * cos - x2 * sin, x2 * cos + x1 * sin, xf[..., rot_dim:]], axis=-1)
    return out.astype(x.dtype)


def retention_dir(q, k, v, log_gamma, include_diag):
    C = q.shape[-2]
    idx = jnp.arange(C, dtype=jnp.float32)
    rel = idx[:, None] - idx[None, :]
    lg = log_gamma[:, None, None]
    mask = (rel >= 0) if include_diag else (rel > 0)
    decay_in = jnp.where(mask[None], jnp.exp(lg * jnp.maximum(rel, 0.0)[None]), 0.0)
    s = jnp.einsum('bhncd,bhnkd->bhnck', q, k) * decay_in[:, None]
    o_in = jnp.einsum('bhnck,bhnke->bhnce', s, v)
    k_dec = k * jnp.exp(lg * (C - 1 - idx)[None, :])[:, None, :, :].transpose(0, 1, 3, 2)
    kv = jnp.einsum('bhncd,bhnce->bhnde', k_dec, v)
    chunk_decay = jnp.exp(log_gamma * C)[:, None, None]

    def step(state, kv_n):
        return state * chunk_decay + kv_n, state

    init = jnp.zeros(kv.shape[:2] + kv.shape[3:], jnp.float32)
    _, s_prev = lax.scan(step, init, jnp.moveaxis(kv, 2, 0))
    s_prev = jnp.moveaxis(s_prev, 0, 2)
    q_dec = q * jnp.exp(lg * (idx + 1.0)[None, :])[:, None, :, :].transpose(0, 1, 3, 2)
    o_x = jnp.einsum('bhncd,bhnde->bhnce', q_dec, s_prev)
    return o_in + o_x


def retention_branch(q, k, v, gate, log_decay, pad):
    B, L = q.shape[:2]
    Lp = L + pad
    nc = Lp // BLOCK
    pos = jnp.arange(L)
    q = rotate(q, pos, XPOS_THETA, RET_QK_DIM) * (RET_QK_DIM ** -0.5)
    k = rotate(k, pos, XPOS_THETA, RET_QK_DIM)

    def chunk(t):
        t = jnp.pad(t.astype(jnp.float32), ((0, 0), (pad, 0), (0, 0), (0, 0)))
        return t.reshape(B, nc, BLOCK, t.shape[2], t.shape[3]).transpose(0, 3, 1, 2, 4)

    qc, kc, vc = chunk(q), chunk(k), chunk(v)
    flip = lambda t: t[:, :, ::-1, ::-1]
    o = retention_dir(qc, kc, vc, log_decay[0], True) + flip(
        retention_dir(flip(qc), flip(kc), flip(vc), log_decay[1], False))
    o = o.transpose(0, 2, 3, 1, 4).reshape(B, Lp, RET_HEADS, RET_V_DIM)[:, pad:]
    mu = jnp.mean(o, axis=-1, keepdims=True)
    var = jnp.mean(jnp.square(o - mu), axis=-1, keepdims=True)
    o = (o - mu) * lax.rsqrt(var + EPS)
    o = o.reshape(B, L, RET_V).astype(gate.dtype)
    return o * jax.nn.silu(gate)


def attention_branch(q, k, v, sink, pad):
    B, L = q.shape[:2]
    Lp = L + pad
    nb = Lp // BLOCK
    pos = jnp.arange(L)
    q = rotate(q, pos, ROPE_THETA, ROPE_DIM)
    k = rotate(k, pos, ROPE_THETA, ROPE_DIM)
    meta_k, meta_v = k[:, :N_META], v[:, :N_META]
    qb = jnp.pad(q, ((0, 0), (pad, 0), (0, 0), (0, 0))).reshape(
        B, nb, BLOCK, ATT_KV_HEADS, ATT_GROUP, ATT_HEAD_DIM)
    ext = ((0, 0), (pad + BLOCK, BLOCK), (0, 0), (0, 0))
    kb = jnp.pad(k, ext).reshape(B, nb + 2, BLOCK, ATT_KV_HEADS, ATT_HEAD_DIM)
    vb = jnp.pad(v, ext).reshape(B, nb + 2, BLOCK, ATT_KV_HEADS, ATT_HEAD_DIM)

    def band(t):
        return jnp.concatenate([t[:, :-2], t[:, 1:-1], t[:, 2:]], axis=2)

    kband, vband = band(kb), band(vb)
    qpos = jnp.arange(nb)[:, None] * BLOCK + jnp.arange(BLOCK)[None, :]
    kpos = (jnp.arange(nb)[:, None] - 1) * BLOCK + jnp.arange(3 * BLOCK)[None, :]
    valid = ((kpos[:, None, :] >= pad + N_META) & (kpos[:, None, :] < Lp)
             & (jnp.abs(qpos[:, :, None] - kpos[:, None, :]) <= WINDOW))
    scale = ATT_HEAD_DIM ** -0.5
    s_band = jnp.einsum('bnqgrd,bnkgd->bngrqk', qb, kband).astype(jnp.float32) * scale
    s_band = jnp.where(valid[None, :, None, None], s_band, NEG_INF)
    s_meta = jnp.einsum('bnqgrd,bmgd->bngrqm', qb, meta_k).astype(jnp.float32) * scale
    s_sink = jnp.broadcast_to(sink.astype(jnp.float32).reshape(1, 1, ATT_KV_HEADS, ATT_GROUP, 1, 1),
                              s_meta.shape[:-1] + (1,))
    p = jax.nn.softmax(jnp.concatenate([s_sink, s_meta, s_band], axis=-1), axis=-1).astype(v.dtype)
    o = (jnp.einsum('bngrqm,bmgd->bnqgrd', p[..., 1:1 + N_META], meta_v)
         + jnp.einsum('bngrqk,bnkgd->bnqgrd', p[..., 1 + N_META:], vband))
    return o.reshape(B, Lp, ATT_Q)[:, pad:]


def setup_inputs(seed: int = 0) -> dict:
    key = jax.random.key(seed)
    ks = jax.random.split(key, 14)
    f = jnp.float32
    nrm = lambda k, shape, s: jax.random.normal(k, shape, f) * s
    heads = np.arange(RET_HEADS)
    base = np.log(-np.log(1.0 - 2.0 ** (-5.0 - heads))).astype(np.float32)
    return {
        "x": nrm(ks[0], (BATCH, SEQ, D_MODEL), 1.0),
        "meta_tokens": nrm(ks[1], (N_META, D_MODEL), 1.0),
        "w_in": nrm(ks[2], (DEPTH, D_MODEL, D_IN), D_MODEL ** -0.5),
        "w_ret_o": nrm(ks[3], (DEPTH, RET_V, D_MODEL), RET_V ** -0.5),
        "w_att_o": nrm(ks[4], (DEPTH, ATT_Q, D_MODEL), ATT_Q ** -0.5),
        "w_mix_o": nrm(ks[5], (DEPTH, D_MODEL, D_MODEL), D_MODEL ** -0.5),
        "w_ff1": nrm(ks[6], (DEPTH, D_MODEL, D_FF), D_MODEL ** -0.5),
        "w_ff2": nrm(ks[7], (DEPTH, D_FF, D_MODEL), D_FF ** -0.5),
        "norm_mix_pre": 1.0 + nrm(ks[8], (DEPTH, D_MODEL), 0.02),
        "norm_mix_post": 1.0 + nrm(ks[9], (DEPTH, D_MODEL), 0.02),
        "norm_ff_pre": 1.0 + nrm(ks[10], (DEPTH, D_MODEL), 0.02),
        "norm_ff_post": 1.0 + nrm(ks[11], (DEPTH, D_MODEL), 0.02),
        "ret_decay": jnp.asarray(base)[None, None, :] + nrm(ks[12], (DEPTH, 2, RET_HEADS), 0.05),
        "attn_sink": nrm(ks[13], (DEPTH, ATT_Q_HEADS), 0.5),
    }


def reference(x, meta_tokens, w_in, w_ret_o, w_att_o, w_mix_o, w_ff1, w_ff2,
              norm_mix_pre, norm_mix_post, norm_ff_pre, norm_ff_post, ret_decay, attn_sink):
    B = x.shape[0]
    h = jnp.concatenate([jnp.broadcast_to(meta_tokens[None].astype(x.dtype), (B, N_META, D_MODEL)), x], axis=1)
    L = h.shape[1]
    pad = (-L) % BLOCK
    for l in range(DEPTH):
        u = rms_norm(h, norm_mix_pre[l])
        proj = u @ w_in[l]
        parts, off = [], 0
        for size in SPLITS:
            parts.append(proj[..., off:off + size])
            off += size
        q_r, k_r, v_r, g_r, q_a, k_a, v_a, gate_r, gate_a = parts
        log_decay = -jnp.exp(ret_decay[l].astype(jnp.float32))
        y_r = retention_branch(q_r.reshape(B, L, RET_HEADS, RET_QK_DIM),
                               k_r.reshape(B, L, RET_HEADS, RET_QK_DIM),
                               v_r.reshape(B, L, RET_HEADS, RET_V_DIM),
                               g_r, log_decay, pad) @ w_ret_o[l]
        y_a = attention_branch(q_a.reshape(B, L, ATT_Q_HEADS, ATT_HEAD_DIM),
                               k_a.reshape(B, L, ATT_KV_HEADS, ATT_HEAD_DIM),
                               v_a.reshape(B, L, ATT_KV_HEADS, ATT_HEAD_DIM),
                               attn_sink[l], pad) @ w_att_o[l]
        mix = (jax.nn.sigmoid(gate_r) * y_r + jax.nn.sigmoid(gate_a) * y_a) @ w_mix_o[l]
        h = h + rms_norm(mix, norm_mix_post[l])
        u = rms_norm(h, norm_ff_pre[l])
        ff = jnp.square(jax.nn.relu(u @ w_ff1[l])) @ w_ff2[l]
        h = h + rms_norm(ff, norm_ff_post[l])
    return h[:, N_META:]
```

```cpp
#include <hip/hip_runtime.h>
#include <hip/hip_cooperative_groups.h>
#include <cstdio>
namespace cg = cooperative_groups;
#ifndef REP_G1
#define REP_G1 1
#endif
#ifndef REP_MX
#define REP_MX 1
#endif
#ifndef REP_FF
#define REP_FF 1
#endif
#ifndef REP_G23
#define REP_G23 1
#endif

#define LAS __attribute__((address_space(3)))
#define DI __device__ __forceinline__
typedef unsigned short bf16_t;
typedef short bf16x8 __attribute__((ext_vector_type(8)));
typedef short bf16x4 __attribute__((ext_vector_type(4)));
typedef float f32x4 __attribute__((ext_vector_type(4)));
typedef float f32x2 __attribute__((ext_vector_type(2)));
typedef unsigned u32x4 __attribute__((ext_vector_type(4)));
typedef unsigned u32x2 __attribute__((ext_vector_type(2)));
typedef __bf16 bfx2 __attribute__((ext_vector_type(2)));

constexpr int RX = 16384;
constexpr int RT = 16512;
constexpr int DM = 1024, DIN = 5888, DFF = 4096, LP = 2176, NCH = 17;
constexpr float EPS = 1e-6f;

constexpr size_t WS_HMETA = 0;
constexpr size_t WS_TABR = WS_HMETA + (size_t)128 * 1024 * 4;
constexpr size_t WS_TABA = WS_TABR + (size_t)2064 * 32 * 2 * 4;
constexpr size_t WS_W = WS_TABA + (size_t)2064 * 8 * 2 * 4;
constexpr size_t W_IN = 0;
constexpr size_t W_CAT = W_IN + (size_t)DIN * 1024 * 2;
constexpr size_t W_MIX = W_CAT + (size_t)1024 * 1536 * 2;
constexpr size_t W_FF1 = W_MIX + (size_t)1024 * 1024 * 2;
constexpr size_t W_FF2 = W_FF1 + (size_t)4096 * 1024 * 2;
constexpr size_t W_END = W_FF2 + (size_t)1024 * 4096 * 2;
constexpr size_t WS_U = WS_W + W_END;
constexpr size_t WS_ST = WS_U + (size_t)RT * 1536 * 2;
constexpr size_t WS_PROJ = WS_ST + (size_t)8 * 8 * 17 * 2 * 128 * 64 * 2;
constexpr size_t P_QR = 0;
constexpr size_t P_KR = P_QR + (size_t)RT * 512 * 2;
constexpr size_t P_KDF = P_KR + (size_t)RT * 512 * 2;
constexpr size_t P_KDB = P_KDF + (size_t)64 * 64 * LP * 2;
constexpr size_t P_VRT = P_KDB + (size_t)64 * 64 * LP * 2;
constexpr size_t P_GR = P_VRT + (size_t)64 * 128 * LP * 2;
constexpr size_t P_QA = P_GR + (size_t)RT * 1024 * 2;
constexpr size_t P_KA = P_QA + (size_t)RT * 512 * 2;
constexpr size_t P_VAT = P_KA + (size_t)RT * 128 * 2;
constexpr size_t P_GATER = P_VAT + (size_t)16 * 64 * LP * 2;
constexpr size_t P_GATEA = P_GATER + (size_t)RT * 1024 * 2;
constexpr size_t P_END = P_GATEA + (size_t)RT * 1024 * 2;
constexpr size_t P_FFH = 0;
constexpr size_t P_MIX = (size_t)RT * 4096 * 2;
static_assert(P_MIX + (size_t)RT * 1024 * 4 <= P_END, "alias");
constexpr size_t WS_BAR = WS_PROJ + P_END;
constexpr size_t WS_END = WS_BAR + 16384;

constexpr int LDS_MAIN = 134400;
constexpr int LDS_BYTES = LDS_MAIN + 16;

struct Params {
    const float *x, *meta, *w_in, *w_ret_o, *w_att_o, *w_mix_o, *w_ff1, *w_ff2;
    const float *n_mix_pre, *n_mix_post, *n_ff_pre, *n_ff_post, *ret_decay, *attn_sink;
    float* out; unsigned char* ws;
};

DI unsigned pk2(float lo, float hi) { f32x2 v = {lo, hi}; bfx2 b = __builtin_convertvector(v, bfx2); return __builtin_bit_cast(unsigned, b); }
DI u32x2 pk4(f32x4 v) { u32x2 r; r.x = pk2(v[0], v[1]); r.y = pk2(v[2], v[3]); return r; }
DI void st4(bf16_t* p, f32x4 v) { *(u32x2*)p = pk4(v); }
DI void st_pair16(bf16_t* p, f32x4 a, f32x4 b, int fq) {
    const u32x2 pa = pk4(a), pb = pk4(b);
    const auto r0 = __builtin_amdgcn_permlane16_swap(pa.x, pb.x, false, false);
    const auto r1 = __builtin_amdgcn_permlane16_swap(pa.y, pb.y, false, false);
    u32x4 w; w.x = r0[0]; w.y = r1[0]; w.z = r0[1]; w.w = r1[1];
    *(u32x4*)(p + (fq & 1) * 16 + (fq >> 1) * 8) = w;
}
DI bf16_t bf1(float x) { return (bf16_t)(pk2(x, x) & 0xffffu); }
DI f32x4 ld4(const bf16_t* p) {
    u32x2 w = *(const u32x2*)p; f32x4 r;
    r[0] = __uint_as_float(w.x << 16); r[1] = __uint_as_float(w.x & 0xffff0000u);
    r[2] = __uint_as_float(w.y << 16); r[3] = __uint_as_float(w.y & 0xffff0000u); return r;
}
DI bf16x8 pack8(f32x4 a, f32x4 b) { u32x4 w; w.x = pk2(a[0], a[1]); w.y = pk2(a[2], a[3]); w.z = pk2(b[0], b[1]); w.w = pk2(b[2], b[3]); return __builtin_bit_cast(bf16x8, w); }
DI bf16x8 cat8(bf16x4 lo, bf16x4 hi) { return __builtin_shufflevector(lo, hi, 0, 1, 2, 3, 4, 5, 6, 7); }
DI bf16x8 ld8(const bf16_t* p) { return *(const bf16x8*)p; }
DI bf16x4 ld4s(const bf16_t* p) { return *(const bf16x4*)p; }
DI f32x4 mfma16(bf16x8 a, bf16x8 b, f32x4 c) { return __builtin_amdgcn_mfma_f32_16x16x32_bf16(a, b, c, 0, 0, 0); }
DI float sigm(float x) { return __builtin_amdgcn_rcpf(1.0f + __expf(-x)); }
DI float wsum(float v) { v += __shfl_xor(v, 1); v += __shfl_xor(v, 2); v += __shfl_xor(v, 4); v += __shfl_xor(v, 8); v += __shfl_xor(v, 16); v += __shfl_xor(v, 32); return v; }
DI int otid() { int t = threadIdx.x; asm volatile("" : "+v"(t)); return t; }
DI void row_bp(int row, int& b, int& p, int& pp) {
    if (row < RX) { b = row >> 11; const int s = row & 2047; p = 16 + s; pp = 128 + s; }
    else { const int m = row - RX; b = m >> 4; p = m & 15; pp = 112 + p; }
}

DI void unpack8(u32x4 w, f32x4& lo, f32x4& hi) {
    lo[0] = __uint_as_float(w.x << 16); lo[1] = __uint_as_float(w.x & 0xffff0000u); lo[2] = __uint_as_float(w.y << 16); lo[3] = __uint_as_float(w.y & 0xffff0000u);
    hi[0] = __uint_as_float(w.z << 16); hi[1] = __uint_as_float(w.z & 0xffff0000u); hi[2] = __uint_as_float(w.w << 16); hi[3] = __uint_as_float(w.w & 0xffff0000u);
}
DI void st8(bf16_t* p, f32x4 a, f32x4 b) { u32x4 w; w.x = pk2(a[0], a[1]); w.y = pk2(a[2], a[3]); w.z = pk2(b[0], b[1]); w.w = pk2(b[2], b[3]); *(u32x4*)p = w; }
struct EpiIn {
    unsigned char* proj; const float* tabR; const float* tabA; const float* rd; const float* rs;
    template <int SEC> DI f32x4 load_cs(int row, int col) const {
        int b, p, pp; row_bp(row, b, p, pp);
        if (SEC == 0 || SEC == 1) { const int w = col & 63; return *(const f32x4*)(tabR + ((size_t)p * 32 + (w >> 1)) * 2); }
        if (SEC == 4 || SEC == 5) { const int w = col & 63; if (w < 16) return *(const f32x4*)(tabA + ((size_t)p * 8 + (w >> 1)) * 2); }
        return (f32x4){1.f, 0.f, 1.f, 0.f};
    }
    template <int SEC> DI f32x4 xform(f32x4 v, f32x4 cs) const {
        f32x4 o = v;
        if (SEC == 0 || SEC == 1 || SEC == 4 || SEC == 5) {
            o[0] = v[0] * cs[0] - v[1] * cs[1]; o[1] = v[1] * cs[0] + v[0] * cs[1];
            o[2] = v[2] * cs[2] - v[3] * cs[3]; o[3] = v[3] * cs[2] + v[2] * cs[3];
            if (SEC == 0 || SEC == 4) o *= 0.125f;
        } else if (SEC == 3) {
#pragma unroll
            for (int jj = 0; jj < 4; ++jj) o[jj] = v[jj] * sigm(v[jj]);
        } else if (SEC == 7 || SEC == 8) {
#pragma unroll
            for (int jj = 0; jj < 4; ++jj) o[jj] = sigm(v[jj]);
        }
        return o;
    }
    template <int SEC> DI bf16_t* dst(int row, int col) const {
        if (SEC == 0) return (bf16_t*)(proj + P_QR) + (size_t)row * 512 + col;
        if (SEC == 1) return (bf16_t*)(proj + P_KR) + (size_t)row * 512 + (col - 512);
        if (SEC == 3) return (bf16_t*)(proj + P_GR) + (size_t)row * 1024 + (col - 2048);
        if (SEC == 4) return (bf16_t*)(proj + P_QA) + (size_t)row * 512 + (col - 3072);
        if (SEC == 5) return (bf16_t*)(proj + P_KA) + (size_t)row * 128 + (col - 3584);
        if (SEC == 7) return (bf16_t*)(proj + P_GATER) + (size_t)row * 1024 + (col - 3840);
        if (SEC == 8) return (bf16_t*)(proj + P_GATEA) + (size_t)row * 1024 + (col - 4864);
        return nullptr;
    }
    template <int SEC> DI void scatter(int row, int col, f32x4 o, float lgf, float lgb) const {
        if (SEC != 1 && SEC != 2 && SEC != 6) return;
        int b, p, pp; row_bp(row, b, p, pp);
        if (SEC == 1) {
            const int c = col & 511, w = c & 63, h = c >> 6;
            const int j = pp & 127;
            const float df = __expf(lgf * (float)(127 - j)), db = __expf(lgb * (float)j);
            const size_t base = ((size_t)(b * 8 + h) * 64 + w) * LP + pp;
            bf16_t* kf = (bf16_t*)(proj + P_KDF) + base; bf16_t* kb = (bf16_t*)(proj + P_KDB) + base;
#pragma unroll
            for (int jj = 0; jj < 4; ++jj) { kf[(size_t)jj * LP] = bf1(o[jj] * df); kb[(size_t)jj * LP] = bf1(o[jj] * db); }
        } else if (SEC == 2) {
            const int c = col - 1024, h = c >> 7, e = c & 127;
            bf16_t* vt = (bf16_t*)(proj + P_VRT) + ((size_t)(b * 8 + h) * 128 + e) * LP + pp;
#pragma unroll
            for (int jj = 0; jj < 4; ++jj) vt[(size_t)jj * LP] = bf1(o[jj]);
        } else {
            const int c = col - 3712, g = c >> 6, d = c & 63;
            bf16_t* vt = (bf16_t*)(proj + P_VAT) + ((size_t)(b * 2 + g) * 64 + d) * LP + pp;
#pragma unroll
            for (int jj = 0; jj < 4; ++jj) vt[(size_t)jj * LP] = bf1(o[jj]);
        }
    }
    template <int SEC> DI void body(int row, int col, f32x4 v, f32x4 cs, float lgf, float lgb) const {
        const f32x4 o = xform<SEC>(v * rs[row], cs);
        if (SEC != 2 && SEC != 6) st4(dst<SEC>(row, col), o);
        scatter<SEC>(row, col, o, lgf, lgb);
    }
    template <int SEC> DI void body2(int row, int col, f32x4 v0, f32x4 v1, f32x4 cs0, f32x4 cs1, float lgf, float lgb, float rsv) const {
        const f32x4 o0 = xform<SEC>(v0 * rsv, cs0), o1 = xform<SEC>(v1 * rsv, cs1);
        if (SEC != 2 && SEC != 6) st8(dst<SEC>(row, col), o0, o1);
        scatter<SEC>(row, col, o0, lgf, lgb); scatter<SEC>(row, col + 4, o1, lgf, lgb);
    }
    static DI int section(int col) {
        return col < 512 ? 0 : col < 1024 ? 1 : col < 2048 ? 2 : col < 3072 ? 3 : col < 3584 ? 4 : col < 3712 ? 5 : col < 3840 ? 6 : col < 4864 ? 7 : 8;
    }
    template <int SEC> DI void one(int row, int col, f32x4 v) const {
        float lgf = 0.f, lgb = 0.f;
        if (SEC == 1) { const int h = (col & 511) >> 6; lgf = -__expf(rd[h]); lgb = -__expf(rd[8 + h]); }
        body<SEC>(row, col, v, load_cs<SEC>(row, col), lgf, lgb);
    }
    DI void operator()(int row, int col, f32x4 v) const {
        switch (section(col)) {
            case 0: one<0>(row, col, v); break; case 1: one<1>(row, col, v); break; case 2: one<2>(row, col, v); break;
            case 3: one<3>(row, col, v); break; case 4: one<4>(row, col, v); break; case 5: one<5>(row, col, v); break;
            case 6: one<6>(row, col, v); break; case 7: one<7>(row, col, v); break; default: one<8>(row, col, v); break;
        }
    }
};
struct EpiF32 { bf16_t* out; DI void operator()(int row, int col, f32x4 v) const { st4(out + (size_t)row * 1024 + col, v); } };
struct EpiRelu2 { bf16_t* out; const float* rs; DI void operator()(int row, int col, f32x4 v) const {
    f32x4 o; const float r = rs[row];
#pragma unroll
    for (int jj = 0; jj < 4; ++jj) { const float t = fmaxf(v[jj] * r, 0.f); o[jj] = t * t; }
    st4(out + (size_t)row * 4096 + col, o); } };

constexpr int HALF = 128, BK = 64, HTB = HALF * BK * 2;
DI int lds_byte(int r, int c) { const int st = (r >> 4) * 2 + (c >> 5), rr = r & 15, cc = c & 31, ob = rr * 64 + cc * 2; return st * 1024 + (ob ^ (((ob >> 9) & 1) << 5)); }
DI int perm32(int rho) { const int n = rho >> 4, i = rho & 15; return 8 * (i >> 2) + 4 * n + (i & 3); }
DI void stage_rc(int b, int& R, int& C) { const int st = b / 1024, sb = b % 1024, swz = sb ^ (((sb >> 9) & 1) << 5); R = (st >> 1) * 16 + swz / 64; C = (st & 1) * 32 + (swz % 64) / 2; }

struct Unit { const char* A; const char* B; int nt, pm, pn, kind; };
struct TileOrder {
    int nM, nN, nwg, G, c;
    DI void init(int N) { nM = RX / 256; nN = N / 256; nwg = nM * nN; G = gridDim.x; c = blockIdx.x; }
    DI bool tile(int i, int& pm, int& pn) const {
        const long L = (long)i * G + c; if (L >= nwg) return false;
        int wgid = (int)L; { const int q = nwg / 8, r = nwg % 8, xcd = wgid % 8, off = wgid / 8; wgid = (xcd < r ? xcd * (q + 1) : r * (q + 1) + (xcd - r) * q) + off; }
        const int nig = 8 * nN, gid = wgid / nig, fm = gid * 8, gsz = (nM - fm) < 8 ? (nM - fm) : 8;
        pm = fm + ((wgid % nig) % gsz); pn = (wgid % nig) / gsz; return true;
    }
};
struct SchedPlain {
    TileOrder T; const char* A; const char* B; size_t tstep; int nt;
    DI bool next(int i, Unit& u) const { if (!T.tile(i, u.pm, u.pn)) return false; u.A = A + (size_t)u.pm * tstep; u.B = B + (size_t)u.pn * tstep; u.nt = nt; u.kind = 1; return true; }
};
struct SchedGate {
    TileOrder T; const char* A; const char* B; size_t tstep;
    DI bool next(int i, Unit& u) const { if (!T.tile(i >> 1, u.pm, u.pn)) return false; const int kind = i & 1; u.kind = kind;
        u.A = A + (size_t)u.pm * tstep + (kind ? 2048 : 0); u.B = B + (size_t)u.pn * tstep + (kind ? 2048 : 0); u.nt = kind ? 8 : 16; return true; }
};

template <class F> DI void for_acc(f32x4 (&acc)[2][2][4][2], const Unit& u, int wr, int wc, int fr, int fq, const F& f) {
#pragma unroll
    for (int bj = 0; bj < 2; ++bj)
#pragma unroll
        for (int ai = 0; ai < 2; ++ai)
#pragma unroll
            for (int m = 0; m < 4; ++m)
#pragma unroll
                for (int n = 0; n < 2; ++n)
                    f(u.pm * 256 + ai * HALF + wr * 64 + m * 16 + fr, u.pn * 256 + bj * HALF + wc * 32 + fq * 8 + n * 4, acc[ai][bj][m][n]);
}
template <class E> struct MainEpi { E e; DI bool run(f32x4 (&acc)[2][2][4][2], const Unit& u, int wr, int wc, int fr, int fq) const {
    for_acc(acc, u, wr, wc, fr, fq, [&](int row, int col, f32x4& v) { e(row, col, v); }); return false; } };
struct MainEpiIn { EpiIn e;
    template <int S> DI void sec_loop(f32x4 (&acc)[2][2][4][2], const Unit& u, int bj, int wr, int wc, int fr, int fq) const {
        const int colb = u.pn * 256 + bj * HALF + wc * 32 + fq * 8;
        float lgf = 0.f, lgb = 0.f;
        if (S == 1) { const int h = ((u.pn * 256 + bj * HALF + wc * 32) & 511) >> 6; lgf = -__expf(e.rd[h]); lgb = -__expf(e.rd[8 + h]); }
#pragma unroll
        for (int ai = 0; ai < 2; ++ai) {
            const int rowb = u.pm * 256 + ai * HALF + wr * 64 + fr;
            f32x4 cs[4][2]; float rsv[4];
#pragma unroll
            for (int m = 0; m < 4; ++m) { rsv[m] = e.rs[rowb + m * 16];
#pragma unroll
                for (int n = 0; n < 2; ++n) cs[m][n] = e.load_cs<S>(rowb + m * 16, colb + n * 4); }
#pragma unroll
            for (int m = 0; m < 4; ++m) e.body2<S>(rowb + m * 16, colb, acc[ai][bj][m][0], acc[ai][bj][m][1], cs[m][0], cs[m][1], lgf, lgb, rsv[m]);
        }
    }
    DI bool run(f32x4 (&acc)[2][2][4][2], const Unit& u, int wr, int wc, int fr, int fq) const {
        {
            const int sec0 = EpiIn::section(u.pn * 256);
#define SECCASE(S, BJ) case S: sec_loop<S>(acc, u, BJ, wr, wc, fr, fq); break;
            switch (sec0) { SECCASE(0, 0) SECCASE(1, 0) SECCASE(2, 0) SECCASE(3, 0) SECCASE(4, 0) SECCASE(5, 0) SECCASE(6, 0) SECCASE(7, 0) default: sec_loop<8>(acc, u, 0, wr, wc, fr, fq); break; }
            const int sec1 = EpiIn::section(u.pn * 256 + HALF);
            switch (sec1) { SECCASE(0, 1) SECCASE(1, 1) SECCASE(2, 1) SECCASE(3, 1) SECCASE(4, 1) SECCASE(5, 1) SECCASE(6, 1) SECCASE(7, 1) default: sec_loop<8>(acc, u, 1, wr, wc, fr, fq); break; }
#undef SECCASE
        }
        return false; } };
struct MainEpiGate { const bf16_t* gr; const bf16_t* ga; bf16_t* z;
    DI bool run(f32x4 (&acc)[2][2][4][2], const Unit& u, int wr, int wc, int fr, int fq) const {
        const bool k0 = (u.kind == 0);
#pragma unroll
        for (int bj = 0; bj < 2; ++bj)
#pragma unroll
            for (int ai = 0; ai < 2; ++ai) {
                const size_t base = (size_t)(u.pm * 256 + ai * HALF + wr * 64 + fr) * 1024 + (u.pn * 256 + bj * HALF + wc * 32 + fq * 8);
                u32x4 ra[4], rb[4];
#pragma unroll
                for (int m = 0; m < 4; ++m) { rb[m] = *(const u32x4*)(ga + base + (size_t)m * 16 * 1024); if (k0) ra[m] = *(const u32x4*)(gr + base + (size_t)m * 16 * 1024); else ra[m] = rb[m]; }
#pragma unroll
                for (int m = 0; m < 4; ++m) {
                    f32x4 a0, a1, b0, b1; unpack8(ra[m], a0, a1); unpack8(rb[m], b0, b1);
                    f32x4& v0 = acc[ai][bj][m][0]; f32x4& v1 = acc[ai][bj][m][1];
                    if (k0) {
#pragma unroll
                        for (int jj = 0; jj < 4; ++jj) { v0[jj] *= a0[jj] * __builtin_amdgcn_rcpf(fmaxf(b0[jj], 1e-30f)); v1[jj] *= a1[jj] * __builtin_amdgcn_rcpf(fmaxf(b1[jj], 1e-30f)); }
                    } else st8(z + base + (size_t)m * 16 * 1024, v0 * b0, v1 * b1);
                }
            }
        return k0;
    } };
template <class F> DI void for_acc2(f32x4 (&acc)[2][2][4][2], const Unit& u, int wr, int wc, int fr, int fq, const F& f) {
#pragma unroll
    for (int bj = 0; bj < 2; ++bj)
#pragma unroll
        for (int ai = 0; ai < 2; ++ai)
#pragma unroll
            for (int m = 0; m < 4; ++m)
                f(u.pm * 256 + ai * HALF + wr * 64 + m * 16 + fr, u.pn * 256 + bj * HALF + wc * 32 + fq * 8, acc[ai][bj][m][0], acc[ai][bj][m][1]);
}
struct MainEpiBf16 { bf16_t* out; DI bool run(f32x4 (&acc)[2][2][4][2], const Unit& u, int wr, int wc, int fr, int fq) const {
    for_acc2(acc, u, wr, wc, fr, fq, [&](int row, int col, const f32x4& a, const f32x4& b) { st8(out + (size_t)row * 1024 + col, a, b); }); return false; } };
struct MainEpiRelu2 { bf16_t* out; const float* rs; DI bool run(f32x4 (&acc)[2][2][4][2], const Unit& u, int wr, int wc, int fr, int fq) const {
    float rsv[2][4];
#pragma unroll
    for (int ai = 0; ai < 2; ++ai)
#pragma unroll
        for (int m = 0; m < 4; ++m) rsv[ai][m] = rs[u.pm * 256 + ai * HALF + wr * 64 + m * 16 + fr];
#pragma unroll
    for (int bj = 0; bj < 2; ++bj)
#pragma unroll
        for (int ai = 0; ai < 2; ++ai)
#pragma unroll
            for (int m = 0; m < 4; ++m) {
                const int row = u.pm * 256 + ai * HALF + wr * 64 + m * 16 + fr, col = u.pn * 256 + bj * HALF + wc * 32 + fq * 8;
                const f32x4 a = acc[ai][bj][m][0] * rsv[ai][m], b = acc[ai][bj][m][1] * rsv[ai][m];
                f32x4 x, y;
#pragma unroll
                for (int jj = 0; jj < 4; ++jj) { const float t = fmaxf(a[jj], 0.f), w = fmaxf(b[jj], 0.f); x[jj] = t * t; y[jj] = w * w; }
                st8(out + (size_t)row * 4096 + col, x, y);
            }
    return false; } };

template <class Sched, class Epi>
DI void gemm_main(LAS unsigned char* lds, int pitch, const Sched& S, const Epi& E) {
    const int tid = otid(), wid = __builtin_amdgcn_readfirstlane(tid >> 6), lane = tid & 63, wr = wid >> 2, wc = wid & 3, fr = lane & 15, fq = lane >> 4;
    unsigned voff[2], voffB[2];
#pragma unroll
    for (int i = 0; i < 2; ++i) { int R, C; stage_rc(tid * 16 + i * 8192, R, C); voff[i] = (unsigned)(R * pitch + C) * 2u;
        const int Rb = (R & ~31) + perm32(R & 31); voffB[i] = (unsigned)(Rb * pitch + C) * 2u; }
    const size_t kstep = (size_t)(BK * 2);
    const size_t hstep = (size_t)HALF * pitch * 2;
    const unsigned ldsw = (unsigned)wid * 1024u;
    const int aoff = lds_byte(wr * 64 + fr, fq * 8), boff = lds_byte(wc * 32 + fr, fq * 8);
#define G_SA(b, h) (((b) * 2 + (h)) * HTB)
#define G_SB(b, h) ((4 + (b) * 2 + (h)) * HTB)
#define G_STAGEV(bufoff, gbase, VO) do { _Pragma("unroll") for (int _i = 0; _i < 2; ++_i) \
        __builtin_amdgcn_global_load_lds((const unsigned*)((const char*)(gbase) + VO[_i]), (LAS unsigned*)(lds + (bufoff) + ldsw + _i * 8192), 16, 0, 0); } while (0)
#define G_STAGE(bufoff, gbase) G_STAGEV(bufoff, gbase, voff)
#define G_STAGEB(bufoff, gbase) G_STAGEV(bufoff, gbase, voffB)
#define G_LDA(dst, b, h) do { _Pragma("unroll") for (int m = 0; m < 4; ++m) _Pragma("unroll") for (int k = 0; k < 2; ++k) dst[m][k] = *(const LAS bf16x8*)(lds + G_SA(b, h) + aoff + m * 2048 + k * 1024); } while (0)
#define G_LDB(dst, b, h) do { _Pragma("unroll") for (int n = 0; n < 2; ++n) _Pragma("unroll") for (int k = 0; k < 2; ++k) dst[n][k] = *(const LAS bf16x8*)(lds + G_SB(b, h) + boff + n * 2048 + k * 1024); } while (0)
#define G_MMA(ai, bj, At, Bt) do { __builtin_amdgcn_s_setprio(1); _Pragma("unroll") for (int m = 0; m < 4; ++m) _Pragma("unroll") for (int n = 0; n < 2; ++n) _Pragma("unroll") for (int k = 0; k < 2; ++k) \
        acc[ai][bj][m][n] = __builtin_amdgcn_mfma_f32_16x16x32_bf16(Bt[n][k], At[m][k], acc[ai][bj][m][n], 0, 0, 0); __builtin_amdgcn_s_setprio(0); } while (0)
#define G_WAIT_V(n) asm volatile("s_waitcnt vmcnt(" #n ")" ::: "memory")
#define G_WAIT_L(n) asm volatile("s_waitcnt lgkmcnt(" #n ")" ::: "memory")
#define G_BAR __builtin_amdgcn_s_barrier()
#define G_SCHED __builtin_amdgcn_sched_barrier(0)
    Unit cur, nxt; int ui = 0;
    if (!S.next(0, cur)) return;
    f32x4 acc[2][2][4][2];
#pragma unroll
    for (int a = 0; a < 2; ++a)
#pragma unroll
        for (int b = 0; b < 2; ++b)
#pragma unroll
            for (int m = 0; m < 4; ++m)
#pragma unroll
                for (int n = 0; n < 2; ++n) acc[a][b][m][n] = (f32x4){0.f, 0.f, 0.f, 0.f};
    bf16x8 At[4][2], B0[2][2], B1[2][2];
    const char* cA = cur.A; const char* cB = cur.B;
    G_STAGEB(G_SB(0, 0), cB); G_STAGE(G_SA(0, 0), cA); G_STAGEB(G_SB(0, 1), cB + hstep); G_STAGE(G_SA(0, 1), cA + hstep);
    if (wr == 1) G_BAR;
    G_WAIT_V(4); G_BAR;
    G_STAGEB(G_SB(1, 0), cB + kstep); G_STAGE(G_SA(1, 0), cA + kstep); G_STAGEB(G_SB(1, 1), cB + hstep + kstep);
    G_WAIT_V(6); G_BAR;
    for (;;) {
        const bool has_next = S.next(ui + 1, nxt);
        const char* nA = has_next ? nxt.A : cA; const char* nB = has_next ? nxt.B : cB;
        const int nt = cur.nt;
        for (int t = 0; t < nt; t += 2) {
            const bool last = (t == nt - 2);
            const char* a1 = cA + (size_t)(t + 1) * kstep;
            const char* a2 = last ? nA : cA + (size_t)(t + 2) * kstep; const char* b2 = last ? nB : cB + (size_t)(t + 2) * kstep;
            const char* a3 = a2 + kstep; const char* b3 = b2 + kstep;
            G_LDB(B0, 0, 0); G_SCHED; G_LDA(At, 0, 0); G_STAGE(G_SA(1, 1), a1 + hstep);
            G_WAIT_L(8); G_BAR; G_WAIT_L(0); G_MMA(0, 0, At, B0); G_BAR; G_SCHED;
            G_LDB(B1, 0, 1); G_STAGEB(G_SB(0, 0), b2);
            G_BAR; G_WAIT_L(0); G_MMA(0, 1, At, B1); G_BAR;
            G_LDA(At, 0, 1); G_STAGE(G_SA(0, 0), a2);
            G_BAR; G_WAIT_L(0); G_MMA(1, 0, At, B0); G_BAR; G_SCHED;
            G_STAGEB(G_SB(0, 1), b2 + hstep);
            G_WAIT_V(6); G_BAR; G_MMA(1, 1, At, B1); G_BAR;
            G_LDB(B0, 1, 0); G_SCHED; G_LDA(At, 1, 0); G_STAGE(G_SA(0, 1), a2 + hstep);
            G_WAIT_L(8); G_BAR; G_WAIT_L(0); G_MMA(0, 0, At, B0); G_BAR; G_SCHED;
            G_LDB(B1, 1, 1); G_STAGEB(G_SB(1, 0), b3);
            G_BAR; G_WAIT_L(0); G_MMA(0, 1, At, B1); G_BAR;
            G_LDA(At, 1, 1); G_STAGE(G_SA(1, 0), a3);
            G_BAR; G_WAIT_L(0); G_MMA(1, 0, At, B0); G_BAR; G_SCHED;
            G_STAGEB(G_SB(1, 1), b3 + hstep);
            G_WAIT_V(6); G_BAR; G_MMA(1, 1, At, B1); G_BAR;
        }
        const bool keep = E.run(acc, cur, wr, wc, fr, fq);
        if (!has_next) break;
        if (!keep) {
#pragma unroll
            for (int a = 0; a < 2; ++a)
#pragma unroll
                for (int b = 0; b < 2; ++b)
#pragma unroll
                    for (int m = 0; m < 4; ++m)
#pragma unroll
                        for (int n = 0; n < 2; ++n) acc[a][b][m][n] = (f32x4){0.f, 0.f, 0.f, 0.f};
        }
        cur = nxt; cA = nA; cB = nB; ++ui;
    }
    G_WAIT_V(0);
    if (wr == 0) G_BAR;
    G_BAR;
#undef G_SA
#undef G_SB
#undef G_STAGE
#undef G_STAGEV
#undef G_STAGEB
#undef G_LDA
#undef G_LDB
#undef G_MMA
}

#define SB() __builtin_amdgcn_sched_barrier(0)
template <class Epi>
DI void gemm_tail(LAS unsigned char* lds, const bf16_t* A, const bf16_t* Bt, int pitch, int K, int N, const Epi& epi) {
    const int tid = otid(), wid = __builtin_amdgcn_readfirstlane(tid >> 6), lane = tid & 63, fr = lane & 15, fq = lane >> 4;
    LAS f32x4* red = (LAS f32x4*)lds;
    const int nitems = 8 * (N >> 6);
    const int kslice = K >> 3;
    for (int it = blockIdx.x; it < nitems; it += gridDim.x) {
        const int rt = it & 7, cg = it >> 3;
        const bf16_t* ap = A + (size_t)(RX + rt * 16 + fr) * pitch + fq * 8 + wid * kslice;
        const bf16_t* bp = Bt + (size_t)(cg * 64 + fr) * pitch + fq * 8 + wid * kslice;
        f32x4 acc[4];
#pragma unroll
        for (int cf = 0; cf < 4; ++cf) acc[cf] = (f32x4){0.f, 0.f, 0.f, 0.f};
        for (int k0 = 0; k0 < kslice; k0 += 128) {
            bf16x8 av[4], bv[4][4];
#pragma unroll
            for (int s4 = 0; s4 < 4; ++s4) { av[s4] = ld8(ap + k0 + s4 * 32);
#pragma unroll
                for (int cf = 0; cf < 4; ++cf) bv[s4][cf] = ld8(bp + (size_t)cf * 16 * pitch + k0 + s4 * 32); }
            SB();
#pragma unroll
            for (int s4 = 0; s4 < 4; ++s4)
#pragma unroll
                for (int cf = 0; cf < 4; ++cf) acc[cf] = mfma16(bv[s4][cf], av[s4], acc[cf]);
        }
#pragma unroll
        for (int cf = 0; cf < 4; ++cf) red[(wid * 4 + cf) * 64 + lane] = acc[cf];
        __syncthreads();
        if (wid < 4) {
            f32x4 v = red[(0 * 4 + wid) * 64 + lane];
#pragma unroll
            for (int w = 1; w < 8; ++w) v += red[(w * 4 + wid) * 64 + lane];
            epi(RX + rt * 16 + fr, cg * 64 + wid * 16 + fq * 4, v);
        }
        __syncthreads();
    }
}
DI void gemm_tail_gate(LAS unsigned char* lds, const bf16_t* A, const bf16_t* Bt, const bf16_t* gr, const bf16_t* ga, bf16_t* z) {
    const int tid = otid(), wid = __builtin_amdgcn_readfirstlane(tid >> 6), lane = tid & 63, fr = lane & 15, fq = lane >> 4;
    LAS f32x4* red = (LAS f32x4*)lds;
    for (int it = blockIdx.x; it < 128; it += gridDim.x) {
        const int rt = it & 7, cg = it >> 3;
        const bf16_t* ap = A + (size_t)(RX + rt * 16 + fr) * 1536 + fq * 8;
        const bf16_t* bp = Bt + (size_t)(cg * 64 + fr) * 1536 + fq * 8;
        bf16x8 av[6], bv[6][4];
#pragma unroll
        for (int s6 = 0; s6 < 6; ++s6) { const int ko = s6 < 4 ? wid * 128 + s6 * 32 : 1024 + wid * 64 + (s6 - 4) * 32; av[s6] = ld8(ap + ko);
#pragma unroll
            for (int cf = 0; cf < 4; ++cf) bv[s6][cf] = ld8(bp + (size_t)cf * 16 * 1536 + ko); }
        SB();
        f32x4 a0[4], a1[4];
#pragma unroll
        for (int cf = 0; cf < 4; ++cf) { a0[cf] = (f32x4){0.f, 0.f, 0.f, 0.f}; a1[cf] = (f32x4){0.f, 0.f, 0.f, 0.f}; }
#pragma unroll
        for (int s6 = 0; s6 < 6; ++s6)
#pragma unroll
            for (int cf = 0; cf < 4; ++cf) { if (s6 < 4) a0[cf] = mfma16(bv[s6][cf], av[s6], a0[cf]); else a1[cf] = mfma16(bv[s6][cf], av[s6], a1[cf]); }
#pragma unroll
        for (int cf = 0; cf < 4; ++cf) { red[(wid * 4 + cf) * 64 + lane] = a0[cf]; red[2048 + (wid * 4 + cf) * 64 + lane] = a1[cf]; }
        __syncthreads();
        if (wid < 4) {
            f32x4 v0 = red[(0 * 4 + wid) * 64 + lane], v1 = red[2048 + (0 * 4 + wid) * 64 + lane];
#pragma unroll
            for (int w = 1; w < 8; ++w) { v0 += red[(w * 4 + wid) * 64 + lane]; v1 += red[2048 + (w * 4 + wid) * 64 + lane]; }
            const int row = RX + rt * 16 + fr, col = cg * 64 + wid * 16 + fq * 4;
            const f32x4 sr = ld4(gr + (size_t)row * 1024 + col), sa = ld4(ga + (size_t)row * 1024 + col);
            st4(z + (size_t)row * 1024 + col, sr * v0 + sa * v1);
        }
        __syncthreads();
    }
}

struct Mix {
    const bf16_t *q_r, *k_r, *kdF, *kdB, *v_rT, *g_r, *q_a, *k_a, *v_aT;
    bf16_t* states; bf16_t* ycat; const float* rd; const float* sink;
};

DI bf16x8 ldsr8(const LAS unsigned char* p) { return *(const LAS bf16x8*)p; }
DI bf16x4 ldsr4(const LAS unsigned char* p) { return *(const LAS bf16x4*)p; }
DI bf16x8 pack8i(f32x4 a, f32x4 b) { u32x4 w; w.x = pk2(a[0], b[0]); w.y = pk2(a[1], b[1]); w.z = pk2(a[2], b[2]); w.w = pk2(a[3], b[3]); return __builtin_bit_cast(bf16x8, w); }

constexpr int ATT_KP = 208, ATT_VP = 800, ATT_VOFF = 400 * ATT_KP;
struct AttPre { bf16x8 k[7]; bf16x8 v[7]; };
template <bool DOK, bool DOV> DI void attn_prefetch(AttPre& R, const Mix& M, int t, int tid) {
    asm volatile("" : "+v"(tid));
    const int b = t & 7, qb = (t >> 3) & 15, g = t >> 7, s0 = qb * 128;
    if (DOK) {
#pragma unroll
    for (int i = 0; i < 7; ++i) {
        const int c = tid + 512 * i;
        if (c < 3200) {
            const int lk = c >> 3, c16 = c & 7;
            int row;
            if (lk < 384) { int sk = s0 - 128 + lk; sk = sk < 0 ? 0 : (sk > 2047 ? 2047 : sk); row = b * 2048 + sk; } else row = RX + b * 16 + (lk - 384);
            R.k[i] = ld8(M.k_a + (size_t)row * 128 + g * 64 + c16 * 8);
        }
    }
    }
    if (DOV) {
#pragma unroll
    for (int i = 0; i < 7; ++i) {
        const int c = tid + 512 * i;
        if (c < 3200) {
            const int e = c / 50, c16 = c - e * 50;
            int pp = (c16 < 48) ? (s0 + c16 * 8) : (112 + (c16 - 48) * 8);
            pp = pp > LP - 8 ? LP - 8 : pp;
            R.v[i] = ld8(M.v_aT + ((size_t)(b * 2 + g) * 64 + e) * LP + pp);
        }
    }
    }
}
DI void attn_commit(const AttPre& R, LAS unsigned char* lds, int tid) {
    asm volatile("" : "+v"(tid));
#pragma unroll
    for (int i = 0; i < 7; ++i) { const int c = tid + 512 * i; if (c < 3200) *(LAS bf16x8*)(lds + (c >> 3) * ATT_KP + (c & 7) * 16) = R.k[i]; }
#pragma unroll
    for (int i = 0; i < 7; ++i) { const int c = tid + 512 * i; if (c < 3200) { const int e = c / 50, c16 = c - e * 50; *(LAS bf16x8*)(lds + ATT_VOFF + e * ATT_VP + c16 * 16) = R.v[i]; } }
}
template <class Hook> DI void attn_wave(const Mix& M, const LAS unsigned char* lds, int b, int hq, int s0, int w, bf16x8 q0, bf16x8 q1, int lane, const Hook& hook) {
    asm volatile("" : "+v"(lane));
    const int fr = lane & 15, fq = lane >> 4;
    const int s = s0 + 16 * w + fr;
    const int rowq = (w >= 0) ? (b * 2048 + s) : (RX + b * 16 + fr);
    const int blk_lo = (w >= 0) ? (w >> 1) : 0;
    const LAS unsigned char* kb = lds + (32 * blk_lo + (fr >> 2) * 8 + 2 * (fr & 3)) * ATT_KP + fq * 16;
    f32x4 sa[9], sb[9], sm;
#pragma unroll
    for (int i0 = 0; i0 < 9; i0 += 3) {
        bf16x8 ka[3][2], kc[3][2];
#pragma unroll
        for (int u = 0; u < 3; ++u) {
            const int i = i0 + u;
            ka[u][0] = ldsr8(kb + i * 32 * ATT_KP); ka[u][1] = ldsr8(kb + i * 32 * ATT_KP + 64);
            kc[u][0] = ldsr8(kb + i * 32 * ATT_KP + ATT_KP); kc[u][1] = ldsr8(kb + i * 32 * ATT_KP + ATT_KP + 64);
        }
        SB();
#pragma unroll
        for (int u = 0; u < 3; ++u) {
            f32x4 a = {0.f, 0.f, 0.f, 0.f}, c = {0.f, 0.f, 0.f, 0.f};
            a = mfma16(ka[u][0], q0, a); a = mfma16(ka[u][1], q1, a);
            c = mfma16(kc[u][0], q0, c); c = mfma16(kc[u][1], q1, c);
            sa[i0 + u] = a; sb[i0 + u] = c;
        }
        SB();
    }
    {
        const LAS unsigned char* km = lds + (384 + fr) * ATT_KP + fq * 16;
        const bf16x8 k0 = ldsr8(km), k1 = ldsr8(km + 64);
        f32x4 a = {0.f, 0.f, 0.f, 0.f};
        a = mfma16(k0, q0, a); a = mfma16(k1, q1, a); sm = a;
    }
    const float sink = M.sink[hq];
    float mx = sink;
#pragma unroll
    for (int i = 0; i < 9; ++i)
#pragma unroll
        for (int jj = 0; jj < 4; ++jj) {
            const int ska = s0 - 128 + 32 * (blk_lo + i) + fq * 8 + 2 * jj; const int da = s - ska;
            const bool oka = (ska >= 0) && (ska < 2048) && (da <= 128) && (da >= -128);
            const bool okb = (ska + 1 >= 0) && (ska + 1 < 2048) && (da - 1 <= 128) && (da - 1 >= -128);
            const float va = oka ? sa[i][jj] : -1e30f, vb = okb ? sb[i][jj] : -1e30f;
            sa[i][jj] = va; sb[i][jj] = vb; mx = fmaxf(mx, fmaxf(va, vb));
        }
#pragma unroll
    for (int jj = 0; jj < 4; ++jj) mx = fmaxf(mx, sm[jj]);
    mx = fmaxf(mx, __shfl_xor(mx, 16)); mx = fmaxf(mx, __shfl_xor(mx, 32));
    float sum = 0.f;
    bf16x8 py[9], pym;
#pragma unroll
    for (int i = 0; i < 9; ++i) {
#pragma unroll
        for (int jj = 0; jj < 4; ++jj) { const float p0 = __expf(sa[i][jj] - mx), p1 = __expf(sb[i][jj] - mx); sa[i][jj] = p0; sb[i][jj] = p1; sum += p0 + p1; }
        py[i] = pack8i(sa[i], sb[i]);
    }
    {
#pragma unroll
        for (int jj = 0; jj < 4; ++jj) { const float p0 = __expf(sm[jj] - mx); sm[jj] = p0; sum += p0; }
        pym = pack8(sm, (f32x4){0.f, 0.f, 0.f, 0.f});
    }
    sum += __shfl_xor(sum, 16); sum += __shfl_xor(sum, 32);
    sum += __expf(sink - mx);
    SB(); hook(); SB();
    f32x4 o[4];
#pragma unroll
    for (int ef = 0; ef < 4; ++ef) o[ef] = (f32x4){0.f, 0.f, 0.f, 0.f};
    const LAS unsigned char* vb = lds + ATT_VOFF + fr * ATT_VP + (32 * blk_lo + fq * 8) * 2;
#pragma unroll
    for (int i0 = 0; i0 < 9; i0 += 3) {
        bf16x8 vx[3][4];
#pragma unroll
        for (int u = 0; u < 3; ++u)
#pragma unroll
            for (int ef = 0; ef < 4; ++ef) vx[u][ef] = ldsr8(vb + ef * 16 * ATT_VP + (i0 + u) * 64);
        SB();
#pragma unroll
        for (int u = 0; u < 3; ++u)
#pragma unroll
            for (int ef = 0; ef < 4; ++ef) o[ef] = mfma16(vx[u][ef], py[i0 + u], o[ef]);
        SB();
    }
    {
        const LAS unsigned char* vm = lds + ATT_VOFF + fr * ATT_VP + (384 + fq * 4) * 2;
        const bf16x4 z4 = {0, 0, 0, 0};
#pragma unroll
        for (int ef = 0; ef < 4; ++ef) o[ef] = mfma16(cat8(ldsr4(vm + ef * 16 * ATT_VP), z4), pym, o[ef]);
    }
    const float inv = 1.0f / sum;
#pragma unroll
    for (int ef = 0; ef < 4; ef += 2) st_pair16(M.ycat + (size_t)rowq * 1536 + 1024 + hq * 64 + ef * 16, o[ef] * inv, o[ef + 1] * inv, fq);
}
DI void attn_phase(const Mix& M, LAS unsigned char* lds, int first, int step, int count) {
    const int tid = otid(), wid = __builtin_amdgcn_readfirstlane(tid >> 6), lane = tid & 63, fr = lane & 15, fq = lane >> 4;
    AttPre R;
    if (count > 0) attn_prefetch<true, true>(R, M, first, tid);
    for (int k = 0; k < count; ++k) {
        const int t = first + k * step;
        const int b = t & 7, qb = (t >> 3) & 15, g = t >> 7;
        const int rowq = b * 2048 + qb * 128 + 16 * wid + fr;
        bf16x8 q[4][2];
#pragma unroll
        for (int hh = 0; hh < 4; ++hh) { q[hh][0] = ld8(M.q_a + (size_t)rowq * 512 + (g * 4 + hh) * 64 + fq * 8); q[hh][1] = ld8(M.q_a + (size_t)rowq * 512 + (g * 4 + hh) * 64 + 32 + fq * 8); }
        __syncthreads();
        attn_commit(R, lds, tid);
        __syncthreads();
        const bool more = (k + 1 < count);
        if (more) attn_prefetch<true, true>(R, M, t + step, tid);
#pragma unroll
        for (int hh = 0; hh < 4; ++hh) attn_wave(M, lds, b, g * 4 + hh, qb * 128, wid, q[hh][0], q[hh][1], lane, [] {});
        if (qb == 0 && wid < 4) {
            const int rowm = RX + b * 16 + fr; const int hq = g * 4 + wid;
            const bf16x8 m0 = ld8(M.q_a + (size_t)rowm * 512 + hq * 64 + fq * 8), m1 = ld8(M.q_a + (size_t)rowm * 512 + hq * 64 + 32 + fq * 8);
            attn_wave(M, lds, b, hq, 0, -1, m0, m1, lane, [] {});
        }
    }
    __syncthreads();
}

constexpr int SC_P = 288, SC_KB = 64 * SC_P, SC_BUF = SC_KB + 64 * SC_P;
static_assert(2 * SC_BUF <= LDS_MAIN, "lds");
struct ScanPre { bf16x8 k[2]; bf16x8 v[2]; };
DI void scan_prefetch(ScanPre& R, const bf16_t* kd, const bf16_t* vt, int n, int tid) {
    asm volatile("" : "+v"(tid));
#pragma unroll
    for (int i = 0; i < 2; ++i) { const int c = tid + 512 * i; R.k[i] = ld8(kd + (size_t)(c >> 4) * LP + 128 * n + (c & 15) * 8); R.v[i] = ld8(vt + (size_t)(c >> 4) * LP + 128 * n + (c & 15) * 8); }
}
DI void scan_commit(const ScanPre& R, LAS unsigned char* buf, int tid) {
    asm volatile("" : "+v"(tid));
#pragma unroll
    for (int i = 0; i < 2; ++i) { const int c = tid + 512 * i; *(LAS bf16x8*)(buf + (c >> 4) * SC_P + (c & 15) * 16) = R.k[i]; *(LAS bf16x8*)(buf + SC_KB + (c >> 4) * SC_P + (c & 15) * 16) = R.v[i]; }
}
DI void scan_block(const Mix& M, LAS unsigned char* lds, int item) {
    const int tid = otid(), wid = __builtin_amdgcn_readfirstlane(tid >> 6), lane = tid & 63, fr = lane & 15, fq = lane >> 4;
    const int xq = item & 7, yq = item >> 3;
    const int eh = yq & 1, dir = (yq >> 1) & 1, bh = (yq >> 2) * 8 + xq, h = bh & 7;
    const int efl = wid & 3, dh = wid >> 2;
    const bf16_t* kd = (dir ? M.kdB : M.kdF) + (size_t)bh * 64 * LP;
    const bf16_t* vt = M.v_rT + ((size_t)bh * 128 + eh * 64) * LP;
    const float lg = -__expf(M.rd[dir * 8 + h]); const float gC = __expf(lg * 128.0f);
    bf16_t* sbase = M.states + (((size_t)bh * NCH) * 2 + dir) * 128 * 64 + (size_t)(eh * 64 + efl * 16 + fr) * 64 + dh * 32 + fq * 4;
    f32x4 acc[2];
#pragma unroll
    for (int df = 0; df < 2; ++df) acc[df] = (f32x4){0.f, 0.f, 0.f, 0.f};
    ScanPre ring[4];
#pragma unroll
    for (int s0 = 0; s0 < 4; ++s0) scan_prefetch(ring[s0], kd, vt, dir ? (16 - s0) : s0, tid);
    __syncthreads();
#pragma unroll
    for (int s = 0; s < 16; ++s) {
        LAS unsigned char* buf = lds + (s & 1) * SC_BUF;
        scan_commit(ring[s & 3], buf, tid);
        if (s + 4 < 16) scan_prefetch(ring[s & 3], kd, vt, dir ? (16 - (s + 4)) : (s + 4), tid);
        __syncthreads();
        const int n = dir ? (16 - s) : s;
        bf16_t* sp = sbase + (size_t)n * 2 * 128 * 64;
        st_pair16(sp - fq * 4, acc[0], acc[1], fq);
#pragma unroll
        for (int df = 0; df < 2; ++df) acc[df] *= gC;
        const LAS unsigned char* kp = buf + (dh * 32 + fr) * SC_P + fq * 16;
        const LAS unsigned char* vp = buf + SC_KB + (efl * 16 + fr) * SC_P + fq * 16;
        bf16x8 vy[4], kx[4][2];
#pragma unroll
        for (int ks = 0; ks < 4; ++ks) { vy[ks] = ldsr8(vp + ks * 64);
#pragma unroll
            for (int df = 0; df < 2; ++df) kx[ks][df] = ldsr8(kp + df * 16 * SC_P + ks * 64); }
        SB();
#pragma unroll
        for (int ks = 0; ks < 4; ++ks)
#pragma unroll
            for (int df = 0; df < 2; ++df) acc[df] = mfma16(kx[ks][df], vy[ks], acc[df]);
        SB();
    }
    {
        bf16_t* sp = sbase + (size_t)(dir ? 0 : 16) * 2 * 128 * 64;
        st_pair16(sp - fq * 4, acc[0], acc[1], fq);
    }
    __syncthreads();
}

DI void ret_item(const Mix& M, int b, int h, int n, int iq) {
    const int lane = otid() & 63, fr = lane & 15, fq = lane >> 4;
    const int i = 16 * iq + fr;
    const int rowq = n ? (b * 2048 + (n - 1) * 128 + i) : (RX + b * 16 + (i - 112));
    bf16x8 qy[2];
#pragma unroll
    for (int ks = 0; ks < 2; ++ks) qy[ks] = ld8(M.q_r + (size_t)rowq * 512 + h * 64 + ks * 32 + fq * 8);
    const float lgf = -__expf(M.rd[h]), lgb = -__expf(M.rd[8 + h]);
    const float cf = __expf(lgf * (float)(i + 1)), cb = __expf(lgb * (float)(128 - i));
    const bf16_t* SF = M.states + (((size_t)(b * 8 + h) * NCH + n) * 2 + 0) * 128 * 64 + (size_t)fr * 64 + fq * 8;
    const bf16_t* SBk = SF + 128 * 64;
    const bf16_t* vbase = M.v_rT + ((size_t)(b * 8 + h) * 128 + fr) * LP + 128 * n + fq * 4;
    bf16x8 sfx[8][2], kx[8][2];
#pragma unroll
    for (int ef = 0; ef < 8; ++ef)
#pragma unroll
        for (int ks = 0; ks < 2; ++ks) sfx[ef][ks] = ld8(SF + (size_t)ef * 16 * 64 + ks * 32);
#pragma unroll
    for (int jf = 0; jf < 8; ++jf) {
        const int j = 16 * jf + fr;
        int jm = j - 112; jm = jm < 0 ? 0 : jm;
        const int rowk = n ? (b * 2048 + (n - 1) * 128 + j) : (RX + b * 16 + jm);
        const bf16_t* kp = M.k_r + (size_t)rowk * 512 + h * 64 + fq * 8;
        kx[jf][0] = ld8(kp); kx[jf][1] = ld8(kp + 32);
    }
    SB();
    f32x4 o[8];
#pragma unroll
    for (int ef = 0; ef < 8; ++ef) {
        f32x4 t = {0.f, 0.f, 0.f, 0.f};
        t = mfma16(sfx[ef][0], qy[0], t); t = mfma16(sfx[ef][1], qy[1], t);
        o[ef] = t * cf;
    }
    f32x4 st[8];
#pragma unroll
    for (int jf = 0; jf < 8; ++jf) {
        f32x4 t = {0.f, 0.f, 0.f, 0.f};
        t = mfma16(kx[jf][0], qy[0], t); t = mfma16(kx[jf][1], qy[1], t);
        st[jf] = t;
    }
    SB();
    bf16x8 sbx[8][2];
#pragma unroll
    for (int ef = 0; ef < 8; ++ef)
#pragma unroll
        for (int ks = 0; ks < 2; ++ks) sbx[ef][ks] = ld8(SBk + (size_t)ef * 16 * 64 + ks * 32);
    bf16x4 va[2][8][2];
#pragma unroll
    for (int pr = 0; pr < 2; ++pr)
#pragma unroll
        for (int ef = 0; ef < 8; ++ef) { va[pr][ef][0] = ld4s(vbase + (size_t)ef * 16 * LP + 32 * pr); va[pr][ef][1] = ld4s(vbase + (size_t)ef * 16 * LP + 32 * pr + 16); }
    SB();
#pragma unroll
    for (int ef = 0; ef < 8; ++ef) {
        f32x4 t = {0.f, 0.f, 0.f, 0.f};
        t = mfma16(sbx[ef][0], qy[0], t); t = mfma16(sbx[ef][1], qy[1], t);
        o[ef] += t * cb;
    }
    bf16x8 py[4];
#pragma unroll
    for (int pr = 0; pr < 4; ++pr) {
#pragma unroll
        for (int hh = 0; hh < 2; ++hh) {
            const int jf = 2 * pr + hh;
#pragma unroll
            for (int jj = 0; jj < 4; ++jj) {
                const int jv = 16 * jf + fq * 4 + jj; const int d = i - jv;
                float w = (d >= 0) ? __expf(lgf * (float)d) : __expf(lgb * (float)(-d));
                if (n == 0 && jv < 112) w = 0.f;
                st[jf][jj] *= w;
            }
        }
        py[pr] = pack8(st[2 * pr], st[2 * pr + 1]);
    }
    SB();
    bf16x4 vb[2][8][2];
#pragma unroll
    for (int pr = 0; pr < 2; ++pr)
#pragma unroll
        for (int ef = 0; ef < 8; ++ef) { vb[pr][ef][0] = ld4s(vbase + (size_t)ef * 16 * LP + 32 * (pr + 2)); vb[pr][ef][1] = ld4s(vbase + (size_t)ef * 16 * LP + 32 * (pr + 2) + 16); }
    u32x2 gx[8];
#pragma unroll
    for (int ef = 0; ef < 8; ++ef) gx[ef] = *(const u32x2*)(M.g_r + (size_t)rowq * 1024 + h * 128 + ef * 16 + fq * 4);
    SB();
#pragma unroll
    for (int pr = 0; pr < 2; ++pr)
#pragma unroll
        for (int ef = 0; ef < 8; ++ef) o[ef] = mfma16(cat8(va[pr][ef][0], va[pr][ef][1]), py[pr], o[ef]);
#pragma unroll
    for (int pr = 0; pr < 2; ++pr)
#pragma unroll
        for (int ef = 0; ef < 8; ++ef) o[ef] = mfma16(cat8(vb[pr][ef][0], vb[pr][ef][1]), py[pr + 2], o[ef]);
    float s = 0.f;
#pragma unroll
    for (int ef = 0; ef < 8; ++ef) s += (o[ef][0] + o[ef][1]) + (o[ef][2] + o[ef][3]);
    s += __shfl_xor(s, 16); s += __shfl_xor(s, 32);
    const float mean = s * (1.0f / 128.0f);
    float q = 0.f;
#pragma unroll
    for (int ef = 0; ef < 8; ++ef) { const f32x4 d = o[ef] - mean; q += (d[0] * d[0] + d[1] * d[1]) + (d[2] * d[2] + d[3] * d[3]); }
    q += __shfl_xor(q, 16); q += __shfl_xor(q, 32);
    const float rstd = rsqrtf(q * (1.0f / 128.0f) + EPS);
#pragma unroll
    for (int ef = 0; ef < 8; ++ef) {
        f32x4 gv; gv[0] = __uint_as_float(gx[ef].x << 16); gv[1] = __uint_as_float(gx[ef].x & 0xffff0000u); gv[2] = __uint_as_float(gx[ef].y << 16); gv[3] = __uint_as_float(gx[ef].y & 0xffff0000u);
        st4(M.ycat + (size_t)rowq * 1536 + h * 128 + ef * 16 + fq * 4, (o[ef] - mean) * rstd * gv);
    }
}

constexpr int RET_KP = 208, RET_SP = 160, RET_VP = 288;
constexpr int RET_SFOFF = 128 * RET_KP, RET_SBOFF = RET_SFOFF + 128 * RET_SP, RET_VOFF = RET_SBOFF + 128 * RET_SP;
static_assert(RET_VOFF + 128 * RET_VP <= LDS_MAIN, "lds");
struct RetPre { bf16x8 k[2], sf[2], sb[2], v[4], q[2]; };
DI void ret_prefetch(RetPre& R, const Mix& M, int t, int tid) {
    asm volatile("" : "+v"(tid));
    const int n = (t & 15) + 1, bh = t >> 4, b = bh >> 3, h = bh & 7;
    const int wid = tid >> 6, lane = tid & 63, fr = lane & 15, fq = lane >> 4;
    const bf16_t* SF = M.states + (((size_t)bh * NCH + n) * 2 + 0) * 128 * 64;
#pragma unroll
    for (int i = 0; i < 2; ++i) {
        const int c = tid + 512 * i;
        R.k[i] = ld8(M.k_r + (size_t)(b * 2048 + (n - 1) * 128 + (c >> 3)) * 512 + h * 64 + (c & 7) * 8);
        R.sf[i] = ld8(SF + (size_t)c * 8); R.sb[i] = ld8(SF + 128 * 64 + (size_t)c * 8);
    }
#pragma unroll
    for (int i = 0; i < 4; ++i) { const int c = tid + 512 * i; R.v[i] = ld8(M.v_rT + ((size_t)bh * 128 + (c >> 4)) * LP + 128 * n + (c & 15) * 8); }
    const int rowq = b * 2048 + (n - 1) * 128 + 16 * wid + fr;
    R.q[0] = ld8(M.q_r + (size_t)rowq * 512 + h * 64 + fq * 8); R.q[1] = ld8(M.q_r + (size_t)rowq * 512 + h * 64 + 32 + fq * 8);
}
DI void ret_commit(const RetPre& R, LAS unsigned char* lds, int tid) {
    asm volatile("" : "+v"(tid));
#pragma unroll
    for (int i = 0; i < 2; ++i) {
        const int c = tid + 512 * i;
        *(LAS bf16x8*)(lds + (c >> 3) * RET_KP + (c & 7) * 16) = R.k[i];
        *(LAS bf16x8*)(lds + RET_SFOFF + (c >> 3) * RET_SP + (c & 7) * 16) = R.sf[i];
        *(LAS bf16x8*)(lds + RET_SBOFF + (c >> 3) * RET_SP + (c & 7) * 16) = R.sb[i];
    }
#pragma unroll
    for (int i = 0; i < 4; ++i) { const int c = tid + 512 * i; *(LAS bf16x8*)(lds + RET_VOFF + (c >> 4) * RET_VP + (c & 15) * 16) = R.v[i]; }
}
DI void ret_wave(const Mix& M, const LAS unsigned char* lds, int b, int h, int n, int w, bf16x8 q0, bf16x8 q1, int lane) {
    asm volatile("" : "+v"(lane));
    const int fr = lane & 15, fq = lane >> 4;
    const int i = 16 * w + fr;
    const int rowq = b * 2048 + (n - 1) * 128 + i;
    u32x2 gx[8];
#pragma unroll
    for (int ef = 0; ef < 8; ++ef) gx[ef] = *(const u32x2*)(M.g_r + (size_t)rowq * 1024 + h * 128 + ef * 16 + fq * 4);
    const float lgf = -__expf(M.rd[h]), lgb = -__expf(M.rd[8 + h]);
    const float cf = __expf(lgf * (float)(i + 1)), cb = __expf(lgb * (float)(128 - i));
    f32x4 o[8];
    const LAS unsigned char* sfp = lds + RET_SFOFF + fr * RET_SP + fq * 16;
    const LAS unsigned char* sbp = lds + RET_SBOFF + fr * RET_SP + fq * 16;
#pragma unroll
    for (int e0 = 0; e0 < 8; e0 += 4) {
        bf16x8 xf[4][2], xb[4][2];
#pragma unroll
        for (int u = 0; u < 4; ++u) { const int ef = e0 + u;
            xf[u][0] = ldsr8(sfp + ef * 16 * RET_SP); xf[u][1] = ldsr8(sfp + ef * 16 * RET_SP + 64);
            xb[u][0] = ldsr8(sbp + ef * 16 * RET_SP); xb[u][1] = ldsr8(sbp + ef * 16 * RET_SP + 64); }
        SB();
#pragma unroll
        for (int u = 0; u < 4; ++u) {
            f32x4 t = {0.f, 0.f, 0.f, 0.f}, t2 = {0.f, 0.f, 0.f, 0.f};
            t = mfma16(xf[u][0], q0, t); t = mfma16(xf[u][1], q1, t);
            t2 = mfma16(xb[u][0], q0, t2); t2 = mfma16(xb[u][1], q1, t2);
            o[e0 + u] = t * cf + t2 * cb;
        }
        SB();
    }
    const LAS unsigned char* kb = lds + ((fr >> 2) * 8 + 2 * (fr & 3)) * RET_KP + fq * 16;
    bf16x8 py[4];
    bf16x8 kxa[4][2], kxc[4][2];
#pragma unroll
    for (int blk = 0; blk < 4; ++blk) {
        kxa[blk][0] = ldsr8(kb + blk * 32 * RET_KP); kxa[blk][1] = ldsr8(kb + blk * 32 * RET_KP + 64);
        kxc[blk][0] = ldsr8(kb + blk * 32 * RET_KP + RET_KP); kxc[blk][1] = ldsr8(kb + blk * 32 * RET_KP + RET_KP + 64);
    }
    SB();
#pragma unroll
    for (int blk = 0; blk < 4; ++blk) {
        f32x4 a = {0.f, 0.f, 0.f, 0.f}, c = {0.f, 0.f, 0.f, 0.f};
        a = mfma16(kxa[blk][0], q0, a); a = mfma16(kxa[blk][1], q1, a);
        c = mfma16(kxc[blk][0], q0, c); c = mfma16(kxc[blk][1], q1, c);
#pragma unroll
        for (int jj = 0; jj < 4; ++jj) {
            const int ja = 32 * blk + fq * 8 + 2 * jj; const int da = i - ja, db = da - 1;
            a[jj] *= (da >= 0) ? __expf(lgf * (float)da) : __expf(lgb * (float)(-da));
            c[jj] *= (db >= 0) ? __expf(lgf * (float)db) : __expf(lgb * (float)(-db));
        }
        py[blk] = pack8i(a, c);
    }
    const LAS unsigned char* vp = lds + RET_VOFF + fr * RET_VP + fq * 16;
    SB();
#pragma unroll
    for (int blk = 0; blk < 4; blk += 2) {
        bf16x8 vx[2][8];
#pragma unroll
        for (int u = 0; u < 2; ++u)
#pragma unroll
            for (int ef = 0; ef < 8; ++ef) vx[u][ef] = ldsr8(vp + ef * 16 * RET_VP + (blk + u) * 64);
        SB();
#pragma unroll
        for (int u = 0; u < 2; ++u)
#pragma unroll
            for (int ef = 0; ef < 8; ++ef) o[ef] = mfma16(vx[u][ef], py[blk + u], o[ef]);
        SB();
    }
    float s = 0.f;
#pragma unroll
    for (int ef = 0; ef < 8; ++ef) s += (o[ef][0] + o[ef][1]) + (o[ef][2] + o[ef][3]);
    s += __shfl_xor(s, 16); s += __shfl_xor(s, 32);
    const float mean = s * (1.0f / 128.0f);
    float q = 0.f;
#pragma unroll
    for (int ef = 0; ef < 8; ++ef) { const f32x4 d = o[ef] - mean; q += (d[0] * d[0] + d[1] * d[1]) + (d[2] * d[2] + d[3] * d[3]); }
    q += __shfl_xor(q, 16); q += __shfl_xor(q, 32);
    const float rstd = rsqrtf(q * (1.0f / 128.0f) + EPS);
#pragma unroll
    for (int ef = 0; ef < 8; ef += 2) {
        f32x4 gv, gw;
        gv[0] = __uint_as_float(gx[ef].x << 16); gv[1] = __uint_as_float(gx[ef].x & 0xffff0000u); gv[2] = __uint_as_float(gx[ef].y << 16); gv[3] = __uint_as_float(gx[ef].y & 0xffff0000u);
        gw[0] = __uint_as_float(gx[ef + 1].x << 16); gw[1] = __uint_as_float(gx[ef + 1].x & 0xffff0000u); gw[2] = __uint_as_float(gx[ef + 1].y << 16); gw[3] = __uint_as_float(gx[ef + 1].y & 0xffff0000u);
        st_pair16(M.ycat + (size_t)rowq * 1536 + h * 128 + ef * 16, (o[ef] - mean) * rstd * gv, (o[ef + 1] - mean) * rstd * gw, fq);
    }
}
DI void ret_phase(const Mix& M, LAS unsigned char* lds) {
    const int tid = otid(), wid = __builtin_amdgcn_readfirstlane(tid >> 6), lane = tid & 63;
    const int G = gridDim.x;
    int t = blockIdx.x;
    RetPre R;
    if (t < 1024) ret_prefetch(R, M, t, tid);
    for (; t < 1024; t += G) {
        __syncthreads();
        ret_commit(R, lds, tid);
        const bf16x8 q0 = R.q[0], q1 = R.q[1];
        __syncthreads();
        if (t + G < 1024) ret_prefetch(R, M, t + G, tid);
        const int n = (t & 15) + 1, bh = t >> 4;
        ret_wave(M, lds, bh >> 3, bh & 7, n, wid, q0, q1, lane);
    }
    __syncthreads();
}

DI bf16_t* hrow(const Params& P, int row) { return (bf16_t*)(P.ws + WS_ST) + (size_t)row * 1024; }
template <int NB>
DI void rowpass_rows(const Params& P, const bf16_t* t, const float* gpost, const float* gpre, float* rs, int row0, int rstride, int lane) {
    f32x4 hv[NB][4]; u32x2 tr[NB][4], hr[NB][4];
#pragma unroll
    for (int r = 0; r < NB; ++r) {
        const int row = row0 + r * rstride;
        const bf16_t* hp = hrow(P, row); const bf16_t* tp = t + (size_t)row * 1024;
#pragma unroll
        for (int k = 0; k < 4; ++k) { tr[r][k] = *(const u32x2*)(tp + (k * 64 + lane) * 4); hr[r][k] = *(const u32x2*)(hp + (k * 64 + lane) * 4); }
    }
    f32x4 gp[4];
#pragma unroll
    for (int k = 0; k < 4; ++k) gp[k] = *(const f32x4*)(gpost + (k * 64 + lane) * 4);
    SB();
    float s2[NB];
#pragma unroll
    for (int r = 0; r < NB; ++r) {
        f32x4 tv[4]; float ss = 0.f;
#pragma unroll
        for (int k = 0; k < 4; ++k) {
            tv[k][0] = __uint_as_float(tr[r][k].x << 16); tv[k][1] = __uint_as_float(tr[r][k].x & 0xffff0000u); tv[k][2] = __uint_as_float(tr[r][k].y << 16); tv[k][3] = __uint_as_float(tr[r][k].y & 0xffff0000u);
            hv[r][k][0] = __uint_as_float(hr[r][k].x << 16); hv[r][k][1] = __uint_as_float(hr[r][k].x & 0xffff0000u); hv[r][k][2] = __uint_as_float(hr[r][k].y << 16); hv[r][k][3] = __uint_as_float(hr[r][k].y & 0xffff0000u);
            ss += (tv[k][0] * tv[k][0] + tv[k][1] * tv[k][1]) + (tv[k][2] * tv[k][2] + tv[k][3] * tv[k][3]);
        }
        ss = wsum(ss);
        const float sc = rsqrtf(ss * (1.0f / 1024.0f) + EPS);
        const int row = row0 + r * rstride;
        bf16_t* hp = hrow(P, row);
        float q = 0.f;
#pragma unroll
        for (int k = 0; k < 4; ++k) { hv[r][k] += tv[k] * sc * gp[k];
            if (gpre) st4(hp + (k * 64 + lane) * 4, hv[r][k]); else if (row < RX) *(f32x4*)(P.out + (size_t)row * 1024 + (k * 64 + lane) * 4) = hv[r][k];
            q += (hv[r][k][0] * hv[r][k][0] + hv[r][k][1] * hv[r][k][1]) + (hv[r][k][2] * hv[r][k][2] + hv[r][k][3] * hv[r][k][3]); }
        s2[r] = q;
    }
    if (gpre) {
#pragma unroll
        for (int r = 0; r < NB; ++r) {
            const float sc2 = rsqrtf(wsum(s2[r]) * (1.0f / 1024.0f) + EPS);
            if (lane == 0) rs[row0 + r * rstride] = sc2;
        }
    }
}
DI void rowpass(const Params& P, const bf16_t* t, const float* gpost, const float* gpre, float* u, int gw, int nw) {
    const int lane = otid() & 63;
    if (nw == 2048) {
        const int blk = gw >> 3, wid = gw & 7;
        const int base = 2048 * (blk & 7) + (blk >> 3) * 64 + wid;
        rowpass_rows<4>(P, t, gpost, gpre, u, base, 8, lane);
        rowpass_rows<4>(P, t, gpost, gpre, u, base + 32, 8, lane);
    } else {
        for (int base = gw; base < RX; base += nw * 4) {
            if (base + 3 * nw < RX) rowpass_rows<4>(P, t, gpost, gpre, u, base, nw, lane);
            else for (int row = base; row < RX; row += nw) rowpass_rows<1>(P, t, gpost, gpre, u, row, 0, lane);
        }
    }
    for (int row = RX + gw; row < RT; row += nw) rowpass_rows<1>(P, t, gpost, gpre, u, row, 0, lane);
}
DI void rowinit(const Params& P, float* rs, int gw, int nw) {
    const int lane = otid() & 63;
    for (int row = gw; row < RT; row += nw) {
        bf16_t* hp = hrow(P, row);
        const float* src = row < RX ? P.x + (size_t)row * 1024 : P.meta + (size_t)((row - RX) & 15) * 1024;
        f32x4 hv[4]; float s2 = 0.f;
#pragma unroll
        for (int k = 0; k < 4; ++k) hv[k] = *(const f32x4*)(src + (k * 64 + lane) * 4);
        SB();
#pragma unroll
        for (int k = 0; k < 4; ++k) { st4(hp + (k * 64 + lane) * 4, hv[k]);
            s2 += (hv[k][0] * hv[k][0] + hv[k][1] * hv[k][1]) + (hv[k][2] * hv[k][2] + hv[k][3] * hv[k][3]); }
        s2 = wsum(s2);
        if (lane == 0) rs[row] = rsqrtf(s2 * (1.0f / 1024.0f) + EPS);
    }
}

DI int perm64(int mode, int w) { return mode == 1 ? ((w >> 1) + 32 * (w & 1)) : (mode == 2 ? (w < 16 ? ((w >> 1) + 8 * (w & 1)) : w) : w); }
struct ConvJob { const float* W; bf16_t* Bt; const float* gain; int ncols, k0, n0, ldb, koff, mode; };
DI ConvJob conv_decode(const Params& P, int l, int job) {
    unsigned char* wb = P.ws + WS_W;
    ConvJob J; int j = job; J.gain = nullptr;
    if (j < 1472) { J.gain = P.n_mix_pre + l * 1024; const int nt = j % 92, kt = j / 92; const int c0 = nt * 64;
        J.W = P.w_in + (size_t)l * 1024 * DIN; J.ncols = DIN; J.k0 = kt * 64; J.n0 = c0; J.Bt = (bf16_t*)(wb + W_IN); J.ldb = 1024; J.koff = 0;
        J.mode = c0 < 1024 ? 1 : ((c0 >= 3072 && c0 < 3712) ? 2 : 0); return J; }
    j -= 1472; J.mode = 0; J.koff = 0; J.ncols = 1024;
    if (j < 256) { J.W = P.w_ret_o + (size_t)l * 1024 * 1024; J.k0 = (j >> 4) * 64; J.n0 = (j & 15) * 64; J.Bt = (bf16_t*)(wb + W_CAT); J.ldb = 1536; return J; }
    j -= 256;
    if (j < 128) { J.W = P.w_att_o + (size_t)l * 512 * 1024; J.k0 = (j >> 4) * 64; J.n0 = (j & 15) * 64; J.Bt = (bf16_t*)(wb + W_CAT); J.ldb = 1536; J.koff = 1024; return J; }
    j -= 128;
    if (j < 256) { J.W = P.w_mix_o + (size_t)l * 1024 * 1024; J.k0 = (j >> 4) * 64; J.n0 = (j & 15) * 64; J.Bt = (bf16_t*)(wb + W_MIX); J.ldb = 1024; return J; }
    j -= 256;
    if (j < 1024) { J.gain = P.n_ff_pre + l * 1024; J.W = P.w_ff1 + (size_t)l * 1024 * 4096; J.ncols = 4096; J.k0 = (j >> 6) * 64; J.n0 = (j & 63) * 64; J.Bt = (bf16_t*)(wb + W_FF1); J.ldb = 1024; return J; }
    j -= 1024;
    J.W = P.w_ff2 + (size_t)l * 4096 * 1024; J.k0 = (j >> 4) * 64; J.n0 = (j & 15) * 64; J.Bt = (bf16_t*)(wb + W_FF2); J.ldb = 4096; return J;
}
DI void convert_weights(const Params& P, int l, LAS unsigned char* lds) {
    LAS float* tiles = (LAS float*)lds;
    const int t = otid();
    const int G = gridDim.x;
    for (int base = blockIdx.x; base < 4160; base += 4 * G) {
        ConvJob J[4]; f32x4 v[4][2];
#pragma unroll
        for (int q = 0; q < 4; ++q) {
            const int job = base + q * G;
            if (job < 4160) {
                J[q] = conv_decode(P, l, job);
#pragma unroll
                for (int rep = 0; rep < 2; ++rep) { const int kk = (t >> 4) + 32 * rep, nn = (t & 15) * 4; v[q][rep] = *(const f32x4*)(J[q].W + (size_t)(J[q].k0 + kk) * J[q].ncols + J[q].n0 + nn);
                    if (J[q].gain) v[q][rep] *= J[q].gain[J[q].k0 + kk]; }
            }
        }
        SB();
#pragma unroll
        for (int q = 0; q < 4; ++q) {
            if (base + q * G < 4160) {
                LAS float* tile = tiles + q * 4160;
#pragma unroll
                for (int rep = 0; rep < 2; ++rep) { const int kk = (t >> 4) + 32 * rep, nn = (t & 15) * 4;
                    tile[kk * 65 + nn] = v[q][rep][0]; tile[kk * 65 + nn + 1] = v[q][rep][1]; tile[kk * 65 + nn + 2] = v[q][rep][2]; tile[kk * 65 + nn + 3] = v[q][rep][3]; }
            }
        }
        __syncthreads();
#pragma unroll
        for (int q = 0; q < 4; ++q) {
            if (base + q * G < 4160) {
                const LAS float* tile = tiles + q * 4160;
                const int nq = t >> 3, kk8 = (t & 7) * 8, sc = perm64(J[q].mode, nq);
                u32x4 w;
                w.x = pk2(tile[(kk8 + 0) * 65 + sc], tile[(kk8 + 1) * 65 + sc]); w.y = pk2(tile[(kk8 + 2) * 65 + sc], tile[(kk8 + 3) * 65 + sc]);
                w.z = pk2(tile[(kk8 + 4) * 65 + sc], tile[(kk8 + 5) * 65 + sc]); w.w = pk2(tile[(kk8 + 6) * 65 + sc], tile[(kk8 + 7) * 65 + sc]);
                *(u32x4*)(J[q].Bt + (size_t)(J[q].n0 + nq) * J[q].ldb + J[q].koff + J[q].k0 + kk8) = w;
            }
        }
        __syncthreads();
    }
}

DI void make_tables(const Params& P) {
    float* tabR = (float*)(P.ws + WS_TABR); float* tabA = (float*)(P.ws + WS_TABA);
    const int gt = blockIdx.x * blockDim.x + otid(), nth = gridDim.x * blockDim.x;
    for (int idx = gt; idx < 2064 * 40; idx += nth) {
        int p, i; float fr; float* dst;
        if (idx < 2064 * 32) { p = idx >> 5; i = idx & 31; fr = powf(10000.0f, -(float)(2 * i) / 64.0f); dst = tabR + (size_t)idx * 2; }
        else { const int k = idx - 2064 * 32; p = k >> 3; i = k & 7; fr = powf(500000.0f, -(float)(2 * i) / 16.0f); dst = tabA + (size_t)k * 2; }
        const float ang = (float)p * fr;
        double rev = (double)ang * 0.15915494309189533576888; rev -= floor(rev);
        const float r = (float)(rev * 6.283185307179586476925);
        dst[0] = __cosf(r); dst[1] = __sinf(r);
    }
}
DI void zero_pads(const Params& P) {
    unsigned char* proj = P.ws + WS_PROJ;
    const int gt = blockIdx.x * blockDim.x + otid(), nth = gridDim.x * blockDim.x;
    const u32x4 z = {0u, 0u, 0u, 0u};
    for (int idx = gt; idx < 17408 * 14; idx += nth) {
        int r = idx / 14; const int c = idx - r * 14;
        bf16_t* base;
        if (r < 4096) base = (bf16_t*)(proj + P_KDF); else if (r < 8192) { base = (bf16_t*)(proj + P_KDB); r -= 4096; }
        else if (r < 16384) { base = (bf16_t*)(proj + P_VRT); r -= 8192; } else { base = (bf16_t*)(proj + P_VAT); r -= 16384; }
        *(u32x4*)(base + (size_t)r * LP + c * 8) = z;
    }
}

#define XB_TMO      128
#define XB_XCNT(j)  (256  + 64 * (j))
#define XB_XSUB(j)  (1280 + 64 * (j))
#define XB_XGEN(j)  (2304 + 64 * (j))
#define XB_TOP      3328
#define XB_TOPGEN   3392
#define XCD_BAR_WORDS 3456
#define XB_SPIN_CAP (1u << 22)
DI unsigned xb_ld(unsigned* p)              { return __hip_atomic_load(p, __ATOMIC_RELAXED, __HIP_MEMORY_SCOPE_AGENT); }
DI unsigned xb_add(unsigned* p, unsigned v) { return __hip_atomic_fetch_add(p, v, __ATOMIC_RELAXED, __HIP_MEMORY_SCOPE_AGENT); }
DI unsigned xb_xcc_id() { return (unsigned)__builtin_amdgcn_s_getreg((3 << 11) | 20) & 0xFu; }
#define XB_SPIN(cond, bar) do { unsigned _sp = 0; while (cond) { __builtin_amdgcn_s_sleep(1); \
    if ((++_sp & 255u) == 0u) { if (xb_ld(&(bar)[XB_TMO])) break; if (_sp > XB_SPIN_CAP) { atomicAdd(&(bar)[XB_TMO], 1u); break; } } } } while (0)
struct XcdBarrier { unsigned* bar; unsigned x; volatile LAS unsigned* st; };
DI XcdBarrier xcd_barrier_post(unsigned* bar, volatile LAS unsigned* st) {
    XcdBarrier b; b.bar = bar; b.x = xb_xcc_id(); b.st = st;
    if (threadIdx.x == 0) (void)xb_add(&bar[XB_XCNT(b.x)], 1u);
    return b;
}
DI void xcd_barrier_complete(unsigned* bar, unsigned x, unsigned& nloc, unsigned& nx) {
    const unsigned G = gridDim.x * gridDim.y * gridDim.z;
    unsigned sum, cnt, mine, sp = 0u;
    for (;;) {
        sum = 0u; cnt = 0u; mine = 0u;
#pragma unroll
        for (unsigned j = 0; j < 16; ++j) { const unsigned c = xb_ld(&bar[XB_XCNT(j)]); sum += c; cnt += (c > 0u) ? 1u : 0u; mine = (j == x) ? c : mine; }
        if (sum == G) break;
        __builtin_amdgcn_s_sleep(1);
        if ((++sp & 255u) == 0u) { if (xb_ld(&bar[XB_TMO])) break; if (sp > XB_SPIN_CAP) { atomicAdd(&bar[XB_TMO], 1u); break; } }
    }
    nloc = mine > 0u ? mine : 1u; nx = cnt > 0u ? cnt : 1u;
}
DI void xcd_barrier(const XcdBarrier& b) {
    asm volatile("s_waitcnt vmcnt(0)" ::: "memory");
    __syncthreads();
    if (threadIdx.x == 0) {
        unsigned* bar = b.bar;
        __builtin_amdgcn_s_waitcnt(0);
        unsigned nloc = b.st[0], nx = b.st[1];
        if (nloc == 0u) { xcd_barrier_complete(bar, b.x, nloc, nx); b.st[0] = nloc; b.st[1] = nx; }
        const unsigned old = xb_add(&bar[XB_XSUB(b.x)], 1u);
        const unsigned gen = old / nloc;
        if (old + 1u == (gen + 1u) * nloc) {
            __builtin_amdgcn_fence(__ATOMIC_RELEASE, "agent");
            asm volatile("s_waitcnt vmcnt(0)" ::: "memory");
            const unsigned og = xb_add(&bar[XB_TOP], 1u);
            const unsigned tg = og / nx;
            if (og + 1u == (tg + 1u) * nx) xb_add(&bar[XB_TOPGEN], 1u);
            else XB_SPIN(xb_ld(&bar[XB_TOPGEN]) == tg, bar);
            __builtin_amdgcn_fence(__ATOMIC_ACQUIRE, "agent");
            xb_add(&bar[XB_XGEN(b.x)], 1u);
            asm volatile("s_waitcnt vmcnt(0)" ::: "memory");
        } else {
            XB_SPIN(xb_ld(&bar[XB_XGEN(b.x)]) == gen, bar);
            __builtin_amdgcn_fence(__ATOMIC_ACQUIRE, "agent");
            asm volatile("s_waitcnt vmcnt(0)" ::: "memory");
        }
    }
    __syncthreads();
}

__global__ void __launch_bounds__(512, 2) mega(Params P) {
    extern __shared__ __attribute__((aligned(16))) unsigned char lds_raw[];
    LAS unsigned char* lds = (LAS unsigned char*)lds_raw;
    cg::grid_group grid = cg::this_grid();
    if (threadIdx.x < 4) ((volatile LAS unsigned*)(lds + LDS_MAIN))[threadIdx.x] = 0u;
    __syncthreads();
    XcdBarrier xb = xcd_barrier_post((unsigned*)(P.ws + WS_BAR), (volatile LAS unsigned*)(lds + LDS_MAIN));
    const int wid = __builtin_amdgcn_readfirstlane(threadIdx.x >> 6);
    const int G = gridDim.x, nw = G * 8;
    const int gw = blockIdx.x * 8 + wid;
    const int gws = wid * G + blockIdx.x;
    unsigned char* ws = P.ws; unsigned char* proj = ws + WS_PROJ;
    bf16_t* U = (bf16_t*)(ws + WS_U); bf16_t* YC = (bf16_t*)(ws + WS_U);
    bf16_t* ST = (bf16_t*)P.out; bf16_t* Z = (bf16_t*)P.out;
    bf16_t* FFH = (bf16_t*)(proj + P_FFH); bf16_t* MIXF = (bf16_t*)(proj + P_MIX);
    const bf16_t* Win = (const bf16_t*)(ws + WS_W + W_IN); const bf16_t* Wcat = (const bf16_t*)(ws + WS_W + W_CAT);
    const bf16_t* Wmix = (const bf16_t*)(ws + WS_W + W_MIX); const bf16_t* Wff1 = (const bf16_t*)(ws + WS_W + W_FF1); const bf16_t* Wff2 = (const bf16_t*)(ws + WS_W + W_FF2);

    float* RS = (float*)(ws + WS_HMETA);
    const bf16_t* H16 = (const bf16_t*)(ws + WS_ST);
    if (P.ws == nullptr) grid.sync();

    for (int l = -1; l < 4; ++l) {
      if (l < 0) {
        make_tables(P);
        rowinit(P, RS, gw, nw);
      } else {
        for (int rep = 0; rep < REP_G1; ++rep) {
            zero_pads(P);
            EpiIn e; e.proj = proj; e.tabR = (const float*)(ws + WS_TABR); e.tabA = (const float*)(ws + WS_TABA); e.rd = P.ret_decay + l * 16; e.rs = RS;
            SchedPlain S; S.T.init(DIN); S.A = (const char*)H16; S.B = (const char*)Win; S.tstep = (size_t)256 * 1024 * 2; S.nt = 16;
            MainEpiIn me; me.e = e;
            gemm_main(lds, 1024, S, me);
            gemm_tail(lds, H16, Win, 1024, 1024, DIN, e);
        }
        xcd_barrier(xb);
        Mix M; M.q_r = (const bf16_t*)(proj + P_QR); M.k_r = (const bf16_t*)(proj + P_KR); M.kdF = (const bf16_t*)(proj + P_KDF); M.kdB = (const bf16_t*)(proj + P_KDB);
        M.v_rT = (const bf16_t*)(proj + P_VRT); M.g_r = (const bf16_t*)(proj + P_GR); M.q_a = (const bf16_t*)(proj + P_QA); M.k_a = (const bf16_t*)(proj + P_KA);
        M.v_aT = (const bf16_t*)(proj + P_VAT); M.states = ST; M.ycat = YC; M.rd = P.ret_decay + l * 16; M.sink = P.attn_sink + l * 8;
        for (int rep = 0; rep < REP_MX; ++rep) {
            for (int it = blockIdx.x; it < 256; it += G) scan_block(M, lds, it);
            attn_phase(M, lds, blockIdx.x, G, (256 - (int)blockIdx.x + G - 1) / G);
        }
        xcd_barrier(xb);
        for (int rep = 0; rep < REP_MX; ++rep) {
            ret_phase(M, lds);
            for (int it = gws; it < 64; it += nw) ret_item(M, it >> 3, it & 7, 0, 7);
        }
        xcd_barrier(xb);
        for (int rep = 0; rep < REP_G23; ++rep) {
            SchedGate S; S.T.init(1024); S.A = (const char*)YC; S.B = (const char*)Wcat; S.tstep = (size_t)256 * 1536 * 2;
            MainEpiGate me; me.gr = (const bf16_t*)(proj + P_GATER); me.ga = (const bf16_t*)(proj + P_GATEA); me.z = Z;
            gemm_main(lds, 1536, S, me);
            gemm_tail_gate(lds, YC, Wcat, me.gr, me.ga, Z);
        }
        xcd_barrier(xb);
        for (int rep = 0; rep < REP_G23; ++rep) {
            SchedPlain S; S.T.init(1024); S.A = (const char*)Z; S.B = (const char*)Wmix; S.tstep = (size_t)256 * 1024 * 2; S.nt = 16;
            MainEpiBf16 me; me.out = MIXF; EpiF32 te; te.out = MIXF;
            gemm_main(lds, 1024, S, me);
            gemm_tail(lds, Z, Wmix, 1024, 1024, 1024, te);
        }
        xcd_barrier(xb);
        rowpass(P, MIXF, P.n_mix_post + l * 1024, P.n_ff_pre + l * 1024, RS, gw, nw);
        xcd_barrier(xb);
        for (int rep = 0; rep < REP_FF; ++rep) {
            SchedPlain S; S.T.init(DFF); S.A = (const char*)H16; S.B = (const char*)Wff1; S.tstep = (size_t)256 * 1024 * 2; S.nt = 16;
            MainEpiRelu2 me; me.out = FFH; me.rs = RS; EpiRelu2 te; te.out = FFH; te.rs = RS;
            gemm_main(lds, 1024, S, me);
            gemm_tail(lds, H16, Wff1, 1024, 1024, DFF, te);
        }
        xcd_barrier(xb);
        for (int rep = 0; rep < REP_FF; ++rep) {
            SchedPlain S; S.T.init(1024); S.A = (const char*)FFH; S.B = (const char*)Wff2; S.tstep = (size_t)256 * 4096 * 2; S.nt = 64;
            MainEpiBf16 me; me.out = MIXF; EpiF32 te; te.out = MIXF;
            gemm_main(lds, 4096, S, me);
            gemm_tail(lds, FFH, Wff2, 4096, 4096, 1024, te);
        }
        xcd_barrier(xb);
        rowpass(P, MIXF, P.n_ff_post + l * 1024, l < 3 ? P.n_mix_pre + (l + 1) * 1024 : nullptr, RS, gw, nw);
      }
        if (l < 3) { convert_weights(P, l + 1, lds); xcd_barrier(xb); }
    }
}

extern "C" void kernel_launch(void* const* d_in, const int* in_sizes, int n_in, void* d_out, int out_size, void* d_ws, size_t ws_size, hipStream_t stream) {
    static int grid_blocks = 0;
    if (!grid_blocks) {
        int dev = 0, cus = 0, per_cu = 0;
        hipGetDevice(&dev);
        hipDeviceGetAttribute(&cus, hipDeviceAttributeMultiprocessorCount, dev);
        hipFuncSetAttribute((const void*)mega, hipFuncAttributeMaxDynamicSharedMemorySize, LDS_BYTES);
        hipOccupancyMaxActiveBlocksPerMultiprocessor(&per_cu, (const void*)mega, 512, LDS_BYTES);
        if (per_cu < 1) per_cu = 1;
        grid_blocks = cus * per_cu;
        if (ws_size < WS_END) fprintf(stderr, "kernel_launch: workspace too small: %zu < %zu\n", ws_size, (size_t)WS_END);
    }
    Params p{};
    p.x = (const float*)d_in[0]; p.meta = (const float*)d_in[1]; p.w_in = (const float*)d_in[2]; p.w_ret_o = (const float*)d_in[3];
    p.w_att_o = (const float*)d_in[4]; p.w_mix_o = (const float*)d_in[5]; p.w_ff1 = (const float*)d_in[6]; p.w_ff2 = (const float*)d_in[7];
    p.n_mix_pre = (const float*)d_in[8]; p.n_mix_post = (const float*)d_in[9]; p.n_ff_pre = (const float*)d_in[10]; p.n_ff_post = (const float*)d_in[11];
    p.ret_decay = (const float*)d_in[12]; p.attn_sink = (const float*)d_in[13];
    p.out = (float*)d_out; p.ws = (unsigned char*)d_ws;
    (void)hipMemsetAsync((unsigned char*)d_ws + WS_BAR, 0, 16384, stream);
    void* args[] = {&p};
    hipError_t e = hipLaunchCooperativeKernel((const void*)mega, dim3(grid_blocks), dim3(512), args, LDS_BYTES, stream);
    if (e != hipSuccess) fprintf(stderr, "cooperative launch failed: %s (grid %d)\n", hipGetErrorString(e), grid_blocks);
}
```

```cpp
#include <hip/hip_runtime.h>
#include <hip/hip_cooperative_groups.h>
#include <cstdio>
namespace cg = cooperative_groups;
#ifndef REP_G1
#define REP_G1 1
#endif
#ifndef REP_MX
#define REP_MX 1
#endif
#ifndef REP_FF
#define REP_FF 1
#endif
#ifndef REP_G23
#define REP_G23 1
#endif

#define LAS __attribute__((address_space(3)))
#define DI __device__ __forceinline__
typedef unsigned short bf16_t;
typedef short bf16x8 __attribute__((ext_vector_type(8)));
typedef short bf16x4 __attribute__((ext_vector_type(4)));
typedef float f32x4 __attribute__((ext_vector_type(4)));
typedef float f32x2 __attribute__((ext_vector_type(2)));
typedef unsigned u32x4 __attribute__((ext_vector_type(4)));
typedef unsigned u32x2 __attribute__((ext_vector_type(2)));
typedef __bf16 bfx2 __attribute__((ext_vector_type(2)));

constexpr int RX = 16384;
constexpr int RT = 16512;
constexpr int DM = 1024, DIN = 5888, DFF = 4096, LP = 2176, NCH = 17;
constexpr float EPS = 1e-6f;

constexpr size_t WS_HMETA = 0;
constexpr size_t WS_TABR = WS_HMETA + (size_t)128 * 1024 * 4;
constexpr size_t WS_TABA = WS_TABR + (size_t)2064 * 32 * 2 * 4;
constexpr size_t WS_W = WS_TABA + (size_t)2064 * 8 * 2 * 4;
constexpr size_t W_IN = 0;
constexpr size_t W_CAT = W_IN + (size_t)DIN * 1024 * 2;
constexpr size_t W_MIX = W_CAT + (size_t)1024 * 1536 * 2;
constexpr size_t W_FF1 = W_MIX + (size_t)1024 * 1024 * 2;
constexpr size_t W_FF2 = W_FF1 + (size_t)4096 * 1024 * 2;
constexpr size_t W_END = W_FF2 + (size_t)1024 * 4096 * 2;
constexpr size_t WS_U = WS_W + W_END;
constexpr size_t WS_ST = WS_U + (size_t)RT * 1536 * 2;
constexpr size_t WS_PROJ = WS_ST + (size_t)8 * 8 * 17 * 2 * 128 * 64 * 2;
constexpr size_t P_QR = 0;
constexpr size_t P_KR = P_QR + (size_t)RT * 512 * 2;
constexpr size_t P_KDF = P_KR + (size_t)RT * 512 * 2;
constexpr size_t P_KDB = P_KDF + (size_t)64 * 64 * LP * 2;
constexpr size_t P_VRT = P_KDB + (size_t)64 * 64 * LP * 2;
constexpr size_t P_GR = P_VRT + (size_t)64 * 128 * LP * 2;
constexpr size_t P_QA = P_GR + (size_t)RT * 1024 * 2;
constexpr size_t P_KA = P_QA + (size_t)RT * 512 * 2;
constexpr size_t P_VAT = P_KA + (size_t)RT * 128 * 2;
constexpr size_t P_GATER = P_VAT + (size_t)16 * 64 * LP * 2;
constexpr size_t P_GATEA = P_GATER + (size_t)RT * 1024 * 2;
constexpr size_t P_END = P_GATEA + (size_t)RT * 1024 * 2;
constexpr size_t P_FFH = 0;
constexpr size_t P_MIX = (size_t)RT * 4096 * 2;
static_assert(P_MIX + (size_t)RT * 1024 * 4 <= P_END, "alias");
constexpr size_t WS_BAR = WS_PROJ + P_END;
constexpr size_t WS_END = WS_BAR + 16384;

constexpr int LDS_MAIN = 134400;
constexpr int LDS_BYTES = LDS_MAIN + 16;

struct Params {
    const float *x, *meta, *w_in, *w_ret_o, *w_att_o, *w_mix_o, *w_ff1, *w_ff2;
    const float *n_mix_pre, *n_mix_post, *n_ff_pre, *n_ff_post, *ret_decay, *attn_sink;
    float* out; unsigned char* ws;
};

DI unsigned pk2(float lo, float hi) { f32x2 v = {lo, hi}; bfx2 b = __builtin_convertvector(v, bfx2); return __builtin_bit_cast(unsigned, b); }
DI u32x2 pk4(f32x4 v) { u32x2 r; r.x = pk2(v[0], v[1]); r.y = pk2(v[2], v[3]); return r; }
DI void st4(bf16_t* p, f32x4 v) { *(u32x2*)p = pk4(v); }
DI void st_pair16(bf16_t* p, f32x4 a, f32x4 b, int fq) {
    const u32x2 pa = pk4(a), pb = pk4(b);
    const auto r0 = __builtin_amdgcn_permlane16_swap(pa.x, pb.x, false, false);
    const auto r1 = __builtin_amdgcn_permlane16_swap(pa.y, pb.y, false, false);
    u32x4 w; w.x = r0[0]; w.y = r1[0]; w.z = r0[1]; w.w = r1[1];
    *(u32x4*)(p + (fq & 1) * 16 + (fq >> 1) * 8) = w;
}
DI bf16_t bf1(float x) { return (bf16_t)(pk2(x, x) & 0xffffu); }
DI f32x4 ld4(const bf16_t* p) {
    u32x2 w = *(const u32x2*)p; f32x4 r;
    r[0] = __uint_as_float(w.x << 16); r[1] = __uint_as_float(w.x & 0xffff0000u);
    r[2] = __uint_as_float(w.y << 16); r[3] = __uint_as_float(w.y & 0xffff0000u); return r;
}
DI bf16x8 pack8(f32x4 a, f32x4 b) { u32x4 w; w.x = pk2(a[0], a[1]); w.y = pk2(a[2], a[3]); w.z = pk2(b[0], b[1]); w.w = pk2(b[2], b[3]); return __builtin_bit_cast(bf16x8, w); }
DI bf16x8 cat8(bf16x4 lo, bf16x4 hi) { return __builtin_shufflevector(lo, hi, 0, 1, 2, 3, 4, 5, 6, 7); }
DI bf16x8 ld8(const bf16_t* p) { return *(const bf16x8*)p; }
DI bf16x4 ld4s(const bf16_t* p) { return *(const bf16x4*)p; }
DI f32x4 mfma16(bf16x8 a, bf16x8 b, f32x4 c) { return __builtin_amdgcn_mfma_f32_16x16x32_bf16(a, b, c, 0, 0, 0); }
DI float sigm(float x) { return __builtin_amdgcn_rcpf(1.0f + __expf(-x)); }
DI float wsum(float v) { v += __shfl_xor(v, 1); v += __shfl_xor(v, 2); v += __shfl_xor(v, 4); v += __shfl_xor(v, 8); v += __shfl_xor(v, 16); v += __shfl_xor(v, 32); return v; }
DI int otid() { int t = threadIdx.x; asm volatile("" : "+v"(t)); return t; }
DI void row_bp(int row, int& b, int& p, int& pp) {
    if (row < RX) { b = row >> 11; const int s = row & 2047; p = 16 + s; pp = 128 + s; }
    else { const int m = row - RX; b = m >> 4; p = m & 15; pp = 112 + p; }
}

DI void unpack8(u32x4 w, f32x4& lo, f32x4& hi) {
    lo[0] = __uint_as_float(w.x << 16); lo[1] = __uint_as_float(w.x & 0xffff0000u); lo[2] = __uint_as_float(w.y << 16); lo[3] = __uint_as_float(w.y & 0xffff0000u);
    hi[0] = __uint_as_float(w.z << 16); hi[1] = __uint_as_float(w.z & 0xffff0000u); hi[2] = __uint_as_float(w.w << 16); hi[3] = __uint_as_float(w.w & 0xffff0000u);
}
DI void st8(bf16_t* p, f32x4 a, f32x4 b) { u32x4 w; w.x = pk2(a[0], a[1]); w.y = pk2(a[2], a[3]); w.z = pk2(b[0], b[1]); w.w = pk2(b[2], b[3]); *(u32x4*)p = w; }
struct EpiIn {
    unsigned char* proj; const float* tabR; const float* tabA; const float* rd; const float* rs;
    template <int SEC> DI f32x4 load_cs(int row, int col) const {
        int b, p, pp; row_bp(row, b, p, pp);
        if (SEC == 0 || SEC == 1) { const int w = col & 63; return *(const f32x4*)(tabR + ((size_t)p * 32 + (w >> 1)) * 2); }
        if (SEC == 4 || SEC == 5) { const int w = col & 63; if (w < 16) return *(const f32x4*)(tabA + ((size_t)p * 8 + (w >> 1)) * 2); }
        return (f32x4){1.f, 0.f, 1.f, 0.f};
    }
    template <int SEC> DI f32x4 xform(f32x4 v, f32x4 cs) const {
        f32x4 o = v;
        if (SEC == 0 || SEC == 1 || SEC == 4 || SEC == 5) {
            o[0] = v[0] * cs[0] - v[1] * cs[1]; o[1] = v[1] * cs[0] + v[0] * cs[1];
            o[2] = v[2] * cs[2] - v[3] * cs[3]; o[3] = v[3] * cs[2] + v[2] * cs[3];
            if (SEC == 0 || SEC == 4) o *= 0.125f;
        } else if (SEC == 3) {
#pragma unroll
            for (int jj = 0; jj < 4; ++jj) o[jj] = v[jj] * sigm(v[jj]);
        } else if (SEC == 7 || SEC == 8) {
#pragma unroll
            for (int jj = 0; jj < 4; ++jj) o[jj] = sigm(v[jj]);
        }
        return o;
    }
    template <int SEC> DI bf16_t* dst(int row, int col) const {
        if (SEC == 0) return (bf16_t*)(proj + P_QR) + (size_t)row * 512 + col;
        if (SEC == 1) return (bf16_t*)(proj + P_KR) + (size_t)row * 512 + (col - 512);
        if (SEC == 3) return (bf16_t*)(proj + P_GR) + (size_t)row * 1024 + (col - 2048);
        if (SEC == 4) return (bf16_t*)(proj + P_QA) + (size_t)row * 512 + (col - 3072);
        if (SEC == 5) return (bf16_t*)(proj + P_KA) + (size_t)row * 128 + (col - 3584);
        if (SEC == 7) return (bf16_t*)(proj + P_GATER) + (size_t)row * 1024 + (col - 3840);
        if (SEC == 8) return (bf16_t*)(proj + P_GATEA) + (size_t)row * 1024 + (col - 4864);
        return nullptr;
    }
    template <int SEC> DI void scatter(int row, int col, f32x4 o, float lgf, float lgb) const {
        if (SEC != 1 && SEC != 2 && SEC != 6) return;
        int b, p, pp; row_bp(row, b, p, pp);
        if (SEC == 1) {
            const int c = col & 511, w = c & 63, h = c >> 6;
            const int j = pp & 127;
            const float df = __expf(lgf * (float)(127 - j)), db = __expf(lgb * (float)j);
            const size_t base = ((size_t)(b * 8 + h) * 64 + w) * LP + pp;
            bf16_t* kf = (bf16_t*)(proj + P_KDF) + base; bf16_t* kb = (bf16_t*)(proj + P_KDB) + base;
#pragma unroll
            for (int jj = 0; jj < 4; ++jj) { kf[(size_t)jj * LP] = bf1(o[jj] * df); kb[(size_t)jj * LP] = bf1(o[jj] * db); }
        } else if (SEC == 2) {
            const int c = col - 1024, h = c >> 7, e = c & 127;
            bf16_t* vt = (bf16_t*)(proj + P_VRT) + ((size_t)(b * 8 + h) * 128 + e) * LP + pp;
#pragma unroll
            for (int jj = 0; jj < 4; ++jj) vt[(size_t)jj * LP] = bf1(o[jj]);
        } else {
            const int c = col - 3712, g = c >> 6, d = c & 63;
            bf16_t* vt = (bf16_t*)(proj + P_VAT) + ((size_t)(b * 2 + g) * 64 + d) * LP + pp;
#pragma unroll
            for (int jj = 0; jj < 4; ++jj) vt[(size_t)jj * LP] = bf1(o[jj]);
        }
    }
    template <int SEC> DI void body(int row, int col, f32x4 v, f32x4 cs, float lgf, float lgb) const {
        const f32x4 o = xform<SEC>(v * rs[row], cs);
        if (SEC != 2 && SEC != 6) st4(dst<SEC>(row, col), o);
        scatter<SEC>(row, col, o, lgf, lgb);
    }
    template <int SEC> DI void body2(int row, int col, f32x4 v0, f32x4 v1, f32x4 cs0, f32x4 cs1, float lgf, float lgb, float rsv) const {
        const f32x4 o0 = xform<SEC>(v0 * rsv, cs0), o1 = xform<SEC>(v1 * rsv, cs1);
        if (SEC != 2 && SEC != 6) st8(dst<SEC>(row, col), o0, o1);
        scatter<SEC>(row, col, o0, lgf, lgb); scatter<SEC>(row, col + 4, o1, lgf, lgb);
    }
    static DI int section(int col) {
        return col < 512 ? 0 : col < 1024 ? 1 : col < 2048 ? 2 : col < 3072 ? 3 : col < 3584 ? 4 : col < 3712 ? 5 : col < 3840 ? 6 : col < 4864 ? 7 : 8;
    }
    template <int SEC> DI void one(int row, int col, f32x4 v) const {
        float lgf = 0.f, lgb = 0.f;
        if (SEC == 1) { const int h = (col & 511) >> 6; lgf = -__expf(rd[h]); lgb = -__expf(rd[8 + h]); }
        body<SEC>(row, col, v, load_cs<SEC>(row, col), lgf, lgb);
    }
    DI void operator()(int row, int col, f32x4 v) const {
        if (col >= 3840) {
            const int w = col - 3840, g = 128 * (w >> 8) + (w & 127); const float r = rs[row]; f32x4 o;
#pragma unroll
            for (int jj = 0; jj < 4; ++jj) o[jj] = sigm(v[jj] * r);
            st4((bf16_t*)(proj + (((w >> 7) & 1) ? P_GATEA : P_GATER)) + (size_t)row * 1024 + g, o); return;
        }
        switch (section(col)) {
            case 0: one<0>(row, col, v); break; case 1: one<1>(row, col, v); break; case 2: one<2>(row, col, v); break;
            case 3: one<3>(row, col, v); break; case 4: one<4>(row, col, v); break; case 5: one<5>(row, col, v); break;
            case 6: one<6>(row, col, v); break; case 7: one<7>(row, col, v); break; default: one<8>(row, col, v); break;
        }
    }
};
struct EpiF32 { bf16_t* out; DI void operator()(int row, int col, f32x4 v) const { st4(out + (size_t)row * 1024 + col, v); } };
struct EpiRelu2 { bf16_t* out; const float* rs; DI void operator()(int row, int col, f32x4 v) const {
    f32x4 o; const float r = rs[row];
#pragma unroll
    for (int jj = 0; jj < 4; ++jj) { const float t = fmaxf(v[jj] * r, 0.f); o[jj] = t * t; }
    st4(out + (size_t)row * 4096 + col, o); } };

constexpr int HALF = 128, BK = 64, HTB = HALF * BK * 2;
DI int lds_byte(int r, int c) { const int st = (r >> 4) * 2 + (c >> 5), rr = r & 15, cc = c & 31, ob = rr * 64 + cc * 2; return st * 1024 + (ob ^ (((ob >> 9) & 1) << 5)); }
DI int perm32(int rho) { const int n = rho >> 4, i = rho & 15; return 8 * (i >> 2) + 4 * n + (i & 3); }
DI void stage_rc(int b, int& R, int& C) { const int st = b / 1024, sb = b % 1024, swz = sb ^ (((sb >> 9) & 1) << 5); R = (st >> 1) * 16 + swz / 64; C = (st & 1) * 32 + (swz % 64) / 2; }

struct Unit { const char* A; const char* B; int nt, pm, pn, kind; };
struct TileOrder {
    int nM, nN, nwg, G, c;
    DI void init(int N) { nM = RX / 256; nN = N / 256; nwg = nM * nN; G = gridDim.x; c = blockIdx.x; }
    DI bool tile(int i, int& pm, int& pn) const {
        const long L = (long)i * G + c; if (L >= nwg) return false;
        int wgid = (int)L; { const int q = nwg / 8, r = nwg % 8, xcd = wgid % 8, off = wgid / 8; wgid = (xcd < r ? xcd * (q + 1) : r * (q + 1) + (xcd - r) * q) + off; }
        const int nig = 8 * nN, gid = wgid / nig, fm = gid * 8, gsz = (nM - fm) < 8 ? (nM - fm) : 8;
        pm = fm + ((wgid % nig) % gsz); pn = (wgid % nig) / gsz; return true;
    }
};
struct SchedPlain {
    TileOrder T; const char* A; const char* B; size_t tstep; int nt;
    DI bool next(int i, Unit& u) const { if (!T.tile(i, u.pm, u.pn)) return false; u.A = A + (size_t)u.pm * tstep; u.B = B + (size_t)u.pn * tstep; u.nt = nt; u.kind = 1; return true; }
};
struct SchedGate {
    TileOrder T; const char* A; const char* B; size_t tstep;
    DI bool next(int i, Unit& u) const { if (!T.tile(i >> 1, u.pm, u.pn)) return false; const int kind = i & 1; u.kind = kind;
        u.A = A + (size_t)u.pm * tstep + (kind ? 2048 : 0); u.B = B + (size_t)u.pn * tstep + (kind ? 2048 : 0); u.nt = kind ? 8 : 16; return true; }
};

template <class F> DI void for_acc(f32x4 (&acc)[2][2][4][2], const Unit& u, int wr, int wc, int fr, int fq, const F& f) {
#pragma unroll
    for (int bj = 0; bj < 2; ++bj)
#pragma unroll
        for (int ai = 0; ai < 2; ++ai)
#pragma unroll
            for (int m = 0; m < 4; ++m)
#pragma unroll
                for (int n = 0; n < 2; ++n)
                    f(u.pm * 256 + ai * HALF + wr * 64 + m * 16 + fr, u.pn * 256 + bj * HALF + wc * 32 + fq * 8 + n * 4, acc[ai][bj][m][n]);
}
template <class E> struct MainEpi { E e; DI bool run(f32x4 (&acc)[2][2][4][2], const Unit& u, int wr, int wc, int fr, int fq) const {
    for_acc(acc, u, wr, wc, fr, fq, [&](int row, int col, f32x4& v) { e(row, col, v); }); return false; } };
struct MainEpiIn { EpiIn e;
    template <int S> DI void sec_loop(f32x4 (&acc)[2][2][4][2], const Unit& u, int bj, int wr, int wc, int fr, int fq) const {
        const int colb = u.pn * 256 + bj * HALF + wc * 32 + fq * 8;
        float lgf = 0.f, lgb = 0.f;
        if (S == 1) { const int h = ((u.pn * 256 + bj * HALF + wc * 32) & 511) >> 6; lgf = -__expf(e.rd[h]); lgb = -__expf(e.rd[8 + h]); }
#pragma unroll
        for (int ai = 0; ai < 2; ++ai) {
            const int rowb = u.pm * 256 + ai * HALF + wr * 64 + fr;
            f32x4 cs[4][2]; float rsv[4];
#pragma unroll
            for (int m = 0; m < 4; ++m) { rsv[m] = e.rs[rowb + m * 16];
#pragma unroll
                for (int n = 0; n < 2; ++n) cs[m][n] = e.load_cs<S>(rowb + m * 16, colb + n * 4); }
#pragma unroll
            for (int m = 0; m < 4; ++m) e.body2<S>(rowb + m * 16, colb, acc[ai][bj][m][0], acc[ai][bj][m][1], cs[m][0], cs[m][1], lgf, lgb, rsv[m]);
        }
    }
    DI void gate_pair(f32x4 (&acc)[2][2][4][2], const Unit& u, int wr, int wc, int fr, int fq) const {
        const int gcol = 128 * (u.pn - 15) + wc * 32 + fq * 8;
#pragma unroll
        for (int ai = 0; ai < 2; ++ai)
#pragma unroll
            for (int m = 0; m < 4; ++m) {
                const int row = u.pm * 256 + ai * HALF + wr * 64 + m * 16 + fr; const float rsv = e.rs[row];
                f32x4 rt[2], sa[2];
#pragma unroll
                for (int n = 0; n < 2; ++n)
#pragma unroll
                    for (int jj = 0; jj < 4; ++jj) {
                        const float er = __expf(-acc[ai][0][m][n][jj] * rsv), ea = fminf(__expf(-acc[ai][1][m][n][jj] * rsv), 1e30f);
                        sa[n][jj] = __builtin_amdgcn_rcpf(1.0f + ea); rt[n][jj] = (1.0f + ea) * __builtin_amdgcn_rcpf(1.0f + er);
                    }
                st8((bf16_t*)(e.proj + P_GATER) + (size_t)row * 1024 + gcol, rt[0], rt[1]);
                st8((bf16_t*)(e.proj + P_GATEA) + (size_t)row * 1024 + gcol, sa[0], sa[1]);
            }
    }
    DI bool run(f32x4 (&acc)[2][2][4][2], const Unit& u, int wr, int wc, int fr, int fq) const {
        if (u.pn >= 15) { gate_pair(acc, u, wr, wc, fr, fq); return false; }
        {
            const int sec0 = EpiIn::section(u.pn * 256);
#define SECCASE(S, BJ) case S: sec_loop<S>(acc, u, BJ, wr, wc, fr, fq); break;
            switch (sec0) { SECCASE(0, 0) SECCASE(1, 0) SECCASE(2, 0) SECCASE(3, 0) SECCASE(4, 0) SECCASE(5, 0) SECCASE(6, 0) SECCASE(7, 0) default: sec_loop<8>(acc, u, 0, wr, wc, fr, fq); break; }
            const int sec1 = EpiIn::section(u.pn * 256 + HALF);
            switch (sec1) { SECCASE(0, 1) SECCASE(1, 1) SECCASE(2, 1) SECCASE(3, 1) SECCASE(4, 1) SECCASE(5, 1) SECCASE(6, 1) SECCASE(7, 1) default: sec_loop<8>(acc, u, 1, wr, wc, fr, fq); break; }
#undef SECCASE
        }
        return false; } };
struct MainEpiGate { const bf16_t* gr; const bf16_t* ga; bf16_t* z;
    DI bool run(f32x4 (&acc)[2][2][4][2], const Unit& u, int wr, int wc, int fr, int fq) const {
        const bool k0 = (u.kind == 0);
#pragma unroll
        for (int bj = 0; bj < 2; ++bj)
#pragma unroll
            for (int ai = 0; ai < 2; ++ai) {
                const size_t base = (size_t)(u.pm * 256 + ai * HALF + wr * 64 + fr) * 1024 + (u.pn * 256 + bj * HALF + wc * 32 + fq * 8);
                u32x4 rg[4];
#pragma unroll
                for (int m = 0; m < 4; ++m) rg[m] = *(const u32x4*)((k0 ? gr : ga) + base + (size_t)m * 16 * 1024);
#pragma unroll
                for (int m = 0; m < 4; ++m) {
                    f32x4 g0, g1; unpack8(rg[m], g0, g1);
                    f32x4& v0 = acc[ai][bj][m][0]; f32x4& v1 = acc[ai][bj][m][1];
                    if (k0) { v0 *= g0; v1 *= g1; }
                    else st8(z + base + (size_t)m * 16 * 1024, v0 * g0, v1 * g1);
                }
            }
        return k0;
    } };
template <class F> DI void for_acc2(f32x4 (&acc)[2][2][4][2], const Unit& u, int wr, int wc, int fr, int fq, const F& f) {
#pragma unroll
    for (int bj = 0; bj < 2; ++bj)
#pragma unroll
        for (int ai = 0; ai < 2; ++ai)
#pragma unroll
            for (int m = 0; m < 4; ++m)
                f(u.pm * 256 + ai * HALF + wr * 64 + m * 16 + fr, u.pn * 256 + bj * HALF + wc * 32 + fq * 8, acc[ai][bj][m][0], acc[ai][bj][m][1]);
}
struct MainEpiBf16 { bf16_t* out; DI bool run(f32x4 (&acc)[2][2][4][2], const Unit& u, int wr, int wc, int fr, int fq) const {
    for_acc2(acc, u, wr, wc, fr, fq, [&](int row, int col, const f32x4& a, const f32x4& b) { st8(out + (size_t)row * 1024 + col, a, b); }); return false; } };
struct MainEpiRelu2 { bf16_t* out; const float* rs; DI bool run(f32x4 (&acc)[2][2][4][2], const Unit& u, int wr, int wc, int fr, int fq) const {
    float rsv[2][4];
#pragma unroll
    for (int ai = 0; ai < 2; ++ai)
#pragma unroll
        for (int m = 0; m < 4; ++m) rsv[ai][m] = rs[u.pm * 256 + ai * HALF + wr * 64 + m * 16 + fr];
#pragma unroll
    for (int bj = 0; bj < 2; ++bj)
#pragma unroll
        for (int ai = 0; ai < 2; ++ai)
#pragma unroll
            for (int m = 0; m < 4; ++m) {
                const int row = u.pm * 256 + ai * HALF + wr * 64 + m * 16 + fr, col = u.pn * 256 + bj * HALF + wc * 32 + fq * 8;
                const f32x4 a = acc[ai][bj][m][0] * rsv[ai][m], b = acc[ai][bj][m][1] * rsv[ai][m];
                f32x4 x, y;
#pragma unroll
                for (int jj = 0; jj < 4; ++jj) { const float t = fmaxf(a[jj], 0.f), w = fmaxf(b[jj], 0.f); x[jj] = t * t; y[jj] = w * w; }
                st8(out + (size_t)row * 4096 + col, x, y);
            }
    return false; } };

template <class Sched, class Epi>
DI void gemm_main(LAS unsigned char* lds, int pitch, const Sched& S, const Epi& E) {
    const int tid = otid(), wid = __builtin_amdgcn_readfirstlane(tid >> 6), lane = tid & 63, wr = wid >> 2, wc = wid & 3, fr = lane & 15, fq = lane >> 4;
    unsigned voff[2], voffB[2];
#pragma unroll
    for (int i = 0; i < 2; ++i) { int R, C; stage_rc(tid * 16 + i * 8192, R, C); voff[i] = (unsigned)(R * pitch + C) * 2u;
        const int Rb = (R & ~31) + perm32(R & 31); voffB[i] = (unsigned)(Rb * pitch + C) * 2u; }
    const size_t kstep = (size_t)(BK * 2);
    const size_t hstep = (size_t)HALF * pitch * 2;
    const unsigned ldsw = (unsigned)wid * 1024u;
    const int aoff = lds_byte(wr * 64 + fr, fq * 8), boff = lds_byte(wc * 32 + fr, fq * 8);
#define G_SA(b, h) (((b) * 2 + (h)) * HTB)
#define G_SB(b, h) ((4 + (b) * 2 + (h)) * HTB)
#define G_STAGEV(bufoff, gbase, VO) do { _Pragma("unroll") for (int _i = 0; _i < 2; ++_i) \
        __builtin_amdgcn_global_load_lds((const unsigned*)((const char*)(gbase) + VO[_i]), (LAS unsigned*)(lds + (bufoff) + ldsw + _i * 8192), 16, 0, 0); } while (0)
#define G_STAGE(bufoff, gbase) G_STAGEV(bufoff, gbase, voff)
#define G_STAGEB(bufoff, gbase) G_STAGEV(bufoff, gbase, voffB)
#define G_LDA(dst, b, h) do { _Pragma("unroll") for (int m = 0; m < 4; ++m) _Pragma("unroll") for (int k = 0; k < 2; ++k) dst[m][k] = *(const LAS bf16x8*)(lds + G_SA(b, h) + aoff + m * 2048 + k * 1024); } while (0)
#define G_LDB(dst, b, h) do { _Pragma("unroll") for (int n = 0; n < 2; ++n) _Pragma("unroll") for (int k = 0; k < 2; ++k) dst[n][k] = *(const LAS bf16x8*)(lds + G_SB(b, h) + boff + n * 2048 + k * 1024); } while (0)
#define G_MMA(ai, bj, At, Bt) do { __builtin_amdgcn_s_setprio(1); _Pragma("unroll") for (int m = 0; m < 4; ++m) _Pragma("unroll") for (int n = 0; n < 2; ++n) _Pragma("unroll") for (int k = 0; k < 2; ++k) \
        acc[ai][bj][m][n] = __builtin_amdgcn_mfma_f32_16x16x32_bf16(Bt[n][k], At[m][k], acc[ai][bj][m][n], 0, 0, 0); __builtin_amdgcn_s_setprio(0); } while (0)
#define G_WAIT_V(n) asm volatile("s_waitcnt vmcnt(" #n ")" ::: "memory")
#define G_WAIT_L(n) asm volatile("s_waitcnt lgkmcnt(" #n ")" ::: "memory")
#define G_BAR __builtin_amdgcn_s_barrier()
#define G_SCHED __builtin_amdgcn_sched_barrier(0)
    Unit cur, nxt; int ui = 0;
    if (!S.next(0, cur)) return;
    f32x4 acc[2][2][4][2];
#pragma unroll
    for (int a = 0; a < 2; ++a)
#pragma unroll
        for (int b = 0; b < 2; ++b)
#pragma unroll
            for (int m = 0; m < 4; ++m)
#pragma unroll
                for (int n = 0; n < 2; ++n) acc[a][b][m][n] = (f32x4){0.f, 0.f, 0.f, 0.f};
    bf16x8 At[4][2], B0[2][2], B1[2][2];
    const char* cA = cur.A; const char* cB = cur.B;
    G_STAGEB(G_SB(0, 0), cB); G_STAGE(G_SA(0, 0), cA); G_STAGEB(G_SB(0, 1), cB + hstep); G_STAGE(G_SA(0, 1), cA + hstep);
    if (wr == 1) G_BAR;
    G_WAIT_V(4); G_BAR;
    G_STAGEB(G_SB(1, 0), cB + kstep); G_STAGE(G_SA(1, 0), cA + kstep); G_STAGEB(G_SB(1, 1), cB + hstep + kstep);
    G_WAIT_V(6); G_BAR;
    for (;;) {
        const bool has_next = S.next(ui + 1, nxt);
        const char* nA = has_next ? nxt.A : cA; const char* nB = has_next ? nxt.B : cB;
        const int nt = cur.nt;
        for (int t = 0; t < nt; t += 2) {
            const bool last = (t == nt - 2);
            const char* a1 = cA + (size_t)(t + 1) * kstep;
            const char* a2 = last ? nA : cA + (size_t)(t + 2) * kstep; const char* b2 = last ? nB : cB + (size_t)(t + 2) * kstep;
            const char* a3 = a2 + kstep; const char* b3 = b2 + kstep;
            G_LDB(B0, 0, 0); G_SCHED; G_LDA(At, 0, 0); G_STAGE(G_SA(1, 1), a1 + hstep);
            G_WAIT_L(8); G_BAR; G_WAIT_L(0); G_MMA(0, 0, At, B0); G_BAR; G_SCHED;
            G_LDB(B1, 0, 1); G_STAGEB(G_SB(0, 0), b2);
            G_BAR; G_WAIT_L(0); G_MMA(0, 1, At, B1); G_BAR;
            G_LDA(At, 0, 1); G_STAGE(G_SA(0, 0), a2);
            G_BAR; G_WAIT_L(0); G_MMA(1, 0, At, B0); G_BAR; G_SCHED;
            G_STAGEB(G_SB(0, 1), b2 + hstep);
            G_WAIT_V(6); G_BAR; G_MMA(1, 1, At, B1); G_BAR;
            G_LDB(B0, 1, 0); G_SCHED; G_LDA(At, 1, 0); G_STAGE(G_SA(0, 1), a2 + hstep);
            G_WAIT_L(8); G_BAR; G_WAIT_L(0); G_MMA(0, 0, At, B0); G_BAR; G_SCHED;
            G_LDB(B1, 1, 1); G_STAGEB(G_SB(1, 0), b3);
            G_BAR; G_WAIT_L(0); G_MMA(0, 1, At, B1); G_BAR;
            G_LDA(At, 1, 1); G_STAGE(G_SA(1, 0), a3);
            G_BAR; G_WAIT_L(0); G_MMA(1, 0, At, B0); G_BAR; G_SCHED;
            G_STAGEB(G_SB(1, 1), b3 + hstep);
            G_WAIT_V(6); G_BAR; G_MMA(1, 1, At, B1); G_BAR;
        }
        const bool keep = E.run(acc, cur, wr, wc, fr, fq);
        if (!has_next) break;
        if (!keep) {
#pragma unroll
            for (int a = 0; a < 2; ++a)
#pragma unroll
                for (int b = 0; b < 2; ++b)
#pragma unroll
                    for (int m = 0; m < 4; ++m)
#pragma unroll
                        for (int n = 0; n < 2; ++n) acc[a][b][m][n] = (f32x4){0.f, 0.f, 0.f, 0.f};
        }
        cur = nxt; cA = nA; cB = nB; ++ui;
    }
    G_WAIT_V(0);
    if (wr == 0) G_BAR;
    G_BAR;
#undef G_SA
#undef G_SB
#undef G_STAGE
#undef G_STAGEV
#undef G_STAGEB
#undef G_LDA
#undef G_LDB
#undef G_MMA
}

#define SB() __builtin_amdgcn_sched_barrier(0)
template <class Epi>
DI void gemm_tail(LAS unsigned char* lds, const bf16_t* A, const bf16_t* Bt, int pitch, int K, int N, const Epi& epi) {
    const int tid = otid(), wid = __builtin_amdgcn_readfirstlane(tid >> 6), lane = tid & 63, fr = lane & 15, fq = lane >> 4;
    LAS f32x4* red = (LAS f32x4*)lds;
    const int nitems = 8 * (N >> 6);
    const int kslice = K >> 3;
    for (int it = blockIdx.x; it < nitems; it += gridDim.x) {
        const int rt = it & 7, cg = it >> 3;
        const bf16_t* ap = A + (size_t)(RX + rt * 16 + fr) * pitch + fq * 8 + wid * kslice;
        const bf16_t* bp = Bt + (size_t)(cg * 64 + fr) * pitch + fq * 8 + wid * kslice;
        f32x4 acc[4];
#pragma unroll
        for (int cf = 0; cf < 4; ++cf) acc[cf] = (f32x4){0.f, 0.f, 0.f, 0.f};
        for (int k0 = 0; k0 < kslice; k0 += 128) {
            bf16x8 av[4], bv[4][4];
#pragma unroll
            for (int s4 = 0; s4 < 4; ++s4) { av[s4] = ld8(ap + k0 + s4 * 32);
#pragma unroll
                for (int cf = 0; cf < 4; ++cf) bv[s4][cf] = ld8(bp + (size_t)cf * 16 * pitch + k0 + s4 * 32); }
            SB();
#pragma unroll
            for (int s4 = 0; s4 < 4; ++s4)
#pragma unroll
                for (int cf = 0; cf < 4; ++cf) acc[cf] = mfma16(bv[s4][cf], av[s4], acc[cf]);
        }
#pragma unroll
        for (int cf = 0; cf < 4; ++cf) red[(wid * 4 + cf) * 64 + lane] = acc[cf];
        __syncthreads();
        if (wid < 4) {
            f32x4 v = red[(0 * 4 + wid) * 64 + lane];
#pragma unroll
            for (int w = 1; w < 8; ++w) v += red[(w * 4 + wid) * 64 + lane];
            epi(RX + rt * 16 + fr, cg * 64 + wid * 16 + fq * 4, v);
        }
        __syncthreads();
    }
}
DI void gemm_tail_gate(LAS unsigned char* lds, const bf16_t* A, const bf16_t* Bt, const bf16_t* gr, const bf16_t* ga, bf16_t* z) {
    const int tid = otid(), wid = __builtin_amdgcn_readfirstlane(tid >> 6), lane = tid & 63, fr = lane & 15, fq = lane >> 4;
    LAS f32x4* red = (LAS f32x4*)lds;
    for (int it = blockIdx.x; it < 128; it += gridDim.x) {
        const int rt = it & 7, cg = it >> 3;
        const bf16_t* ap = A + (size_t)(RX + rt * 16 + fr) * 1536 + fq * 8;
        const bf16_t* bp = Bt + (size_t)(cg * 64 + fr) * 1536 + fq * 8;
        bf16x8 av[6], bv[6][4];
#pragma unroll
        for (int s6 = 0; s6 < 6; ++s6) { const int ko = s6 < 4 ? wid * 128 + s6 * 32 : 1024 + wid * 64 + (s6 - 4) * 32; av[s6] = ld8(ap + ko);
#pragma unroll
            for (int cf = 0; cf < 4; ++cf) bv[s6][cf] = ld8(bp + (size_t)cf * 16 * 1536 + ko); }
        SB();
        f32x4 a0[4], a1[4];
#pragma unroll
        for (int cf = 0; cf < 4; ++cf) { a0[cf] = (f32x4){0.f, 0.f, 0.f, 0.f}; a1[cf] = (f32x4){0.f, 0.f, 0.f, 0.f}; }
#pragma unroll
        for (int s6 = 0; s6 < 6; ++s6)
#pragma unroll
            for (int cf = 0; cf < 4; ++cf) { if (s6 < 4) a0[cf] = mfma16(bv[s6][cf], av[s6], a0[cf]); else a1[cf] = mfma16(bv[s6][cf], av[s6], a1[cf]); }
#pragma unroll
        for (int cf = 0; cf < 4; ++cf) { red[(wid * 4 + cf) * 64 + lane] = a0[cf]; red[2048 + (wid * 4 + cf) * 64 + lane] = a1[cf]; }
        __syncthreads();
        if (wid < 4) {
            f32x4 v0 = red[(0 * 4 + wid) * 64 + lane], v1 = red[2048 + (0 * 4 + wid) * 64 + lane];
#pragma unroll
            for (int w = 1; w < 8; ++w) { v0 += red[(w * 4 + wid) * 64 + lane]; v1 += red[2048 + (w * 4 + wid) * 64 + lane]; }
            const int row = RX + rt * 16 + fr, col = cg * 64 + wid * 16 + fq * 4;
            const f32x4 sr = ld4(gr + (size_t)row * 1024 + col), sa = ld4(ga + (size_t)row * 1024 + col);
            st4(z + (size_t)row * 1024 + col, sr * v0 + sa * v1);
        }
        __syncthreads();
    }
}

struct Mix {
    const bf16_t *q_r, *k_r, *kdF, *kdB, *v_rT, *g_r, *q_a, *k_a, *v_aT;
    bf16_t* states; bf16_t* ycat; const float* rd; const float* sink;
};

DI bf16x8 ldsr8(const LAS unsigned char* p) { return *(const LAS bf16x8*)p; }
DI bf16x4 ldsr4(const LAS unsigned char* p) { return *(const LAS bf16x4*)p; }
DI bf16x8 pack8i(f32x4 a, f32x4 b) { u32x4 w; w.x = pk2(a[0], b[0]); w.y = pk2(a[1], b[1]); w.z = pk2(a[2], b[2]); w.w = pk2(a[3], b[3]); return __builtin_bit_cast(bf16x8, w); }

constexpr int ATT_KP = 208, ATT_VP = 800, ATT_VOFF = 400 * ATT_KP;
struct AttPre { bf16x8 k[7]; bf16x8 v[7]; };
template <bool DOK, bool DOV> DI void attn_prefetch(AttPre& R, const Mix& M, int t, int tid) {
    asm volatile("" : "+v"(tid));
    const int b = t & 7, qb = (t >> 3) & 15, g = t >> 7, s0 = qb * 128;
    if (DOK) {
#pragma unroll
    for (int i = 0; i < 7; ++i) {
        const int c = tid + 512 * i;
        if (c < 3200) {
            const int lk = c >> 3, c16 = c & 7;
            int row;
            if (lk < 384) { int sk = s0 - 128 + lk; sk = sk < 0 ? 0 : (sk > 2047 ? 2047 : sk); row = b * 2048 + sk; } else row = RX + b * 16 + (lk - 384);
            R.k[i] = ld8(M.k_a + (size_t)row * 128 + g * 64 + c16 * 8);
        }
    }
    }
    if (DOV) {
#pragma unroll
    for (int i = 0; i < 7; ++i) {
        const int c = tid + 512 * i;
        if (c < 3200) {
            const int e = c / 50, c16 = c - e * 50;
            int pp = (c16 < 48) ? (s0 + c16 * 8) : (112 + (c16 - 48) * 8);
            pp = pp > LP - 8 ? LP - 8 : pp;
            R.v[i] = ld8(M.v_aT + ((size_t)(b * 2 + g) * 64 + e) * LP + pp);
        }
    }
    }
}
DI void attn_commit(const AttPre& R, LAS unsigned char* lds, int tid) {
    asm volatile("" : "+v"(tid));
#pragma unroll
    for (int i = 0; i < 7; ++i) { const int c = tid + 512 * i; if (c < 3200) *(LAS bf16x8*)(lds + (c >> 3) * ATT_KP + (c & 7) * 16) = R.k[i]; }
#pragma unroll
    for (int i = 0; i < 7; ++i) { const int c = tid + 512 * i; if (c < 3200) { const int e = c / 50, c16 = c - e * 50; *(LAS bf16x8*)(lds + ATT_VOFF + e * ATT_VP + c16 * 16) = R.v[i]; } }
}
template <class Hook> DI void attn_wave(const Mix& M, const LAS unsigned char* lds, int b, int hq, int s0, int w, bf16x8 q0, bf16x8 q1, int lane, const Hook& hook) {
    asm volatile("" : "+v"(lane));
    const int fr = lane & 15, fq = lane >> 4;
    const int s = s0 + 16 * w + fr;
    const int rowq = (w >= 0) ? (b * 2048 + s) : (RX + b * 16 + fr);
    const int blk_lo = (w >= 0) ? (w >> 1) : 0;
    const LAS unsigned char* kb = lds + (32 * blk_lo + (fr >> 2) * 8 + 2 * (fr & 3)) * ATT_KP + fq * 16;
    f32x4 sa[9], sb[9], sm;
#pragma unroll
    for (int i0 = 0; i0 < 9; i0 += 3) {
        bf16x8 ka[3][2], kc[3][2];
#pragma unroll
        for (int u = 0; u < 3; ++u) {
            const int i = i0 + u;
            ka[u][0] = ldsr8(kb + i * 32 * ATT_KP); ka[u][1] = ldsr8(kb + i * 32 * ATT_KP + 64);
            kc[u][0] = ldsr8(kb + i * 32 * ATT_KP + ATT_KP); kc[u][1] = ldsr8(kb + i * 32 * ATT_KP + ATT_KP + 64);
        }
        SB();
#pragma unroll
        for (int u = 0; u < 3; ++u) {
            f32x4 a = {0.f, 0.f, 0.f, 0.f}, c = {0.f, 0.f, 0.f, 0.f};
            a = mfma16(ka[u][0], q0, a); a = mfma16(ka[u][1], q1, a);
            c = mfma16(kc[u][0], q0, c); c = mfma16(kc[u][1], q1, c);
            sa[i0 + u] = a; sb[i0 + u] = c;
        }
        SB();
    }
    {
        const LAS unsigned char* km = lds + (384 + fr) * ATT_KP + fq * 16;
        const bf16x8 k0 = ldsr8(km), k1 = ldsr8(km + 64);
        f32x4 a = {0.f, 0.f, 0.f, 0.f};
        a = mfma16(k0, q0, a); a = mfma16(k1, q1, a); sm = a;
    }
    const float sink = M.sink[hq];
    float mx = sink;
#pragma unroll
    for (int i = 0; i < 9; ++i)
#pragma unroll
        for (int jj = 0; jj < 4; ++jj) {
            const int ska = s0 - 128 + 32 * (blk_lo + i) + fq * 8 + 2 * jj; const int da = s - ska;
            const bool oka = (ska >= 0) && (ska < 2048) && (da <= 128) && (da >= -128);
            const bool okb = (ska + 1 >= 0) && (ska + 1 < 2048) && (da - 1 <= 128) && (da - 1 >= -128);
            const float va = oka ? sa[i][jj] : -1e30f, vb = okb ? sb[i][jj] : -1e30f;
            sa[i][jj] = va; sb[i][jj] = vb; mx = fmaxf(mx, fmaxf(va, vb));
        }
#pragma unroll
    for (int jj = 0; jj < 4; ++jj) mx = fmaxf(mx, sm[jj]);
    mx = fmaxf(mx, __shfl_xor(mx, 16)); mx = fmaxf(mx, __shfl_xor(mx, 32));
    float sum = 0.f;
    bf16x8 py[9], pym;
#pragma unroll
    for (int i = 0; i < 9; ++i) {
#pragma unroll
        for (int jj = 0; jj < 4; ++jj) { const float p0 = __expf(sa[i][jj] - mx), p1 = __expf(sb[i][jj] - mx); sa[i][jj] = p0; sb[i][jj] = p1; sum += p0 + p1; }
        py[i] = pack8i(sa[i], sb[i]);
    }
    {
#pragma unroll
        for (int jj = 0; jj < 4; ++jj) { const float p0 = __expf(sm[jj] - mx); sm[jj] = p0; sum += p0; }
        pym = pack8(sm, (f32x4){0.f, 0.f, 0.f, 0.f});
    }
    sum += __shfl_xor(sum, 16); sum += __shfl_xor(sum, 32);
    sum += __expf(sink - mx);
    SB(); hook(); SB();
    f32x4 o[4];
#pragma unroll
    for (int ef = 0; ef < 4; ++ef) o[ef] = (f32x4){0.f, 0.f, 0.f, 0.f};
    const LAS unsigned char* vb = lds + ATT_VOFF + fr * ATT_VP + (32 * blk_lo + fq * 8) * 2;
#pragma unroll
    for (int i0 = 0; i0 < 9; i0 += 3) {
        bf16x8 vx[3][4];
#pragma unroll
        for (int u = 0; u < 3; ++u)
#pragma unroll
            for (int ef = 0; ef < 4; ++ef) vx[u][ef] = ldsr8(vb + ef * 16 * ATT_VP + (i0 + u) * 64);
        SB();
#pragma unroll
        for (int u = 0; u < 3; ++u)
#pragma unroll
            for (int ef = 0; ef < 4; ++ef) o[ef] = mfma16(vx[u][ef], py[i0 + u], o[ef]);
        SB();
    }
    {
        const LAS unsigned char* vm = lds + ATT_VOFF + fr * ATT_VP + (384 + fq * 4) * 2;
        const bf16x4 z4 = {0, 0, 0, 0};
#pragma unroll
        for (int ef = 0; ef < 4; ++ef) o[ef] = mfma16(cat8(ldsr4(vm + ef * 16 * ATT_VP), z4), pym, o[ef]);
    }
    const float inv = 1.0f / sum;
#pragma unroll
    for (int ef = 0; ef < 4; ef += 2) st_pair16(M.ycat + (size_t)rowq * 1536 + 1024 + hq * 64 + ef * 16, o[ef] * inv, o[ef + 1] * inv, fq);
}
DI void attn_phase(const Mix& M, LAS unsigned char* lds, int first, int step, int count) {
    const int tid = otid(), wid = __builtin_amdgcn_readfirstlane(tid >> 6), lane = tid & 63, fr = lane & 15, fq = lane >> 4;
    AttPre R;
    if (count > 0) attn_prefetch<true, true>(R, M, first, tid);
    for (int k = 0; k < count; ++k) {
        const int t = first + k * step;
        const int b = t & 7, qb = (t >> 3) & 15, g = t >> 7;
        const int rowq = b * 2048 + qb * 128 + 16 * wid + fr;
        bf16x8 q[4][2];
#pragma unroll
        for (int hh = 0; hh < 4; ++hh) { q[hh][0] = ld8(M.q_a + (size_t)rowq * 512 + (g * 4 + hh) * 64 + fq * 8); q[hh][1] = ld8(M.q_a + (size_t)rowq * 512 + (g * 4 + hh) * 64 + 32 + fq * 8); }
        __syncthreads();
        attn_commit(R, lds, tid);
        __syncthreads();
        const bool more = (k + 1 < count);
        if (more) attn_prefetch<true, true>(R, M, t + step, tid);
#pragma unroll
        for (int hh = 0; hh < 4; ++hh) attn_wave(M, lds, b, g * 4 + hh, qb * 128, wid, q[hh][0], q[hh][1], lane, [] {});
        if (qb == 0 && wid < 4) {
            const int rowm = RX + b * 16 + fr; const int hq = g * 4 + wid;
            const bf16x8 m0 = ld8(M.q_a + (size_t)rowm * 512 + hq * 64 + fq * 8), m1 = ld8(M.q_a + (size_t)rowm * 512 + hq * 64 + 32 + fq * 8);
            attn_wave(M, lds, b, hq, 0, -1, m0, m1, lane, [] {});
        }
    }
    __syncthreads();
}

constexpr int SC_P = 288, SC_KB = 64 * SC_P, SC_BUF = SC_KB + 64 * SC_P;
static_assert(2 * SC_BUF <= LDS_MAIN, "lds");
struct ScanPre { bf16x8 k[2]; bf16x8 v[2]; };
DI void scan_prefetch(ScanPre& R, const bf16_t* kd, const bf16_t* vt, int n, int tid) {
    asm volatile("" : "+v"(tid));
#pragma unroll
    for (int i = 0; i < 2; ++i) { const int c = tid + 512 * i; R.k[i] = ld8(kd + (size_t)(c >> 4) * LP + 128 * n + (c & 15) * 8); R.v[i] = ld8(vt + (size_t)(c >> 4) * LP + 128 * n + (c & 15) * 8); }
}
DI void scan_commit(const ScanPre& R, LAS unsigned char* buf, int tid) {
    asm volatile("" : "+v"(tid));
#pragma unroll
    for (int i = 0; i < 2; ++i) { const int c = tid + 512 * i; *(LAS bf16x8*)(buf + (c >> 4) * SC_P + (c & 15) * 16) = R.k[i]; *(LAS bf16x8*)(buf + SC_KB + (c >> 4) * SC_P + (c & 15) * 16) = R.v[i]; }
}
DI void scan_block(const Mix& M, LAS unsigned char* lds, int item) {
    const int tid = otid(), wid = __builtin_amdgcn_readfirstlane(tid >> 6), lane = tid & 63, fr = lane & 15, fq = lane >> 4;
    const int xq = item & 7, yq = item >> 3;
    const int eh = yq & 1, dir = (yq >> 1) & 1, bh = (yq >> 2) * 8 + xq, h = bh & 7;
    const int efl = wid & 3, dh = wid >> 2;
    const bf16_t* kd = (dir ? M.kdB : M.kdF) + (size_t)bh * 64 * LP;
    const bf16_t* vt = M.v_rT + ((size_t)bh * 128 + eh * 64) * LP;
    const float lg = -__expf(M.rd[dir * 8 + h]); const float gC = __expf(lg * 128.0f);
    bf16_t* sbase = M.states + (((size_t)bh * NCH) * 2 + dir) * 128 * 64 + (size_t)(eh * 64 + efl * 16 + fr) * 64 + dh * 32 + fq * 4;
    f32x4 acc[2];
#pragma unroll
    for (int df = 0; df < 2; ++df) acc[df] = (f32x4){0.f, 0.f, 0.f, 0.f};
    ScanPre ring[4];
#pragma unroll
    for (int s0 = 0; s0 < 4; ++s0) scan_prefetch(ring[s0], kd, vt, dir ? (16 - s0) : s0, tid);
    __syncthreads();
#pragma unroll
    for (int s = 0; s < 16; ++s) {
        LAS unsigned char* buf = lds + (s & 1) * SC_BUF;
        scan_commit(ring[s & 3], buf, tid);
        if (s + 4 < 16) scan_prefetch(ring[s & 3], kd, vt, dir ? (16 - (s + 4)) : (s + 4), tid);
        __syncthreads();
        const int n = dir ? (16 - s) : s;
        bf16_t* sp = sbase + (size_t)n * 2 * 128 * 64;
        st_pair16(sp - fq * 4, acc[0], acc[1], fq);
#pragma unroll
        for (int df = 0; df < 2; ++df) acc[df] *= gC;
        const LAS unsigned char* kp = buf + (dh * 32 + fr) * SC_P + fq * 16;
        const LAS unsigned char* vp = buf + SC_KB + (efl * 16 + fr) * SC_P + fq * 16;
        bf16x8 vy[4], kx[4][2];
#pragma unroll
        for (int ks = 0; ks < 4; ++ks) { vy[ks] = ldsr8(vp + ks * 64);
#pragma unroll
            for (int df = 0; df < 2; ++df) kx[ks][df] = ldsr8(kp + df * 16 * SC_P + ks * 64); }
        SB();
#pragma unroll
        for (int ks = 0; ks < 4; ++ks)
#pragma unroll
            for (int df = 0; df < 2; ++df) acc[df] = mfma16(kx[ks][df], vy[ks], acc[df]);
        SB();
    }
    {
        bf16_t* sp = sbase + (size_t)(dir ? 0 : 16) * 2 * 128 * 64;
        st_pair16(sp - fq * 4, acc[0], acc[1], fq);
    }
    __syncthreads();
}

DI void ret_item(const Mix& M, int b, int h, int n, int iq) {
    const int lane = otid() & 63, fr = lane & 15, fq = lane >> 4;
    const int i = 16 * iq + fr;
    const int rowq = n ? (b * 2048 + (n - 1) * 128 + i) : (RX + b * 16 + (i - 112));
    bf16x8 qy[2];
#pragma unroll
    for (int ks = 0; ks < 2; ++ks) qy[ks] = ld8(M.q_r + (size_t)rowq * 512 + h * 64 + ks * 32 + fq * 8);
    const float lgf = -__expf(M.rd[h]), lgb = -__expf(M.rd[8 + h]);
    const float cf = __expf(lgf * (float)(i + 1)), cb = __expf(lgb * (float)(128 - i));
    const bf16_t* SF = M.states + (((size_t)(b * 8 + h) * NCH + n) * 2 + 0) * 128 * 64 + (size_t)fr * 64 + fq * 8;
    const bf16_t* SBk = SF + 128 * 64;
    const bf16_t* vbase = M.v_rT + ((size_t)(b * 8 + h) * 128 + fr) * LP + 128 * n + fq * 4;
    bf16x8 sfx[8][2], kx[8][2];
#pragma unroll
    for (int ef = 0; ef < 8; ++ef)
#pragma unroll
        for (int ks = 0; ks < 2; ++ks) sfx[ef][ks] = ld8(SF + (size_t)ef * 16 * 64 + ks * 32);
#pragma unroll
    for (int jf = 0; jf < 8; ++jf) {
        const int j = 16 * jf + fr;
        int jm = j - 112; jm = jm < 0 ? 0 : jm;
        const int rowk = n ? (b * 2048 + (n - 1) * 128 + j) : (RX + b * 16 + jm);
        const bf16_t* kp = M.k_r + (size_t)rowk * 512 + h * 64 + fq * 8;
        kx[jf][0] = ld8(kp); kx[jf][1] = ld8(kp + 32);
    }
    SB();
    f32x4 o[8];
#pragma unroll
    for (int ef = 0; ef < 8; ++ef) {
        f32x4 t = {0.f, 0.f, 0.f, 0.f};
        t = mfma16(sfx[ef][0], qy[0], t); t = mfma16(sfx[ef][1], qy[1], t);
        o[ef] = t * cf;
    }
    f32x4 st[8];
#pragma unroll
    for (int jf = 0; jf < 8; ++jf) {
        f32x4 t = {0.f, 0.f, 0.f, 0.f};
        t = mfma16(kx[jf][0], qy[0], t); t = mfma16(kx[jf][1], qy[1], t);
        st[jf] = t;
    }
    SB();
    bf16x8 sbx[8][2];
#pragma unroll
    for (int ef = 0; ef < 8; ++ef)
#pragma unroll
        for (int ks = 0; ks < 2; ++ks) sbx[ef][ks] = ld8(SBk + (size_t)ef * 16 * 64 + ks * 32);
    bf16x4 va[2][8][2];
#pragma unroll
    for (int pr = 0; pr < 2; ++pr)
#pragma unroll
        for (int ef = 0; ef < 8; ++ef) { va[pr][ef][0] = ld4s(vbase + (size_t)ef * 16 * LP + 32 * pr); va[pr][ef][1] = ld4s(vbase + (size_t)ef * 16 * LP + 32 * pr + 16); }
    SB();
#pragma unroll
    for (int ef = 0; ef < 8; ++ef) {
        f32x4 t = {0.f, 0.f, 0.f, 0.f};
        t = mfma16(sbx[ef][0], qy[0], t); t = mfma16(sbx[ef][1], qy[1], t);
        o[ef] += t * cb;
    }
    bf16x8 py[4];
#pragma unroll
    for (int pr = 0; pr < 4; ++pr) {
#pragma unroll
        for (int hh = 0; hh < 2; ++hh) {
            const int jf = 2 * pr + hh;
#pragma unroll
            for (int jj = 0; jj < 4; ++jj) {
                const int jv = 16 * jf + fq * 4 + jj; const int d = i - jv;
                float w = (d >= 0) ? __expf(lgf * (float)d) : __expf(lgb * (float)(-d));
                if (n == 0 && jv < 112) w = 0.f;
                st[jf][jj] *= w;
            }
        }
        py[pr] = pack8(st[2 * pr], st[2 * pr + 1]);
    }
    SB();
    bf16x4 vb[2][8][2];
#pragma unroll
    for (int pr = 0; pr < 2; ++pr)
#pragma unroll
        for (int ef = 0; ef < 8; ++ef) { vb[pr][ef][0] = ld4s(vbase + (size_t)ef * 16 * LP + 32 * (pr + 2)); vb[pr][ef][1] = ld4s(vbase + (size_t)ef * 16 * LP + 32 * (pr + 2) + 16); }
    u32x2 gx[8];
#pragma unroll
    for (int ef = 0; ef < 8; ++ef) gx[ef] = *(const u32x2*)(M.g_r + (size_t)rowq * 1024 + h * 128 + ef * 16 + fq * 4);
    SB();
#pragma unroll
    for (int pr = 0; pr < 2; ++pr)
#pragma unroll
        for (int ef = 0; ef < 8; ++ef) o[ef] = mfma16(cat8(va[pr][ef][0], va[pr][ef][1]), py[pr], o[ef]);
#pragma unroll
    for (int pr = 0; pr < 2; ++pr)
#pragma unroll
        for (int ef = 0; ef < 8; ++ef) o[ef] = mfma16(cat8(vb[pr][ef][0], vb[pr][ef][1]), py[pr + 2], o[ef]);
    float s = 0.f;
#pragma unroll
    for (int ef = 0; ef < 8; ++ef) s += (o[ef][0] + o[ef][1]) + (o[ef][2] + o[ef][3]);
    s += __shfl_xor(s, 16); s += __shfl_xor(s, 32);
    const float mean = s * (1.0f / 128.0f);
    float q = 0.f;
#pragma unroll
    for (int ef = 0; ef < 8; ++ef) { const f32x4 d = o[ef] - mean; q += (d[0] * d[0] + d[1] * d[1]) + (d[2] * d[2] + d[3] * d[3]); }
    q += __shfl_xor(q, 16); q += __shfl_xor(q, 32);
    const float rstd = rsqrtf(q * (1.0f / 128.0f) + EPS);
#pragma unroll
    for (int ef = 0; ef < 8; ++ef) {
        f32x4 gv; gv[0] = __uint_as_float(gx[ef].x << 16); gv[1] = __uint_as_float(gx[ef].x & 0xffff0000u); gv[2] = __uint_as_float(gx[ef].y << 16); gv[3] = __uint_as_float(gx[ef].y & 0xffff0000u);
        st4(M.ycat + (size_t)rowq * 1536 + h * 128 + ef * 16 + fq * 4, (o[ef] - mean) * rstd * gv);
    }
}

constexpr int RET_KP = 208, RET_SP = 160, RET_VP = 288;
constexpr int RET_SFOFF = 128 * RET_KP, RET_SBOFF = RET_SFOFF + 128 * RET_SP, RET_VOFF = RET_SBOFF + 128 * RET_SP;
static_assert(RET_VOFF + 128 * RET_VP <= LDS_MAIN, "lds");
struct RetPre { bf16x8 k[2], sf[2], sb[2], v[4], q[2]; };
DI void ret_prefetch(RetPre& R, const Mix& M, int t, int tid) {
    asm volatile("" : "+v"(tid));
    const int n = (t & 15) + 1, bh = t >> 4, b = bh >> 3, h = bh & 7;
    const int wid = tid >> 6, lane = tid & 63, fr = lane & 15, fq = lane >> 4;
    const bf16_t* SF = M.states + (((size_t)bh * NCH + n) * 2 + 0) * 128 * 64;
#pragma unroll
    for (int i = 0; i < 2; ++i) {
        const int c = tid + 512 * i;
        R.k[i] = ld8(M.k_r + (size_t)(b * 2048 + (n - 1) * 128 + (c >> 3)) * 512 + h * 64 + (c & 7) * 8);
        R.sf[i] = ld8(SF + (size_t)c * 8); R.sb[i] = ld8(SF + 128 * 64 + (size_t)c * 8);
    }
#pragma unroll
    for (int i = 0; i < 4; ++i) { const int c = tid + 512 * i; R.v[i] = ld8(M.v_rT + ((size_t)bh * 128 + (c >> 4)) * LP + 128 * n + (c & 15) * 8); }
    const int rowq = b * 2048 + (n - 1) * 128 + 16 * wid + fr;
    R.q[0] = ld8(M.q_r + (size_t)rowq * 512 + h * 64 + fq * 8); R.q[1] = ld8(M.q_r + (size_t)rowq * 512 + h * 64 + 32 + fq * 8);
}
DI void ret_commit(const RetPre& R, LAS unsigned char* lds, int tid) {
    asm volatile("" : "+v"(tid));
#pragma unroll
    for (int i = 0; i < 2; ++i) {
        const int c = tid + 512 * i;
        *(LAS bf16x8*)(lds + (c >> 3) * RET_KP + (c & 7) * 16) = R.k[i];
        *(LAS bf16x8*)(lds + RET_SFOFF + (c >> 3) * RET_SP + (c & 7) * 16) = R.sf[i];
        *(LAS bf16x8*)(lds + RET_SBOFF + (c >> 3) * RET_SP + (c & 7) * 16) = R.sb[i];
    }
#pragma unroll
    for (int i = 0; i < 4; ++i) { const int c = tid + 512 * i; *(LAS bf16x8*)(lds + RET_VOFF + (c >> 4) * RET_VP + (c & 15) * 16) = R.v[i]; }
}
DI void ret_wave(const Mix& M, const LAS unsigned char* lds, int b, int h, int n, int w, bf16x8 q0, bf16x8 q1, int lane) {
    asm volatile("" : "+v"(lane));
    const int fr = lane & 15, fq = lane >> 4;
    const int i = 16 * w + fr;
    const int rowq = b * 2048 + (n - 1) * 128 + i;
    u32x2 gx[8];
#pragma unroll
    for (int ef = 0; ef < 8; ++ef) gx[ef] = *(const u32x2*)(M.g_r + (size_t)rowq * 1024 + h * 128 + ef * 16 + fq * 4);
    const float lgf = -__expf(M.rd[h]), lgb = -__expf(M.rd[8 + h]);
    const float cf = __expf(lgf * (float)(i + 1)), cb = __expf(lgb * (float)(128 - i));
    f32x4 o[8];
    const LAS unsigned char* sfp = lds + RET_SFOFF + fr * RET_SP + fq * 16;
    const LAS unsigned char* sbp = lds + RET_SBOFF + fr * RET_SP + fq * 16;
#pragma unroll
    for (int e0 = 0; e0 < 8; e0 += 4) {
        bf16x8 xf[4][2], xb[4][2];
#pragma unroll
        for (int u = 0; u < 4; ++u) { const int ef = e0 + u;
            xf[u][0] = ldsr8(sfp + ef * 16 * RET_SP); xf[u][1] = ldsr8(sfp + ef * 16 * RET_SP + 64);
            xb[u][0] = ldsr8(sbp + ef * 16 * RET_SP); xb[u][1] = ldsr8(sbp + ef * 16 * RET_SP + 64); }
        SB();
#pragma unroll
        for (int u = 0; u < 4; ++u) {
            f32x4 t = {0.f, 0.f, 0.f, 0.f}, t2 = {0.f, 0.f, 0.f, 0.f};
            t = mfma16(xf[u][0], q0, t); t = mfma16(xf[u][1], q1, t);
            t2 = mfma16(xb[u][0], q0, t2); t2 = mfma16(xb[u][1], q1, t2);
            o[e0 + u] = t * cf + t2 * cb;
        }
        SB();
    }
    const LAS unsigned char* kb = lds + ((fr >> 2) * 8 + 2 * (fr & 3)) * RET_KP + fq * 16;
    bf16x8 py[4];
    bf16x8 kxa[4][2], kxc[4][2];
#pragma unroll
    for (int blk = 0; blk < 4; ++blk) {
        kxa[blk][0] = ldsr8(kb + blk * 32 * RET_KP); kxa[blk][1] = ldsr8(kb + blk * 32 * RET_KP + 64);
        kxc[blk][0] = ldsr8(kb + blk * 32 * RET_KP + RET_KP); kxc[blk][1] = ldsr8(kb + blk * 32 * RET_KP + RET_KP + 64);
    }
    SB();
#pragma unroll
    for (int blk = 0; blk < 4; ++blk) {
        f32x4 a = {0.f, 0.f, 0.f, 0.f}, c = {0.f, 0.f, 0.f, 0.f};
        a = mfma16(kxa[blk][0], q0, a); a = mfma16(kxa[blk][1], q1, a);
        c = mfma16(kxc[blk][0], q0, c); c = mfma16(kxc[blk][1], q1, c);
#pragma unroll
        for (int jj = 0; jj < 4; ++jj) {
            const int ja = 32 * blk + fq * 8 + 2 * jj; const int da = i - ja, db = da - 1;
            a[jj] *= (da >= 0) ? __expf(lgf * (float)da) : __expf(lgb * (float)(-da));
            c[jj] *= (db >= 0) ? __expf(lgf * (float)db) : __expf(lgb * (float)(-db));
        }
        py[blk] = pack8i(a, c);
    }
    const LAS unsigned char* vp = lds + RET_VOFF + fr * RET_VP + fq * 16;
    SB();
#pragma unroll
    for (int blk = 0; blk < 4; blk += 2) {
        bf16x8 vx[2][8];
#pragma unroll
        for (int u = 0; u < 2; ++u)
#pragma unroll
            for (int ef = 0; ef < 8; ++ef) vx[u][ef] = ldsr8(vp + ef * 16 * RET_VP + (blk + u) * 64);
        SB();
#pragma unroll
        for (int u = 0; u < 2; ++u)
#pragma unroll
            for (int ef = 0; ef < 8; ++ef) o[ef] = mfma16(vx[u][ef], py[blk + u], o[ef]);
        SB();
    }
    float s = 0.f;
#pragma unroll
    for (int ef = 0; ef < 8; ++ef) s += (o[ef][0] + o[ef][1]) + (o[ef][2] + o[ef][3]);
    s += __shfl_xor(s, 16); s += __shfl_xor(s, 32);
    const float mean = s * (1.0f / 128.0f);
    float q = 0.f;
#pragma unroll
    for (int ef = 0; ef < 8; ++ef) { const f32x4 d = o[ef] - mean; q += (d[0] * d[0] + d[1] * d[1]) + (d[2] * d[2] + d[3] * d[3]); }
    q += __shfl_xor(q, 16); q += __shfl_xor(q, 32);
    const float rstd = rsqrtf(q * (1.0f / 128.0f) + EPS);
#pragma unroll
    for (int ef = 0; ef < 8; ef += 2) {
        f32x4 gv, gw;
        gv[0] = __uint_as_float(gx[ef].x << 16); gv[1] = __uint_as_float(gx[ef].x & 0xffff0000u); gv[2] = __uint_as_float(gx[ef].y << 16); gv[3] = __uint_as_float(gx[ef].y & 0xffff0000u);
        gw[0] = __uint_as_float(gx[ef + 1].x << 16); gw[1] = __uint_as_float(gx[ef + 1].x & 0xffff0000u); gw[2] = __uint_as_float(gx[ef + 1].y << 16); gw[3] = __uint_as_float(gx[ef + 1].y & 0xffff0000u);
        st_pair16(M.ycat + (size_t)rowq * 1536 + h * 128 + ef * 16, (o[ef] - mean) * rstd * gv, (o[ef + 1] - mean) * rstd * gw, fq);
    }
}
DI void ret_phase(const Mix& M, LAS unsigned char* lds) {
    const int tid = otid(), wid = __builtin_amdgcn_readfirstlane(tid >> 6), lane = tid & 63;
    const int G = gridDim.x;
    int t = blockIdx.x;
    RetPre R;
    if (t < 1024) ret_prefetch(R, M, t, tid);
    for (; t < 1024; t += G) {
        __syncthreads();
        ret_commit(R, lds, tid);
        const bf16x8 q0 = R.q[0], q1 = R.q[1];
        __syncthreads();
        if (t + G < 1024) ret_prefetch(R, M, t + G, tid);
        const int n = (t & 15) + 1, bh = t >> 4;
        ret_wave(M, lds, bh >> 3, bh & 7, n, wid, q0, q1, lane);
    }
    __syncthreads();
}

DI bf16_t* hrow(const Params& P, int row) { return (bf16_t*)(P.ws + WS_ST) + (size_t)row * 1024; }
template <int NB>
DI void rowpass_rows(const Params& P, const bf16_t* t, const float* gpost, const float* gpre, float* rs, int row0, int rstride, int lane) {
    f32x4 hv[NB][4]; u32x2 tr[NB][4], hr[NB][4];
#pragma unroll
    for (int r = 0; r < NB; ++r) {
        const int row = row0 + r * rstride;
        const bf16_t* hp = hrow(P, row); const bf16_t* tp = t + (size_t)row * 1024;
#pragma unroll
        for (int k = 0; k < 4; ++k) { tr[r][k] = *(const u32x2*)(tp + (k * 64 + lane) * 4); hr[r][k] = *(const u32x2*)(hp + (k * 64 + lane) * 4); }
    }
    f32x4 gp[4];
#pragma unroll
    for (int k = 0; k < 4; ++k) gp[k] = *(const f32x4*)(gpost + (k * 64 + lane) * 4);
    SB();
    float s2[NB];
#pragma unroll
    for (int r = 0; r < NB; ++r) {
        f32x4 tv[4]; float ss = 0.f;
#pragma unroll
        for (int k = 0; k < 4; ++k) {
            tv[k][0] = __uint_as_float(tr[r][k].x << 16); tv[k][1] = __uint_as_float(tr[r][k].x & 0xffff0000u); tv[k][2] = __uint_as_float(tr[r][k].y << 16); tv[k][3] = __uint_as_float(tr[r][k].y & 0xffff0000u);
            hv[r][k][0] = __uint_as_float(hr[r][k].x << 16); hv[r][k][1] = __uint_as_float(hr[r][k].x & 0xffff0000u); hv[r][k][2] = __uint_as_float(hr[r][k].y << 16); hv[r][k][3] = __uint_as_float(hr[r][k].y & 0xffff0000u);
            ss += (tv[k][0] * tv[k][0] + tv[k][1] * tv[k][1]) + (tv[k][2] * tv[k][2] + tv[k][3] * tv[k][3]);
        }
        ss = wsum(ss);
        const float sc = rsqrtf(ss * (1.0f / 1024.0f) + EPS);
        const int row = row0 + r * rstride;
        bf16_t* hp = hrow(P, row);
        float q = 0.f;
#pragma unroll
        for (int k = 0; k < 4; ++k) { hv[r][k] += tv[k] * sc * gp[k];
            if (gpre) st4(hp + (k * 64 + lane) * 4, hv[r][k]); else if (row < RX) *(f32x4*)(P.out + (size_t)row * 1024 + (k * 64 + lane) * 4) = hv[r][k];
            q += (hv[r][k][0] * hv[r][k][0] + hv[r][k][1] * hv[r][k][1]) + (hv[r][k][2] * hv[r][k][2] + hv[r][k][3] * hv[r][k][3]); }
        s2[r] = q;
    }
    if (gpre) {
#pragma unroll
        for (int r = 0; r < NB; ++r) {
            const float sc2 = rsqrtf(wsum(s2[r]) * (1.0f / 1024.0f) + EPS);
            if (lane == 0) rs[row0 + r * rstride] = sc2;
        }
    }
}
DI void rowpass(const Params& P, const bf16_t* t, const float* gpost, const float* gpre, float* u, int gw, int nw) {
    const int lane = otid() & 63;
    for (int base = gw; base < RX; base += nw * 4) {
        if (base + 3 * nw < RX) rowpass_rows<4>(P, t, gpost, gpre, u, base, nw, lane);
        else for (int row = base; row < RX; row += nw) rowpass_rows<1>(P, t, gpost, gpre, u, row, 0, lane);
    }
    for (int row = RX + gw; row < RT; row += nw) rowpass_rows<1>(P, t, gpost, gpre, u, row, 0, lane);
}
DI void rowinit(const Params& P, float* rs, int gw, int nw) {
    const int lane = otid() & 63;
    for (int row = gw; row < RT; row += nw) {
        bf16_t* hp = hrow(P, row);
        const float* src = row < RX ? P.x + (size_t)row * 1024 : P.meta + (size_t)((row - RX) & 15) * 1024;
        f32x4 hv[4]; float s2 = 0.f;
#pragma unroll
        for (int k = 0; k < 4; ++k) hv[k] = *(const f32x4*)(src + (k * 64 + lane) * 4);
        SB();
#pragma unroll
        for (int k = 0; k < 4; ++k) { st4(hp + (k * 64 + lane) * 4, hv[k]);
            s2 += (hv[k][0] * hv[k][0] + hv[k][1] * hv[k][1]) + (hv[k][2] * hv[k][2] + hv[k][3] * hv[k][3]); }
        s2 = wsum(s2);
        if (lane == 0) rs[row] = rsqrtf(s2 * (1.0f / 1024.0f) + EPS);
    }
}

DI int perm64(int mode, int w) { return mode == 1 ? ((w >> 1) + 32 * (w & 1)) : (mode == 2 ? (w < 16 ? ((w >> 1) + 8 * (w & 1)) : w) : w); }
struct ConvJob { const float* W; bf16_t* Bt; const float* gain; int ncols, k0, n0, n0s, ldb, koff, mode; };
DI ConvJob conv_decode(const Params& P, int l, int job) {
    unsigned char* wb = P.ws + WS_W;
    ConvJob J; int j = job; J.gain = nullptr;
    if (j < 1472) { J.gain = P.n_mix_pre + l * 1024; const int nt = j % 92, kt = j / 92; const int c0 = nt * 64;
        J.W = P.w_in + (size_t)l * 1024 * DIN; J.ncols = DIN; J.k0 = kt * 64; J.n0 = c0; J.Bt = (bf16_t*)(wb + W_IN); J.ldb = 1024; J.koff = 0;
        J.n0s = c0; if (c0 >= 3840) { const int w = c0 - 3840; J.n0s = (((w >> 7) & 1) ? 4864 : 3840) + 128 * (w >> 8) + (w & 127); }
        J.mode = c0 < 1024 ? 1 : ((c0 >= 3072 && c0 < 3712) ? 2 : 0); return J; }
    j -= 1472; J.mode = 0; J.koff = 0; J.ncols = 1024;
    if (j < 256) { J.W = P.w_ret_o + (size_t)l * 1024 * 1024; J.k0 = (j >> 4) * 64; J.n0s = J.n0 = (j & 15) * 64; J.Bt = (bf16_t*)(wb + W_CAT); J.ldb = 1536; return J; }
    j -= 256;
    if (j < 128) { J.W = P.w_att_o + (size_t)l * 512 * 1024; J.k0 = (j >> 4) * 64; J.n0s = J.n0 = (j & 15) * 64; J.Bt = (bf16_t*)(wb + W_CAT); J.ldb = 1536; J.koff = 1024; return J; }
    j -= 128;
    if (j < 256) { J.W = P.w_mix_o + (size_t)l * 1024 * 1024; J.k0 = (j >> 4) * 64; J.n0s = J.n0 = (j & 15) * 64; J.Bt = (bf16_t*)(wb + W_MIX); J.ldb = 1024; return J; }
    j -= 256;
    if (j < 1024) { J.gain = P.n_ff_pre + l * 1024; J.W = P.w_ff1 + (size_t)l * 1024 * 4096; J.ncols = 4096; J.k0 = (j >> 6) * 64; J.n0s = J.n0 = (j & 63) * 64; J.Bt = (bf16_t*)(wb + W_FF1); J.ldb = 1024; return J; }
    j -= 1024;
    J.W = P.w_ff2 + (size_t)l * 4096 * 1024; J.k0 = (j >> 4) * 64; J.n0s = J.n0 = (j & 15) * 64; J.Bt = (bf16_t*)(wb + W_FF2); J.ldb = 4096; return J;
}
DI void convert_weights(const Params& P, int l, LAS unsigned char* lds) {
    LAS float* tiles = (LAS float*)lds;
    const int t = otid();
    const int G = gridDim.x;
    for (int base = blockIdx.x; base < 4160; base += 4 * G) {
        ConvJob J[4]; f32x4 v[4][2];
#pragma unroll
        for (int q = 0; q < 4; ++q) {
            const int job = base + q * G;
            if (job < 4160) {
                J[q] = conv_decode(P, l, job);
#pragma unroll
                for (int rep = 0; rep < 2; ++rep) { const int kk = (t >> 4) + 32 * rep, nn = (t & 15) * 4; v[q][rep] = *(const f32x4*)(J[q].W + (size_t)(J[q].k0 + kk) * J[q].ncols + J[q].n0s + nn);
                    if (J[q].gain) v[q][rep] *= J[q].gain[J[q].k0 + kk]; }
            }
        }
        SB();
#pragma unroll
        for (int q = 0; q < 4; ++q) {
            if (base + q * G < 4160) {
                LAS float* tile = tiles + q * 4160;
#pragma unroll
                for (int rep = 0; rep < 2; ++rep) { const int kk = (t >> 4) + 32 * rep, nn = (t & 15) * 4;
                    tile[kk * 65 + nn] = v[q][rep][0]; tile[kk * 65 + nn + 1] = v[q][rep][1]; tile[kk * 65 + nn + 2] = v[q][rep][2]; tile[kk * 65 + nn + 3] = v[q][rep][3]; }
            }
        }
        __syncthreads();
#pragma unroll
        for (int q = 0; q < 4; ++q) {
            if (base + q * G < 4160) {
                const LAS float* tile = tiles + q * 4160;
                const int nq = t >> 3, kk8 = (t & 7) * 8, sc = perm64(J[q].mode, nq);
                u32x4 w;
                w.x = pk2(tile[(kk8 + 0) * 65 + sc], tile[(kk8 + 1) * 65 + sc]); w.y = pk2(tile[(kk8 + 2) * 65 + sc], tile[(kk8 + 3) * 65 + sc]);
                w.z = pk2(tile[(kk8 + 4) * 65 + sc], tile[(kk8 + 5) * 65 + sc]); w.w = pk2(tile[(kk8 + 6) * 65 + sc], tile[(kk8 + 7) * 65 + sc]);
                *(u32x4*)(J[q].Bt + (size_t)(J[q].n0 + nq) * J[q].ldb + J[q].koff + J[q].k0 + kk8) = w;
            }
        }
        __syncthreads();
    }
}

DI void make_tables(const Params& P) {
    float* tabR = (float*)(P.ws + WS_TABR); float* tabA = (float*)(P.ws + WS_TABA);
    const int gt = blockIdx.x * blockDim.x + otid(), nth = gridDim.x * blockDim.x;
    for (int idx = gt; idx < 2064 * 40; idx += nth) {
        int p, i; float fr; float* dst;
        if (idx < 2064 * 32) { p = idx >> 5; i = idx & 31; fr = powf(10000.0f, -(float)(2 * i) / 64.0f); dst = tabR + (size_t)idx * 2; }
        else { const int k = idx - 2064 * 32; p = k >> 3; i = k & 7; fr = powf(500000.0f, -(float)(2 * i) / 16.0f); dst = tabA + (size_t)k * 2; }
        const float ang = (float)p * fr;
        double rev = (double)ang * 0.15915494309189533576888; rev -= floor(rev);
        const float r = (float)(rev * 6.283185307179586476925);
        dst[0] = __cosf(r); dst[1] = __sinf(r);
    }
}
DI void zero_pads(const Params& P) {
    unsigned char* proj = P.ws + WS_PROJ;
    const int gt = blockIdx.x * blockDim.x + otid(), nth = gridDim.x * blockDim.x;
    for (int idx = gt; idx < 17408 * 14; idx += nth) {
        unsigned zz = 0u; asm volatile("" : "+v"(zz)); const u32x4 z = {zz, zz, zz, zz};
        int r = idx / 14; const int c = idx - r * 14;
        bf16_t* base;
        if (r < 4096) base = (bf16_t*)(proj + P_KDF); else if (r < 8192) { base = (bf16_t*)(proj + P_KDB); r -= 4096; }
        else if (r < 16384) { base = (bf16_t*)(proj + P_VRT); r -= 8192; } else { base = (bf16_t*)(proj + P_VAT); r -= 16384; }
        *(u32x4*)(base + (size_t)r * LP + c * 8) = z;
    }
}

#define XB_TMO      128
#define XB_XCNT(j)  (256  + 64 * (j))
#define XB_XSUB(j)  (1280 + 64 * (j))
#define XB_XGEN(j)  (2304 + 64 * (j))
#define XB_TOP      3328
#define XB_TOPGEN   3392
#define XCD_BAR_WORDS 3456
#define XB_SPIN_CAP (1u << 22)
DI unsigned xb_ld(unsigned* p)              { return __hip_atomic_load(p, __ATOMIC_RELAXED, __HIP_MEMORY_SCOPE_AGENT); }
DI unsigned xb_add(unsigned* p, unsigned v) { return __hip_atomic_fetch_add(p, v, __ATOMIC_RELAXED, __HIP_MEMORY_SCOPE_AGENT); }
DI unsigned xb_xcc_id() { return (unsigned)__builtin_amdgcn_s_getreg((3 << 11) | 20) & 0xFu; }
#define XB_SPIN(cond, bar) do { unsigned _sp = 0; while (cond) { __builtin_amdgcn_s_sleep(1); \
    if ((++_sp & 255u) == 0u) { if (xb_ld(&(bar)[XB_TMO])) break; if (_sp > XB_SPIN_CAP) { atomicAdd(&(bar)[XB_TMO], 1u); break; } } } } while (0)
struct XcdBarrier { unsigned* bar; unsigned x; volatile LAS unsigned* st; };
DI XcdBarrier xcd_barrier_post(unsigned* bar, volatile LAS unsigned* st) {
    XcdBarrier b; b.bar = bar; b.x = xb_xcc_id(); b.st = st;
    if (threadIdx.x == 0) (void)xb_add(&bar[XB_XCNT(b.x)], 1u);
    return b;
}
DI void xcd_barrier_complete(unsigned* bar, unsigned x, unsigned& nloc, unsigned& nx) {
    const unsigned G = gridDim.x * gridDim.y * gridDim.z;
    unsigned sum, cnt, mine, sp = 0u;
    for (;;) {
        sum = 0u; cnt = 0u; mine = 0u;
#pragma unroll
        for (unsigned j = 0; j < 16; ++j) { const unsigned c = xb_ld(&bar[XB_XCNT(j)]); sum += c; cnt += (c > 0u) ? 1u : 0u; mine = (j == x) ? c : mine; }
        if (sum == G) break;
        __builtin_amdgcn_s_sleep(1);
        if ((++sp & 255u) == 0u) { if (xb_ld(&bar[XB_TMO])) break; if (sp > XB_SPIN_CAP) { atomicAdd(&bar[XB_TMO], 1u); break; } }
    }
    nloc = mine > 0u ? mine : 1u; nx = cnt > 0u ? cnt : 1u;
}
DI void xcd_barrier(const XcdBarrier& b) {
    asm volatile("s_waitcnt vmcnt(0)" ::: "memory");
    __syncthreads();
    if (threadIdx.x == 0) {
        unsigned* bar = b.bar;
        __builtin_amdgcn_s_waitcnt(0);
        unsigned nloc = b.st[0], nx = b.st[1];
        if (nloc == 0u) { xcd_barrier_complete(bar, b.x, nloc, nx); b.st[0] = nloc; b.st[1] = nx; }
        const unsigned old = xb_add(&bar[XB_XSUB(b.x)], 1u);
        const unsigned gen = old / nloc;
        if (old + 1u == (gen + 1u) * nloc) {
            __builtin_amdgcn_fence(__ATOMIC_RELEASE, "agent");
            asm volatile("s_waitcnt vmcnt(0)" ::: "memory");
            const unsigned og = xb_add(&bar[XB_TOP], 1u);
            const unsigned tg = og / nx;
            if (og + 1u == (tg + 1u) * nx) xb_add(&bar[XB_TOPGEN], 1u);
            else XB_SPIN(xb_ld(&bar[XB_TOPGEN]) == tg, bar);
            __builtin_amdgcn_fence(__ATOMIC_ACQUIRE, "agent");
            xb_add(&bar[XB_XGEN(b.x)], 1u);
            asm volatile("s_waitcnt vmcnt(0)" ::: "memory");
        } else {
            XB_SPIN(xb_ld(&bar[XB_XGEN(b.x)]) == gen, bar);
            __builtin_amdgcn_fence(__ATOMIC_ACQUIRE, "agent");
            asm volatile("s_waitcnt vmcnt(0)" ::: "memory");
        }
    }
    __syncthreads();
}

__global__ void __launch_bounds__(512, 2) mega(Params P) {
    extern __shared__ __attribute__((aligned(16))) unsigned char lds_raw[];
    LAS unsigned char* lds = (LAS unsigned char*)lds_raw;
    cg::grid_group grid = cg::this_grid();
    if (threadIdx.x < 4) ((volatile LAS unsigned*)(lds + LDS_MAIN))[threadIdx.x] = 0u;
    __syncthreads();
    XcdBarrier xb = xcd_barrier_post((unsigned*)(P.ws + WS_BAR), (volatile LAS unsigned*)(lds + LDS_MAIN));
    const int wid = __builtin_amdgcn_readfirstlane(threadIdx.x >> 6);
    const int G = gridDim.x, nw = G * 8;
    const int gw = blockIdx.x * 8 + wid;
    const int gws = wid * G + blockIdx.x;
    unsigned char* ws = P.ws; unsigned char* proj = ws + WS_PROJ;
    bf16_t* U = (bf16_t*)(ws + WS_U); bf16_t* YC = (bf16_t*)(ws + WS_U);
    bf16_t* ST = (bf16_t*)P.out; bf16_t* Z = (bf16_t*)P.out;
    bf16_t* FFH = (bf16_t*)(proj + P_FFH); bf16_t* MIXF = (bf16_t*)(proj + P_MIX);
    const bf16_t* Win = (const bf16_t*)(ws + WS_W + W_IN); const bf16_t* Wcat = (const bf16_t*)(ws + WS_W + W_CAT);
    const bf16_t* Wmix = (const bf16_t*)(ws + WS_W + W_MIX); const bf16_t* Wff1 = (const bf16_t*)(ws + WS_W + W_FF1); const bf16_t* Wff2 = (const bf16_t*)(ws + WS_W + W_FF2);

    float* RS = (float*)(ws + WS_HMETA);
    const bf16_t* H16 = (const bf16_t*)(ws + WS_ST);
    if (P.ws == nullptr) grid.sync();

    for (int l = -1; l < 4; ++l) {
      if (l < 0) {
        make_tables(P);
        rowinit(P, RS, gw, nw);
      } else {
        for (int rep = 0; rep < REP_G1; ++rep) {
            zero_pads(P);
            EpiIn e; e.proj = proj; e.tabR = (const float*)(ws + WS_TABR); e.tabA = (const float*)(ws + WS_TABA); e.rd = P.ret_decay + l * 16; e.rs = RS;
            SchedPlain S; S.T.init(DIN); S.A = (const char*)H16; S.B = (const char*)Win; S.tstep = (size_t)256 * 1024 * 2; S.nt = 16;
            MainEpiIn me; me.e = e;
            gemm_main(lds, 1024, S, me);
            gemm_tail(lds, H16, Win, 1024, 1024, DIN, e);
        }
        xcd_barrier(xb);
        Mix M; M.q_r = (const bf16_t*)(proj + P_QR); M.k_r = (const bf16_t*)(proj + P_KR); M.kdF = (const bf16_t*)(proj + P_KDF); M.kdB = (const bf16_t*)(proj + P_KDB);
        M.v_rT = (const bf16_t*)(proj + P_VRT); M.g_r = (const bf16_t*)(proj + P_GR); M.q_a = (const bf16_t*)(proj + P_QA); M.k_a = (const bf16_t*)(proj + P_KA);
        M.v_aT = (const bf16_t*)(proj + P_VAT); M.states = ST; M.ycat = YC; M.rd = P.ret_decay + l * 16; M.sink = P.attn_sink + l * 8;
        for (int rep = 0; rep < REP_MX; ++rep) {
            for (int it = blockIdx.x; it < 256; it += G) scan_block(M, lds, it);
            attn_phase(M, lds, blockIdx.x, G, (256 - (int)blockIdx.x + G - 1) / G);
        }
        xcd_barrier(xb);
        for (int rep = 0; rep < REP_MX; ++rep) {
            ret_phase(M, lds);
            for (int it = gws; it < 64; it += nw) ret_item(M, it >> 3, it & 7, 0, 7);
        }
        xcd_barrier(xb);
        for (int rep = 0; rep < REP_G23; ++rep) {
            SchedGate S; S.T.init(1024); S.A = (const char*)YC; S.B = (const char*)Wcat; S.tstep = (size_t)256 * 1536 * 2;
            MainEpiGate me; me.gr = (const bf16_t*)(proj + P_GATER); me.ga = (const bf16_t*)(proj + P_GATEA); me.z = Z;
            gemm_main(lds, 1536, S, me);
            gemm_tail_gate(lds, YC, Wcat, me.gr, me.ga, Z);
        }
        xcd_barrier(xb);
        for (int rep = 0; rep < REP_G23; ++rep) {
            SchedPlain S; S.T.init(1024); S.A = (const char*)Z; S.B = (const char*)Wmix; S.tstep = (size_t)256 * 1024 * 2; S.nt = 16;
            MainEpiBf16 me; me.out = MIXF; EpiF32 te; te.out = MIXF;
            gemm_main(lds, 1024, S, me);
            gemm_tail(lds, Z, Wmix, 1024, 1024, 1024, te);
        }
        xcd_barrier(xb);
        rowpass(P, MIXF, P.n_mix_post + l * 1024, P.n_ff_pre + l * 1024, RS, gw, nw);
        xcd_barrier(xb);
        for (int rep = 0; rep < REP_FF; ++rep) {
            SchedPlain S; S.T.init(DFF); S.A = (const char*)H16; S.B = (const char*)Wff1; S.tstep = (size_t)256 * 1024 * 2; S.nt = 16;
            MainEpiRelu2 me; me.out = FFH; me.rs = RS; EpiRelu2 te; te.out = FFH; te.rs = RS;
            gemm_main(lds, 1024, S, me);
            gemm_tail(lds, H16, Wff1, 1024, 1024, DFF, te);
        }
        xcd_barrier(xb);
        for (int rep = 0; rep < REP_FF; ++rep) {
            SchedPlain S; S.T.init(1024); S.A = (const char*)FFH; S.B = (const char*)Wff2; S.tstep = (size_t)256 * 4096 * 2; S.nt = 64;
            MainEpiBf16 me; me.out = MIXF; EpiF32 te; te.out = MIXF;
            gemm_main(lds, 4096, S, me);
            gemm_tail(lds, FFH, Wff2, 4096, 4096, 1024, te);
        }
        xcd_barrier(xb);
        rowpass(P, MIXF, P.n_ff_post + l * 1024, l < 3 ? P.n_mix_pre + (l + 1) * 1024 : nullptr, RS, gw, nw);
      }
        if (l < 3) { convert_weights(P, l + 1, lds); xcd_barrier(xb); }
    }
}

extern "C" void kernel_launch(void* const* d_in, const int* in_sizes, int n_in, void* d_out, int out_size, void* d_ws, size_t ws_size, hipStream_t stream) {
    static int grid_blocks = 0;
    if (!grid_blocks) {
        int dev = 0, cus = 0, per_cu = 0;
        hipGetDevice(&dev);
        hipDeviceGetAttribute(&cus, hipDeviceAttributeMultiprocessorCount, dev);
        hipFuncSetAttribute((const void*)mega, hipFuncAttributeMaxDynamicSharedMemorySize, LDS_BYTES);
        hipOccupancyMaxActiveBlocksPerMultiprocessor(&per_cu, (const void*)mega, 512, LDS_BYTES);
        if (per_cu < 1) per_cu = 1;
        grid_blocks = cus * per_cu;
        if (ws_size < WS_END) fprintf(stderr, "kernel_launch: workspace too small: %zu < %zu\n", ws_size, (size_t)WS_END);
    }
    Params p{};
    p.x = (const float*)d_in[0]; p.meta = (const float*)d_in[1]; p.w_in = (const float*)d_in[2]; p.w_ret_o = (const float*)d_in[3];
    p.w_att_o = (const float*)d_in[4]; p.w_mix_o = (const float*)d_in[5]; p.w_ff1 = (const float*)d_in[6]; p.w_ff2 = (const float*)d_in[7];
    p.n_mix_pre = (const float*)d_in[8]; p.n_mix_post = (const float*)d_in[9]; p.n_ff_pre = (const float*)d_in[10]; p.n_ff_post = (const float*)d_in[11];
    p.ret_decay = (const float*)d_in[12]; p.attn_sink = (const float*)d_in[13];
    p.out = (float*)d_out; p.ws = (unsigned char*)d_ws;
    (void)hipMemsetAsync((unsigned char*)d_ws + WS_BAR, 0, 16384, stream);
    void* args[] = {&p};
    hipError_t e = hipLaunchCooperativeKernel((const void*)mega, dim3(grid_blocks), dim3(512), args, LDS_BYTES, stream);
    if (e != hipSuccess) fprintf(stderr, "cooperative launch failed: %s (grid %d)\n", hipGetErrorString(e), grid_blocks);
}
```

```cpp
#include <hip/hip_runtime.h>
#include <hip/hip_cooperative_groups.h>
#include <cstdio>
namespace cg = cooperative_groups;
#ifndef REP_G1
#define REP_G1 1
#endif
#ifndef REP_MX
#define REP_MX 1
#endif
#ifndef REP_FF
#define REP_FF 1
#endif
#ifndef REP_G23
#define REP_G23 1
#endif

#define LAS __attribute__((address_space(3)))
#define DI __device__ __forceinline__
typedef unsigned short bf16_t;
typedef short bf16x8 __attribute__((ext_vector_type(8)));
typedef short bf16x4 __attribute__((ext_vector_type(4)));
typedef float f32x4 __attribute__((ext_vector_type(4)));
typedef float f32x2 __attribute__((ext_vector_type(2)));
typedef unsigned u32x4 __attribute__((ext_vector_type(4)));
typedef unsigned u32x2 __attribute__((ext_vector_type(2)));
typedef __bf16 bfx2 __attribute__((ext_vector_type(2)));

constexpr int RX = 16384;
constexpr int RT = 16512;
constexpr int DM = 1024, DIN = 5888, DFF = 4096, LP = 2176, NCH = 17;
constexpr float EPS = 1e-6f;

constexpr size_t WS_HMETA = 0;
constexpr size_t WS_TABR = WS_HMETA + (size_t)128 * 1024 * 4;
constexpr size_t WS_TABA = WS_TABR + (size_t)2064 * 32 * 2 * 4;
constexpr size_t WS_W = WS_TABA + (size_t)2064 * 8 * 2 * 4;
constexpr size_t W_IN = 0;
constexpr size_t W_CAT = W_IN + (size_t)DIN * 1024 * 2;
constexpr size_t W_MIX = W_CAT + (size_t)1024 * 1536 * 2;
constexpr size_t W_FF1 = W_MIX + (size_t)1024 * 1024 * 2;
constexpr size_t W_FF2 = W_FF1 + (size_t)4096 * 1024 * 2;
constexpr size_t W_END = W_FF2 + (size_t)1024 * 4096 * 2;
constexpr size_t WS_U = WS_W + W_END;
constexpr size_t WS_ST = WS_U + (size_t)RT * 1536 * 2;
constexpr size_t WS_PROJ = WS_ST + (size_t)8 * 8 * 17 * 2 * 128 * 64 * 2;
constexpr size_t P_QR = 0;
constexpr size_t P_KR = P_QR + (size_t)RT * 512 * 2;
constexpr size_t P_KDF = P_KR + (size_t)RT * 512 * 2;
constexpr size_t P_KDB = P_KDF + (size_t)64 * 64 * LP * 2;
constexpr size_t P_VRT = P_KDB + (size_t)64 * 64 * LP * 2;
constexpr size_t P_GR = P_VRT + (size_t)64 * 128 * LP * 2;
constexpr size_t P_QA = P_GR + (size_t)RT * 1024 * 2;
constexpr size_t P_KA = P_QA + (size_t)RT * 512 * 2;
constexpr size_t P_VAT = P_KA + (size_t)RT * 128 * 2;
constexpr size_t P_GATER = P_VAT + (size_t)16 * 64 * LP * 2;
constexpr size_t P_GATEA = P_GATER + (size_t)RT * 1024 * 2;
constexpr size_t P_END = P_GATEA + (size_t)RT * 1024 * 2;
constexpr size_t P_FFH = 0;
constexpr size_t P_MIX = (size_t)RT * 4096 * 2;
static_assert(P_MIX + (size_t)RT * 1024 * 4 <= P_END, "alias");
constexpr size_t WS_BAR = WS_PROJ + P_END;
constexpr size_t WS_END = WS_BAR + 16384;

constexpr int LDS_MAIN = 134400;
constexpr int LDS_BYTES = LDS_MAIN + 16;

struct Params {
    const float *x, *meta, *w_in, *w_ret_o, *w_att_o, *w_mix_o, *w_ff1, *w_ff2;
    const float *n_mix_pre, *n_mix_post, *n_ff_pre, *n_ff_post, *ret_decay, *attn_sink;
    float* out; unsigned char* ws;
};

DI unsigned pk2(float lo, float hi) { f32x2 v = {lo, hi}; bfx2 b = __builtin_convertvector(v, bfx2); return __builtin_bit_cast(unsigned, b); }
DI u32x2 pk4(f32x4 v) { u32x2 r; r.x = pk2(v[0], v[1]); r.y = pk2(v[2], v[3]); return r; }
DI void st4(bf16_t* p, f32x4 v) { *(u32x2*)p = pk4(v); }
DI void st_pair16(bf16_t* p, f32x4 a, f32x4 b, int fq) {
    const u32x2 pa = pk4(a), pb = pk4(b);
    const auto r0 = __builtin_amdgcn_permlane16_swap(pa.x, pb.x, false, false);
    const auto r1 = __builtin_amdgcn_permlane16_swap(pa.y, pb.y, false, false);
    u32x4 w; w.x = r0[0]; w.y = r1[0]; w.z = r0[1]; w.w = r1[1];
    *(u32x4*)(p + (fq & 1) * 16 + (fq >> 1) * 8) = w;
}
DI bf16_t bf1(float x) { return (bf16_t)(pk2(x, x) & 0xffffu); }
DI f32x4 ld4(const bf16_t* p) {
    u32x2 w = *(const u32x2*)p; f32x4 r;
    r[0] = __uint_as_float(w.x << 16); r[1] = __uint_as_float(w.x & 0xffff0000u);
    r[2] = __uint_as_float(w.y << 16); r[3] = __uint_as_float(w.y & 0xffff0000u); return r;
}
DI bf16x8 pack8(f32x4 a, f32x4 b) { u32x4 w; w.x = pk2(a[0], a[1]); w.y = pk2(a[2], a[3]); w.z = pk2(b[0], b[1]); w.w = pk2(b[2], b[3]); return __builtin_bit_cast(bf16x8, w); }
DI bf16x8 cat8(bf16x4 lo, bf16x4 hi) { return __builtin_shufflevector(lo, hi, 0, 1, 2, 3, 4, 5, 6, 7); }
DI bf16x8 ld8(const bf16_t* p) { return *(const bf16x8*)p; }
DI bf16x4 ld4s(const bf16_t* p) { return *(const bf16x4*)p; }
DI f32x4 mfma16(bf16x8 a, bf16x8 b, f32x4 c) { return __builtin_amdgcn_mfma_f32_16x16x32_bf16(a, b, c, 0, 0, 0); }
DI float sigm(float x) { return __builtin_amdgcn_rcpf(1.0f + __expf(-x)); }
DI float wsum(float v) { v += __shfl_xor(v, 1); v += __shfl_xor(v, 2); v += __shfl_xor(v, 4); v += __shfl_xor(v, 8); v += __shfl_xor(v, 16); v += __shfl_xor(v, 32); return v; }
DI int otid() { int t = threadIdx.x; asm volatile("" : "+v"(t)); return t; }
DI void row_bp(int row, int& b, int& p, int& pp) {
    if (row < RX) { b = row >> 11; const int s = row & 2047; p = 16 + s; pp = 128 + s; }
    else { const int m = row - RX; b = m >> 4; p = m & 15; pp = 112 + p; }
}

DI void unpack8(u32x4 w, f32x4& lo, f32x4& hi) {
    lo[0] = __uint_as_float(w.x << 16); lo[1] = __uint_as_float(w.x & 0xffff0000u); lo[2] = __uint_as_float(w.y << 16); lo[3] = __uint_as_float(w.y & 0xffff0000u);
    hi[0] = __uint_as_float(w.z << 16); hi[1] = __uint_as_float(w.z & 0xffff0000u); hi[2] = __uint_as_float(w.w << 16); hi[3] = __uint_as_float(w.w & 0xffff0000u);
}
DI void st8(bf16_t* p, f32x4 a, f32x4 b) { u32x4 w; w.x = pk2(a[0], a[1]); w.y = pk2(a[2], a[3]); w.z = pk2(b[0], b[1]); w.w = pk2(b[2], b[3]); *(u32x4*)p = w; }
struct EpiIn {
    unsigned char* proj; const float* tabR; const float* tabA; const float* rd; const float* rs;
    template <int SEC> DI f32x4 load_cs(int row, int col) const {
        int b, p, pp; row_bp(row, b, p, pp);
        if (SEC == 0 || SEC == 1) { const int w = col & 63; return *(const f32x4*)(tabR + ((size_t)p * 32 + (w >> 1)) * 2); }
        if (SEC == 4 || SEC == 5) { const int w = col & 63; if (w < 16) return *(const f32x4*)(tabA + ((size_t)p * 8 + (w >> 1)) * 2); }
        return (f32x4){1.f, 0.f, 1.f, 0.f};
    }
    template <int SEC> DI f32x4 xform(f32x4 v, f32x4 cs) const {
        f32x4 o = v;
        if (SEC == 0 || SEC == 1 || SEC == 4 || SEC == 5) {
            o[0] = v[0] * cs[0] - v[1] * cs[1]; o[1] = v[1] * cs[0] + v[0] * cs[1];
            o[2] = v[2] * cs[2] - v[3] * cs[3]; o[3] = v[3] * cs[2] + v[2] * cs[3];
            if (SEC == 0 || SEC == 4) o *= 0.125f;
        } else if (SEC == 3) {
#pragma unroll
            for (int jj = 0; jj < 4; ++jj) o[jj] = v[jj] * sigm(v[jj]);
        } else if (SEC == 7 || SEC == 8) {
#pragma unroll
            for (int jj = 0; jj < 4; ++jj) o[jj] = sigm(v[jj]);
        }
        return o;
    }
    template <int SEC> DI bf16_t* dst(int row, int col) const {
        if (SEC == 0) return (bf16_t*)(proj + P_QR) + (size_t)row * 512 + col;
        if (SEC == 1) return (bf16_t*)(proj + P_KR) + (size_t)row * 512 + (col - 512);
        if (SEC == 3) return (bf16_t*)(proj + P_GR) + (size_t)row * 1024 + (col - 2048);
        if (SEC == 4) return (bf16_t*)(proj + P_QA) + (size_t)row * 512 + (col - 3072);
        if (SEC == 5) return (bf16_t*)(proj + P_KA) + (size_t)row * 128 + (col - 3584);
        if (SEC == 7) return (bf16_t*)(proj + P_GATER) + (size_t)row * 1024 + (col - 3840);
        if (SEC == 8) return (bf16_t*)(proj + P_GATEA) + (size_t)row * 1024 + (col - 4864);
        return nullptr;
    }
    template <int SEC> DI void scatter(int row, int col, f32x4 o, float lgf, float lgb) const {
        if (SEC != 1 && SEC != 2 && SEC != 6) return;
        int b, p, pp; row_bp(row, b, p, pp);
        if (SEC == 1) {
            const int c = col & 511, w = c & 63, h = c >> 6;
            const int j = pp & 127;
            const float df = __expf(lgf * (float)(127 - j)), db = __expf(lgb * (float)j);
            const size_t base = ((size_t)(b * 8 + h) * 64 + w) * LP + pp;
            bf16_t* kf = (bf16_t*)(proj + P_KDF) + base; bf16_t* kb = (bf16_t*)(proj + P_KDB) + base;
#pragma unroll
            for (int jj = 0; jj < 4; ++jj) { kf[(size_t)jj * LP] = bf1(o[jj] * df); kb[(size_t)jj * LP] = bf1(o[jj] * db); }
        } else if (SEC == 2) {
            const int c = col - 1024, h = c >> 7, e = c & 127;
            bf16_t* vt = (bf16_t*)(proj + P_VRT) + ((size_t)(b * 8 + h) * 128 + e) * LP + pp;
#pragma unroll
            for (int jj = 0; jj < 4; ++jj) vt[(size_t)jj * LP] = bf1(o[jj]);
        } else {
            const int c = col - 3712, g = c >> 6, d = c & 63;
            bf16_t* vt = (bf16_t*)(proj + P_VAT) + ((size_t)(b * 2 + g) * 64 + d) * LP + pp;
#pragma unroll
            for (int jj = 0; jj < 4; ++jj) vt[(size_t)jj * LP] = bf1(o[jj]);
        }
    }
    template <int SEC> DI void body(int row, int col, f32x4 v, f32x4 cs, float lgf, float lgb) const {
        const f32x4 o = xform<SEC>(v * rs[row], cs);
        if (SEC != 2 && SEC != 6) st4(dst<SEC>(row, col), o);
        scatter<SEC>(row, col, o, lgf, lgb);
    }
    template <int SEC> DI void body2(int row, int col, f32x4 v0, f32x4 v1, f32x4 cs0, f32x4 cs1, float lgf, float lgb, float rsv) const {
        const f32x4 o0 = xform<SEC>(v0 * rsv, cs0), o1 = xform<SEC>(v1 * rsv, cs1);
        if (SEC != 2 && SEC != 6) st8(dst<SEC>(row, col), o0, o1);
        scatter<SEC>(row, col, o0, lgf, lgb); scatter<SEC>(row, col + 4, o1, lgf, lgb);
    }
    static DI int section(int col) {
        return col < 512 ? 0 : col < 1024 ? 1 : col < 2048 ? 2 : col < 3072 ? 3 : col < 3584 ? 4 : col < 3712 ? 5 : col < 3840 ? 6 : col < 4864 ? 7 : 8;
    }
    template <int SEC> DI void one(int row, int col, f32x4 v) const {
        float lgf = 0.f, lgb = 0.f;
        if (SEC == 1) { const int h = (col & 511) >> 6; lgf = -__expf(rd[h]); lgb = -__expf(rd[8 + h]); }
        body<SEC>(row, col, v, load_cs<SEC>(row, col), lgf, lgb);
    }
    DI void operator()(int row, int col, f32x4 v) const {
        switch (section(col)) {
            case 0: one<0>(row, col, v); break; case 1: one<1>(row, col, v); break; case 2: one<2>(row, col, v); break;
            case 3: one<3>(row, col, v); break; case 4: one<4>(row, col, v); break; case 5: one<5>(row, col, v); break;
            case 6: one<6>(row, col, v); break; case 7: one<7>(row, col, v); break; default: one<8>(row, col, v); break;
        }
    }
};
struct EpiF32 { bf16_t* out; DI void operator()(int row, int col, f32x4 v) const { st4(out + (size_t)row * 1024 + col, v); } };
struct EpiRelu2 { bf16_t* out; const float* rs; DI void operator()(int row, int col, f32x4 v) const {
    f32x4 o; const float r = rs[row];
#pragma unroll
    for (int jj = 0; jj < 4; ++jj) { const float t = fmaxf(v[jj] * r, 0.f); o[jj] = t * t; }
    st4(out + (size_t)row * 4096 + col, o); } };

constexpr int HALF = 128, BK = 64, HTB = HALF * BK * 2;
DI int lds_byte(int r, int c) { const int st = (r >> 4) * 2 + (c >> 5), rr = r & 15, cc = c & 31, ob = rr * 64 + cc * 2; return st * 1024 + (ob ^ (((ob >> 9) & 1) << 5)); }
DI int perm32(int rho) { const int n = rho >> 4, i = rho & 15; return 8 * (i >> 2) + 4 * n + (i & 3); }
DI void stage_rc(int b, int& R, int& C) { const int st = b / 1024, sb = b % 1024, swz = sb ^ (((sb >> 9) & 1) << 5); R = (st >> 1) * 16 + swz / 64; C = (st & 1) * 32 + (swz % 64) / 2; }

struct Unit { const char* A; const char* B; int nt, pm, pn, kind; };
struct TileOrder {
    int nM, nN, nwg, G, c;
    DI void init(int N) { nM = RX / 256; nN = N / 256; nwg = nM * nN; G = gridDim.x; c = blockIdx.x; }
    DI bool tile(int i, int& pm, int& pn) const {
        const long L = (long)i * G + c; if (L >= nwg) return false;
        int wgid = (int)L; { const int q = nwg / 8, r = nwg % 8, xcd = wgid % 8, off = wgid / 8; wgid = (xcd < r ? xcd * (q + 1) : r * (q + 1) + (xcd - r) * q) + off; }
        const int nig = 8 * nN, gid = wgid / nig, fm = gid * 8, gsz = (nM - fm) < 8 ? (nM - fm) : 8;
        pm = fm + ((wgid % nig) % gsz); pn = (wgid % nig) / gsz; return true;
    }
};
struct SchedPlain {
    TileOrder T; const char* A; const char* B; size_t tstep; int nt;
    DI bool next(int i, Unit& u) const { if (!T.tile(i, u.pm, u.pn)) return false; u.A = A + (size_t)u.pm * tstep; u.B = B + (size_t)u.pn * tstep; u.nt = nt; u.kind = 1; return true; }
};
struct SchedGate {
    TileOrder T; const char* A; const char* B; size_t tstep;
    DI bool next(int i, Unit& u) const { if (!T.tile(i >> 1, u.pm, u.pn)) return false; const int kind = i & 1; u.kind = kind;
        u.A = A + (size_t)u.pm * tstep + (kind ? 2048 : 0); u.B = B + (size_t)u.pn * tstep + (kind ? 2048 : 0); u.nt = kind ? 8 : 16; return true; }
};

template <class F> DI void for_acc(f32x4 (&acc)[2][2][4][2], const Unit& u, int wr, int wc, int fr, int fq, const F& f) {
#pragma unroll
    for (int bj = 0; bj < 2; ++bj)
#pragma unroll
        for (int ai = 0; ai < 2; ++ai)
#pragma unroll
            for (int m = 0; m < 4; ++m)
#pragma unroll
                for (int n = 0; n < 2; ++n)
                    f(u.pm * 256 + ai * HALF + wr * 64 + m * 16 + fr, u.pn * 256 + bj * HALF + wc * 32 + fq * 8 + n * 4, acc[ai][bj][m][n]);
}
template <class E> struct MainEpi { E e; DI bool run(f32x4 (&acc)[2][2][4][2], const Unit& u, int wr, int wc, int fr, int fq) const {
    for_acc(acc, u, wr, wc, fr, fq, [&](int row, int col, f32x4& v) { e(row, col, v); }); return false; } };
struct MainEpiIn { EpiIn e;
    template <int S> DI void sec_loop(f32x4 (&acc)[2][2][4][2], const Unit& u, int bj, int wr, int wc, int fr, int fq) const {
        const int colb = u.pn * 256 + bj * HALF + wc * 32 + fq * 8;
        float lgf = 0.f, lgb = 0.f;
        if (S == 1) { const int h = ((u.pn * 256 + bj * HALF + wc * 32) & 511) >> 6; lgf = -__expf(e.rd[h]); lgb = -__expf(e.rd[8 + h]); }
#pragma unroll
        for (int ai = 0; ai < 2; ++ai) {
            const int rowb = u.pm * 256 + ai * HALF + wr * 64 + fr;
            f32x4 cs[4][2]; float rsv[4];
#pragma unroll
            for (int m = 0; m < 4; ++m) { rsv[m] = e.rs[rowb + m * 16];
#pragma unroll
                for (int n = 0; n < 2; ++n) cs[m][n] = e.load_cs<S>(rowb + m * 16, colb + n * 4); }
#pragma unroll
            for (int m = 0; m < 4; ++m) e.body2<S>(rowb + m * 16, colb, acc[ai][bj][m][0], acc[ai][bj][m][1], cs[m][0], cs[m][1], lgf, lgb, rsv[m]);
        }
    }
    DI bool run(f32x4 (&acc)[2][2][4][2], const Unit& u, int wr, int wc, int fr, int fq) const {
        {
            const int sec0 = EpiIn::section(u.pn * 256);
#define SECCASE(S, BJ) case S: sec_loop<S>(acc, u, BJ, wr, wc, fr, fq); break;
            switch (sec0) { SECCASE(0, 0) SECCASE(1, 0) SECCASE(2, 0) SECCASE(3, 0) SECCASE(4, 0) SECCASE(5, 0) SECCASE(6, 0) SECCASE(7, 0) default: sec_loop<8>(acc, u, 0, wr, wc, fr, fq); break; }
            const int sec1 = EpiIn::section(u.pn * 256 + HALF);
            switch (sec1) { SECCASE(0, 1) SECCASE(1, 1) SECCASE(2, 1) SECCASE(3, 1) SECCASE(4, 1) SECCASE(5, 1) SECCASE(6, 1) SECCASE(7, 1) default: sec_loop<8>(acc, u, 1, wr, wc, fr, fq); break; }
#undef SECCASE
        }
        return false; } };
struct MainEpiGate { const bf16_t* gr; const bf16_t* ga; bf16_t* z;
    DI bool run(f32x4 (&acc)[2][2][4][2], const Unit& u, int wr, int wc, int fr, int fq) const {
        const bool k0 = (u.kind == 0);
#pragma unroll
        for (int bj = 0; bj < 2; ++bj)
#pragma unroll
            for (int ai = 0; ai < 2; ++ai) {
                const size_t base = (size_t)(u.pm * 256 + ai * HALF + wr * 64 + fr) * 1024 + (u.pn * 256 + bj * HALF + wc * 32 + fq * 8);
                u32x4 ra[4], rb[4];
#pragma unroll
                for (int m = 0; m < 4; ++m) { rb[m] = *(const u32x4*)(ga + base + (size_t)m * 16 * 1024); if (k0) ra[m] = *(const u32x4*)(gr + base + (size_t)m * 16 * 1024); else ra[m] = rb[m]; }
#pragma unroll
                for (int m = 0; m < 4; ++m) {
                    f32x4 a0, a1, b0, b1; unpack8(ra[m], a0, a1); unpack8(rb[m], b0, b1);
                    f32x4& v0 = acc[ai][bj][m][0]; f32x4& v1 = acc[ai][bj][m][1];
                    if (k0) {
#pragma unroll
                        for (int jj = 0; jj < 4; ++jj) { v0[jj] *= a0[jj] * __builtin_amdgcn_rcpf(fmaxf(b0[jj], 1e-30f)); v1[jj] *= a1[jj] * __builtin_amdgcn_rcpf(fmaxf(b1[jj], 1e-30f)); }
                    } else st8(z + base + (size_t)m * 16 * 1024, v0 * b0, v1 * b1);
                }
            }
        return k0;
    } };
template <class F> DI void for_acc2(f32x4 (&acc)[2][2][4][2], const Unit& u, int wr, int wc, int fr, int fq, const F& f) {
#pragma unroll
    for (int bj = 0; bj < 2; ++bj)
#pragma unroll
        for (int ai = 0; ai < 2; ++ai)
#pragma unroll
            for (int m = 0; m < 4; ++m)
                f(u.pm * 256 + ai * HALF + wr * 64 + m * 16 + fr, u.pn * 256 + bj * HALF + wc * 32 + fq * 8, acc[ai][bj][m][0], acc[ai][bj][m][1]);
}
struct MainEpiBf16 { bf16_t* out; DI bool run(f32x4 (&acc)[2][2][4][2], const Unit& u, int wr, int wc, int fr, int fq) const {
    for_acc2(acc, u, wr, wc, fr, fq, [&](int row, int col, const f32x4& a, const f32x4& b) { st8(out + (size_t)row * 1024 + col, a, b); }); return false; } };
struct MainEpiRelu2 { bf16_t* out; const float* rs; DI bool run(f32x4 (&acc)[2][2][4][2], const Unit& u, int wr, int wc, int fr, int fq) const {
    float rsv[2][4];
#pragma unroll
    for (int ai = 0; ai < 2; ++ai)
#pragma unroll
        for (int m = 0; m < 4; ++m) rsv[ai][m] = rs[u.pm * 256 + ai * HALF + wr * 64 + m * 16 + fr];
#pragma unroll
    for (int bj = 0; bj < 2; ++bj)
#pragma unroll
        for (int ai = 0; ai < 2; ++ai)
#pragma unroll
            for (int m = 0; m < 4; ++m) {
                const int row = u.pm * 256 + ai * HALF + wr * 64 + m * 16 + fr, col = u.pn * 256 + bj * HALF + wc * 32 + fq * 8;
                const f32x4 a = acc[ai][bj][m][0] * rsv[ai][m], b = acc[ai][bj][m][1] * rsv[ai][m];
                f32x4 x, y;
#pragma unroll
                for (int jj = 0; jj < 4; ++jj) { const float t = fmaxf(a[jj], 0.f), w = fmaxf(b[jj], 0.f); x[jj] = t * t; y[jj] = w * w; }
                st8(out + (size_t)row * 4096 + col, x, y);
            }
    return false; } };

template <class Sched, class Epi>
DI void gemm_main(LAS unsigned char* lds, int pitch, const Sched& S, const Epi& E) {
    const int tid = otid(), wid = __builtin_amdgcn_readfirstlane(tid >> 6), lane = tid & 63, wr = wid >> 2, wc = wid & 3, fr = lane & 15, fq = lane >> 4;
    unsigned voff[2], voffB[2];
#pragma unroll
    for (int i = 0; i < 2; ++i) { int R, C; stage_rc(tid * 16 + i * 8192, R, C); voff[i] = (unsigned)(R * pitch + C) * 2u;
        const int Rb = (R & ~31) + perm32(R & 31); voffB[i] = (unsigned)(Rb * pitch + C) * 2u; }
    const size_t kstep = (size_t)(BK * 2);
    const size_t hstep = (size_t)HALF * pitch * 2;
    const unsigned ldsw = (unsigned)wid * 1024u;
    const int aoff = lds_byte(wr * 64 + fr, fq * 8), boff = lds_byte(wc * 32 + fr, fq * 8);
#define G_SA(b, h) (((b) * 2 + (h)) * HTB)
#define G_SB(b, h) ((4 + (b) * 2 + (h)) * HTB)
#define G_STAGEV(bufoff, gbase, VO) do { _Pragma("unroll") for (int _i = 0; _i < 2; ++_i) \
        __builtin_amdgcn_global_load_lds((const unsigned*)((const char*)(gbase) + VO[_i]), (LAS unsigned*)(lds + (bufoff) + ldsw + _i * 8192), 16, 0, 0); } while (0)
#define G_STAGE(bufoff, gbase) G_STAGEV(bufoff, gbase, voff)
#define G_STAGEB(bufoff, gbase) G_STAGEV(bufoff, gbase, voffB)
#define G_LDA(dst, b, h) do { _Pragma("unroll") for (int m = 0; m < 4; ++m) _Pragma("unroll") for (int k = 0; k < 2; ++k) dst[m][k] = *(const LAS bf16x8*)(lds + G_SA(b, h) + aoff + m * 2048 + k * 1024); } while (0)
#define G_LDB(dst, b, h) do { _Pragma("unroll") for (int n = 0; n < 2; ++n) _Pragma("unroll") for (int k = 0; k < 2; ++k) dst[n][k] = *(const LAS bf16x8*)(lds + G_SB(b, h) + boff + n * 2048 + k * 1024); } while (0)
#define G_MMA(ai, bj, At, Bt) do { __builtin_amdgcn_s_setprio(1); _Pragma("unroll") for (int m = 0; m < 4; ++m) _Pragma("unroll") for (int n = 0; n < 2; ++n) _Pragma("unroll") for (int k = 0; k < 2; ++k) \
        acc[ai][bj][m][n] = __builtin_amdgcn_mfma_f32_16x16x32_bf16(Bt[n][k], At[m][k], acc[ai][bj][m][n], 0, 0, 0); __builtin_amdgcn_s_setprio(0); } while (0)
#define G_WAIT_V(n) asm volatile("s_waitcnt vmcnt(" #n ")" ::: "memory")
#define G_WAIT_L(n) asm volatile("s_waitcnt lgkmcnt(" #n ")" ::: "memory")
#define G_BAR __builtin_amdgcn_s_barrier()
#define G_SCHED __builtin_amdgcn_sched_barrier(0)
    Unit cur, nxt; int ui = 0;
    if (!S.next(0, cur)) return;
    f32x4 acc[2][2][4][2];
#pragma unroll
    for (int a = 0; a < 2; ++a)
#pragma unroll
        for (int b = 0; b < 2; ++b)
#pragma unroll
            for (int m = 0; m < 4; ++m)
#pragma unroll
                for (int n = 0; n < 2; ++n) acc[a][b][m][n] = (f32x4){0.f, 0.f, 0.f, 0.f};
    bf16x8 At[4][2], B0[2][2], B1[2][2];
    const char* cA = cur.A; const char* cB = cur.B;
    G_STAGEB(G_SB(0, 0), cB); G_STAGE(G_SA(0, 0), cA); G_STAGEB(G_SB(0, 1), cB + hstep); G_STAGE(G_SA(0, 1), cA + hstep);
    if (wr == 1) G_BAR;
    G_WAIT_V(4); G_BAR;
    G_STAGEB(G_SB(1, 0), cB + kstep); G_STAGE(G_SA(1, 0), cA + kstep); G_STAGEB(G_SB(1, 1), cB + hstep + kstep);
    G_WAIT_V(6); G_BAR;
    for (;;) {
        const bool has_next = S.next(ui + 1, nxt);
        const char* nA = has_next ? nxt.A : cA; const char* nB = has_next ? nxt.B : cB;
        const int nt = cur.nt;
        for (int t = 0; t < nt; t += 2) {
            const bool last = (t == nt - 2);
            const char* a1 = cA + (size_t)(t + 1) * kstep;
            const char* a2 = last ? nA : cA + (size_t)(t + 2) * kstep; const char* b2 = last ? nB : cB + (size_t)(t + 2) * kstep;
            const char* a3 = a2 + kstep; const char* b3 = b2 + kstep;
            G_LDB(B0, 0, 0); G_SCHED; G_LDA(At, 0, 0); G_STAGE(G_SA(1, 1), a1 + hstep);
            G_WAIT_L(8); G_BAR; G_WAIT_L(0); G_MMA(0, 0, At, B0); G_BAR; G_SCHED;
            G_LDB(B1, 0, 1); G_STAGEB(G_SB(0, 0), b2);
            G_BAR; G_WAIT_L(0); G_MMA(0, 1, At, B1); G_BAR;
            G_LDA(At, 0, 1); G_STAGE(G_SA(0, 0), a2);
            G_BAR; G_WAIT_L(0); G_MMA(1, 0, At, B0); G_BAR; G_SCHED;
            G_STAGEB(G_SB(0, 1), b2 + hstep);
            G_WAIT_V(6); G_BAR; G_MMA(1, 1, At, B1); G_BAR;
            G_LDB(B0, 1, 0); G_SCHED; G_LDA(At, 1, 0); G_STAGE(G_SA(0, 1), a2 + hstep);
            G_WAIT_L(8); G_BAR; G_WAIT_L(0); G_MMA(0, 0, At, B0); G_BAR; G_SCHED;
            G_LDB(B1, 1, 1); G_STAGEB(G_SB(1, 0), b3);
            G_BAR; G_WAIT_L(0); G_MMA(0, 1, At, B1); G_BAR;
            G_LDA(At, 1, 1); G_STAGE(G_SA(1, 0), a3);
            G_BAR; G_WAIT_L(0); G_MMA(1, 0, At, B0); G_BAR; G_SCHED;
            G_STAGEB(G_SB(1, 1), b3 + hstep);
            G_WAIT_V(6); G_BAR; G_MMA(1, 1, At, B1); G_BAR;
        }
        const bool keep = E.run(acc, cur, wr, wc, fr, fq);
        if (!has_next) break;
        if (!keep) {
#pragma unroll
            for (int a = 0; a < 2; ++a)
#pragma unroll
                for (int b = 0; b < 2; ++b)
#pragma unroll
                    for (int m = 0; m < 4; ++m)
#pragma unroll
                        for (int n = 0; n < 2; ++n) acc[a][b][m][n] = (f32x4){0.f, 0.f, 0.f, 0.f};
        }
        cur = nxt; cA = nA; cB = nB; ++ui;
    }
    G_WAIT_V(0);
    if (wr == 0) G_BAR;
    G_BAR;
#undef G_SA
#undef G_SB
#undef G_STAGE
#undef G_STAGEV
#undef G_STAGEB
#undef G_LDA
#undef G_LDB
#undef G_MMA
}

#define SB() __builtin_amdgcn_sched_barrier(0)
template <class Epi>
DI void gemm_tail(LAS unsigned char* lds, const bf16_t* A, const bf16_t* Bt, int pitch, int K, int N, const Epi& epi) {
    const int tid = otid(), wid = __builtin_amdgcn_readfirstlane(tid >> 6), lane = tid & 63, fr = lane & 15, fq = lane >> 4;
    LAS f32x4* red = (LAS f32x4*)lds;
    const int nitems = 8 * (N >> 6);
    const int kslice = K >> 3;
    for (int it = blockIdx.x; it < nitems; it += gridDim.x) {
        const int rt = it & 7, cg = it >> 3;
        const bf16_t* ap = A + (size_t)(RX + rt * 16 + fr) * pitch + fq * 8 + wid * kslice;
        const bf16_t* bp = Bt + (size_t)(cg * 64 + fr) * pitch + fq * 8 + wid * kslice;
        f32x4 acc[4];
#pragma unroll
        for (int cf = 0; cf < 4; ++cf) acc[cf] = (f32x4){0.f, 0.f, 0.f, 0.f};
        for (int k0 = 0; k0 < kslice; k0 += 128) {
            bf16x8 av[4], bv[4][4];
#pragma unroll
            for (int s4 = 0; s4 < 4; ++s4) { av[s4] = ld8(ap + k0 + s4 * 32);
#pragma unroll
                for (int cf = 0; cf < 4; ++cf) bv[s4][cf] = ld8(bp + (size_t)cf * 16 * pitch + k0 + s4 * 32); }
            SB();
#pragma unroll
            for (int s4 = 0; s4 < 4; ++s4)
#pragma unroll
                for (int cf = 0; cf < 4; ++cf) acc[cf] = mfma16(bv[s4][cf], av[s4], acc[cf]);
        }
#pragma unroll
        for (int cf = 0; cf < 4; ++cf) red[(wid * 4 + cf) * 64 + lane] = acc[cf];
        __syncthreads();
        if (wid < 4) {
            f32x4 v = red[(0 * 4 + wid) * 64 + lane];
#pragma unroll
            for (int w = 1; w < 8; ++w) v += red[(w * 4 + wid) * 64 + lane];
            epi(RX + rt * 16 + fr, cg * 64 + wid * 16 + fq * 4, v);
        }
        __syncthreads();
    }
}
DI void gemm_tail_gate(LAS unsigned char* lds, const bf16_t* A, const bf16_t* Bt, const bf16_t* gr, const bf16_t* ga, bf16_t* z) {
    const int tid = otid(), wid = __builtin_amdgcn_readfirstlane(tid >> 6), lane = tid & 63, fr = lane & 15, fq = lane >> 4;
    LAS f32x4* red = (LAS f32x4*)lds;
    for (int it = blockIdx.x; it < 128; it += gridDim.x) {
        const int rt = it & 7, cg = it >> 3;
        const bf16_t* ap = A + (size_t)(RX + rt * 16 + fr) * 1536 + fq * 8;
        const bf16_t* bp = Bt + (size_t)(cg * 64 + fr) * 1536 + fq * 8;
        bf16x8 av[6], bv[6][4];
#pragma unroll
        for (int s6 = 0; s6 < 6; ++s6) { const int ko = s6 < 4 ? wid * 128 + s6 * 32 : 1024 + wid * 64 + (s6 - 4) * 32; av[s6] = ld8(ap + ko);
#pragma unroll
            for (int cf = 0; cf < 4; ++cf) bv[s6][cf] = ld8(bp + (size_t)cf * 16 * 1536 + ko); }
        SB();
        f32x4 a0[4], a1[4];
#pragma unroll
        for (int cf = 0; cf < 4; ++cf) { a0[cf] = (f32x4){0.f, 0.f, 0.f, 0.f}; a1[cf] = (f32x4){0.f, 0.f, 0.f, 0.f}; }
#pragma unroll
        for (int s6 = 0; s6 < 6; ++s6)
#pragma unroll
            for (int cf = 0; cf < 4; ++cf) { if (s6 < 4) a0[cf] = mfma16(bv[s6][cf], av[s6], a0[cf]); else a1[cf] = mfma16(bv[s6][cf], av[s6], a1[cf]); }
#pragma unroll
        for (int cf = 0; cf < 4; ++cf) { red[(wid * 4 + cf) * 64 + lane] = a0[cf]; red[2048 + (wid * 4 + cf) * 64 + lane] = a1[cf]; }
        __syncthreads();
        if (wid < 4) {
            f32x4 v0 = red[(0 * 4 + wid) * 64 + lane], v1 = red[2048 + (0 * 4 + wid) * 64 + lane];
#pragma unroll
            for (int w = 1; w < 8; ++w) { v0 += red[(w * 4 + wid) * 64 + lane]; v1 += red[2048 + (w * 4 + wid) * 64 + lane]; }
            const int row = RX + rt * 16 + fr, col = cg * 64 + wid * 16 + fq * 4;
            const f32x4 sr = ld4(gr + (size_t)row * 1024 + col), sa = ld4(ga + (size_t)row * 1024 + col);
            st4(z + (size_t)row * 1024 + col, sr * v0 + sa * v1);
        }
        __syncthreads();
    }
}

struct Mix {
    const bf16_t *q_r, *k_r, *kdF, *kdB, *v_rT, *g_r, *q_a, *k_a, *v_aT;
    bf16_t* states; bf16_t* ycat; const float* rd; const float* sink;
};

DI bf16x8 ldsr8(const LAS unsigned char* p) { return *(const LAS bf16x8*)p; }
DI bf16x4 ldsr4(const LAS unsigned char* p) { return *(const LAS bf16x4*)p; }
DI bf16x8 pack8i(f32x4 a, f32x4 b) { u32x4 w; w.x = pk2(a[0], b[0]); w.y = pk2(a[1], b[1]); w.z = pk2(a[2], b[2]); w.w = pk2(a[3], b[3]); return __builtin_bit_cast(bf16x8, w); }

constexpr int ATT_KP = 208, ATT_VP = 800, ATT_VOFF = 400 * ATT_KP;
struct AttPre { bf16x8 k[7]; bf16x8 v[7]; };
template <bool DOK, bool DOV> DI void attn_prefetch(AttPre& R, const Mix& M, int t, int tid) {
    asm volatile("" : "+v"(tid));
    const int b = t & 7, qb = (t >> 3) & 15, g = t >> 7, s0 = qb * 128;
    if (DOK) {
#pragma unroll
    for (int i = 0; i < 7; ++i) {
        const int c = tid + 512 * i;
        if (c < 3200) {
            const int lk = c >> 3, c16 = c & 7;
            int row;
            if (lk < 384) { int sk = s0 - 128 + lk; sk = sk < 0 ? 0 : (sk > 2047 ? 2047 : sk); row = b * 2048 + sk; } else row = RX + b * 16 + (lk - 384);
            R.k[i] = ld8(M.k_a + (size_t)row * 128 + g * 64 + c16 * 8);
        }
    }
    }
    if (DOV) {
#pragma unroll
    for (int i = 0; i < 7; ++i) {
        const int c = tid + 512 * i;
        if (c < 3200) {
            const int e = c / 50, c16 = c - e * 50;
            int pp = (c16 < 48) ? (s0 + c16 * 8) : (112 + (c16 - 48) * 8);
            pp = pp > LP - 8 ? LP - 8 : pp;
            R.v[i] = ld8(M.v_aT + ((size_t)(b * 2 + g) * 64 + e) * LP + pp);
        }
    }
    }
}
DI void attn_commit(const AttPre& R, LAS unsigned char* lds, int tid) {
    asm volatile("" : "+v"(tid));
#pragma unroll
    for (int i = 0; i < 7; ++i) { const int c = tid + 512 * i; if (c < 3200) *(LAS bf16x8*)(lds + (c >> 3) * ATT_KP + (c & 7) * 16) = R.k[i]; }
#pragma unroll
    for (int i = 0; i < 7; ++i) { const int c = tid + 512 * i; if (c < 3200) { const int e = c / 50, c16 = c - e * 50; *(LAS bf16x8*)(lds + ATT_VOFF + e * ATT_VP + c16 * 16) = R.v[i]; } }
}
template <class Hook> DI void attn_wave(const Mix& M, const LAS unsigned char* lds, int b, int hq, int s0, int w, bf16x8 q0, bf16x8 q1, int lane, const Hook& hook) {
    asm volatile("" : "+v"(lane));
    const int fr = lane & 15, fq = lane >> 4;
    const int s = s0 + 16 * w + fr;
    const int rowq = (w >= 0) ? (b * 2048 + s) : (RX + b * 16 + fr);
    const int blk_lo = (w >= 0) ? (w >> 1) : 0;
    const LAS unsigned char* kb = lds + (32 * blk_lo + (fr >> 2) * 8 + 2 * (fr & 3)) * ATT_KP + fq * 16;
    f32x4 sa[9], sb[9], sm;
#pragma unroll
    for (int i0 = 0; i0 < 9; i0 += 3) {
        bf16x8 ka[3][2], kc[3][2];
#pragma unroll
        for (int u = 0; u < 3; ++u) {
            const int i = i0 + u;
            ka[u][0] = ldsr8(kb + i * 32 * ATT_KP); ka[u][1] = ldsr8(kb + i * 32 * ATT_KP + 64);
            kc[u][0] = ldsr8(kb + i * 32 * ATT_KP + ATT_KP); kc[u][1] = ldsr8(kb + i * 32 * ATT_KP + ATT_KP + 64);
        }
        SB();
#pragma unroll
        for (int u = 0; u < 3; ++u) {
            f32x4 a = {0.f, 0.f, 0.f, 0.f}, c = {0.f, 0.f, 0.f, 0.f};
            a = mfma16(ka[u][0], q0, a); a = mfma16(ka[u][1], q1, a);
            c = mfma16(kc[u][0], q0, c); c = mfma16(kc[u][1], q1, c);
            sa[i0 + u] = a; sb[i0 + u] = c;
        }
        SB();
    }
    {
        const LAS unsigned char* km = lds + (384 + fr) * ATT_KP + fq * 16;
        const bf16x8 k0 = ldsr8(km), k1 = ldsr8(km + 64);
        f32x4 a = {0.f, 0.f, 0.f, 0.f};
        a = mfma16(k0, q0, a); a = mfma16(k1, q1, a); sm = a;
    }
    const float sink = M.sink[hq];
    float mx = sink;
#pragma unroll
    for (int i = 0; i < 9; ++i)
#pragma unroll
        for (int jj = 0; jj < 4; ++jj) {
            const int ska = s0 - 128 + 32 * (blk_lo + i) + fq * 8 + 2 * jj; const int da = s - ska;
            const bool oka = (ska >= 0) && (ska < 2048) && (da <= 128) && (da >= -128);
            const bool okb = (ska + 1 >= 0) && (ska + 1 < 2048) && (da - 1 <= 128) && (da - 1 >= -128);
            const float va = oka ? sa[i][jj] : -1e30f, vb = okb ? sb[i][jj] : -1e30f;
            sa[i][jj] = va; sb[i][jj] = vb; mx = fmaxf(mx, fmaxf(va, vb));
        }
#pragma unroll
    for (int jj = 0; jj < 4; ++jj) mx = fmaxf(mx, sm[jj]);
    mx = fmaxf(mx, __shfl_xor(mx, 16)); mx = fmaxf(mx, __shfl_xor(mx, 32));
    float sum = 0.f;
    bf16x8 py[9], pym;
#pragma unroll
    for (int i = 0; i < 9; ++i) {
#pragma unroll
        for (int jj = 0; jj < 4; ++jj) { const float p0 = __expf(sa[i][jj] - mx), p1 = __expf(sb[i][jj] - mx); sa[i][jj] = p0; sb[i][jj] = p1; sum += p0 + p1; }
        py[i] = pack8i(sa[i], sb[i]);
    }
    {
#pragma unroll
        for (int jj = 0; jj < 4; ++jj) { const float p0 = __expf(sm[jj] - mx); sm[jj] = p0; sum += p0; }
        pym = pack8(sm, (f32x4){0.f, 0.f, 0.f, 0.f});
    }
    sum += __shfl_xor(sum, 16); sum += __shfl_xor(sum, 32);
    sum += __expf(sink - mx);
    SB(); hook(); SB();
    f32x4 o[4];
#pragma unroll
    for (int ef = 0; ef < 4; ++ef) o[ef] = (f32x4){0.f, 0.f, 0.f, 0.f};
    const LAS unsigned char* vb = lds + ATT_VOFF + fr * ATT_VP + (32 * blk_lo + fq * 8) * 2;
#pragma unroll
    for (int i0 = 0; i0 < 9; i0 += 3) {
        bf16x8 vx[3][4];
#pragma unroll
        for (int u = 0; u < 3; ++u)
#pragma unroll
            for (int ef = 0; ef < 4; ++ef) vx[u][ef] = ldsr8(vb + ef * 16 * ATT_VP + (i0 + u) * 64);
        SB();
#pragma unroll
        for (int u = 0; u < 3; ++u)
#pragma unroll
            for (int ef = 0; ef < 4; ++ef) o[ef] = mfma16(vx[u][ef], py[i0 + u], o[ef]);
        SB();
    }
    {
        const LAS unsigned char* vm = lds + ATT_VOFF + fr * ATT_VP + (384 + fq * 4) * 2;
        const bf16x4 z4 = {0, 0, 0, 0};
#pragma unroll
        for (int ef = 0; ef < 4; ++ef) o[ef] = mfma16(cat8(ldsr4(vm + ef * 16 * ATT_VP), z4), pym, o[ef]);
    }
    const float inv = 1.0f / sum;
#pragma unroll
    for (int ef = 0; ef < 4; ef += 2) st_pair16(M.ycat + (size_t)rowq * 1536 + 1024 + hq * 64 + ef * 16, o[ef] * inv, o[ef + 1] * inv, fq);
}
DI void attn_phase(const Mix& M, LAS unsigned char* lds, int first, int step, int count) {
    const int tid = otid(), wid = __builtin_amdgcn_readfirstlane(tid >> 6), lane = tid & 63, fr = lane & 15, fq = lane >> 4;
    AttPre R;
    if (count > 0) attn_prefetch<true, true>(R, M, first, tid);
    for (int k = 0; k < count; ++k) {
        const int t = first + k * step;
        const int b = t & 7, qb = (t >> 3) & 15, g = t >> 7;
        const int rowq = b * 2048 + qb * 128 + 16 * wid + fr;
        bf16x8 q[4][2];
#pragma unroll
        for (int hh = 0; hh < 4; ++hh) { q[hh][0] = ld8(M.q_a + (size_t)rowq * 512 + (g * 4 + hh) * 64 + fq * 8); q[hh][1] = ld8(M.q_a + (size_t)rowq * 512 + (g * 4 + hh) * 64 + 32 + fq * 8); }
        __syncthreads();
        attn_commit(R, lds, tid);
        __syncthreads();
        const bool more = (k + 1 < count);
        if (more) attn_prefetch<true, true>(R, M, t + step, tid);
#pragma unroll
        for (int hh = 0; hh < 4; ++hh) attn_wave(M, lds, b, g * 4 + hh, qb * 128, wid, q[hh][0], q[hh][1], lane, [] {});
        if (qb == 0 && wid < 4) {
            const int rowm = RX + b * 16 + fr; const int hq = g * 4 + wid;
            const bf16x8 m0 = ld8(M.q_a + (size_t)rowm * 512 + hq * 64 + fq * 8), m1 = ld8(M.q_a + (size_t)rowm * 512 + hq * 64 + 32 + fq * 8);
            attn_wave(M, lds, b, hq, 0, -1, m0, m1, lane, [] {});
        }
    }
    __syncthreads();
}

constexpr int SC_P = 288, SC_KB = 64 * SC_P, SC_BUF = SC_KB + 64 * SC_P;
static_assert(2 * SC_BUF <= LDS_MAIN, "lds");
struct ScanPre { bf16x8 k[2]; bf16x8 v[2]; };
DI void scan_prefetch(ScanPre& R, const bf16_t* kd, const bf16_t* vt, int n, int tid) {
    asm volatile("" : "+v"(tid));
#pragma unroll
    for (int i = 0; i < 2; ++i) { const int c = tid + 512 * i; R.k[i] = ld8(kd + (size_t)(c >> 4) * LP + 128 * n + (c & 15) * 8); R.v[i] = ld8(vt + (size_t)(c >> 4) * LP + 128 * n + (c & 15) * 8); }
}
DI void scan_commit(const ScanPre& R, LAS unsigned char* buf, int tid) {
    asm volatile("" : "+v"(tid));
#pragma unroll
    for (int i = 0; i < 2; ++i) { const int c = tid + 512 * i; *(LAS bf16x8*)(buf + (c >> 4) * SC_P + (c & 15) * 16) = R.k[i]; *(LAS bf16x8*)(buf + SC_KB + (c >> 4) * SC_P + (c & 15) * 16) = R.v[i]; }
}
DI void scan_block(const Mix& M, LAS unsigned char* lds, int item) {
    const int tid = otid(), wid = __builtin_amdgcn_readfirstlane(tid >> 6), lane = tid & 63, fr = lane & 15, fq = lane >> 4;
    const int xq = item & 7, yq = item >> 3;
    const int eh = yq & 1, dir = (yq >> 1) & 1, bh = (yq >> 2) * 8 + xq, h = bh & 7;
    const int efl = wid & 3, dh = wid >> 2;
    const bf16_t* kd = (dir ? M.kdB : M.kdF) + (size_t)bh * 64 * LP;
    const bf16_t* vt = M.v_rT + ((size_t)bh * 128 + eh * 64) * LP;
    const float lg = -__expf(M.rd[dir * 8 + h]); const float gC = __expf(lg * 128.0f);
    bf16_t* sbase = M.states + (((size_t)bh * NCH) * 2 + dir) * 128 * 64 + (size_t)(eh * 64 + efl * 16 + fr) * 64 + dh * 32 + fq * 4;
    f32x4 acc[2];
#pragma unroll
    for (int df = 0; df < 2; ++df) acc[df] = (f32x4){0.f, 0.f, 0.f, 0.f};
    ScanPre ring[4];
#pragma unroll
    for (int s0 = 0; s0 < 4; ++s0) scan_prefetch(ring[s0], kd, vt, dir ? (16 - s0) : s0, tid);
    __syncthreads();
#pragma unroll
    for (int s = 0; s < 16; ++s) {
        LAS unsigned char* buf = lds + (s & 1) * SC_BUF;
        scan_commit(ring[s & 3], buf, tid);
        if (s + 4 < 16) scan_prefetch(ring[s & 3], kd, vt, dir ? (16 - (s + 4)) : (s + 4), tid);
        __syncthreads();
        const int n = dir ? (16 - s) : s;
        bf16_t* sp = sbase + (size_t)n * 2 * 128 * 64;
        st_pair16(sp - fq * 4, acc[0], acc[1], fq);
#pragma unroll
        for (int df = 0; df < 2; ++df) acc[df] *= gC;
        const LAS unsigned char* kp = buf + (dh * 32 + fr) * SC_P + fq * 16;
        const LAS unsigned char* vp = buf + SC_KB + (efl * 16 + fr) * SC_P + fq * 16;
        bf16x8 vy[4], kx[4][2];
#pragma unroll
        for (int ks = 0; ks < 4; ++ks) { vy[ks] = ldsr8(vp + ks * 64);
#pragma unroll
            for (int df = 0; df < 2; ++df) kx[ks][df] = ldsr8(kp + df * 16 * SC_P + ks * 64); }
        SB();
#pragma unroll
        for (int ks = 0; ks < 4; ++ks)
#pragma unroll
            for (int df = 0; df < 2; ++df) acc[df] = mfma16(kx[ks][df], vy[ks], acc[df]);
        SB();
    }
    {
        bf16_t* sp = sbase + (size_t)(dir ? 0 : 16) * 2 * 128 * 64;
        st_pair16(sp - fq * 4, acc[0], acc[1], fq);
    }
    __syncthreads();
}

DI void ret_item(const Mix& M, int b, int h, int n, int iq) {
    const int lane = otid() & 63, fr = lane & 15, fq = lane >> 4;
    const int i = 16 * iq + fr;
    const int rowq = n ? (b * 2048 + (n - 1) * 128 + i) : (RX + b * 16 + (i - 112));
    bf16x8 qy[2];
#pragma unroll
    for (int ks = 0; ks < 2; ++ks) qy[ks] = ld8(M.q_r + (size_t)rowq * 512 + h * 64 + ks * 32 + fq * 8);
    const float lgf = -__expf(M.rd[h]), lgb = -__expf(M.rd[8 + h]);
    const float cf = __expf(lgf * (float)(i + 1)), cb = __expf(lgb * (float)(128 - i));
    const bf16_t* SF = M.states + (((size_t)(b * 8 + h) * NCH + n) * 2 + 0) * 128 * 64 + (size_t)fr * 64 + fq * 8;
    const bf16_t* SBk = SF + 128 * 64;
    const bf16_t* vbase = M.v_rT + ((size_t)(b * 8 + h) * 128 + fr) * LP + 128 * n + fq * 4;
    bf16x8 sfx[8][2], kx[8][2];
#pragma unroll
    for (int ef = 0; ef < 8; ++ef)
#pragma unroll
        for (int ks = 0; ks < 2; ++ks) sfx[ef][ks] = ld8(SF + (size_t)ef * 16 * 64 + ks * 32);
#pragma unroll
    for (int jf = 0; jf < 8; ++jf) {
        const int j = 16 * jf + fr;
        int jm = j - 112; jm = jm < 0 ? 0 : jm;
        const int rowk = n ? (b * 2048 + (n - 1) * 128 + j) : (RX + b * 16 + jm);
        const bf16_t* kp = M.k_r + (size_t)rowk * 512 + h * 64 + fq * 8;
        kx[jf][0] = ld8(kp); kx[jf][1] = ld8(kp + 32);
    }
    SB();
    f32x4 o[8];
#pragma unroll
    for (int ef = 0; ef < 8; ++ef) {
        f32x4 t = {0.f, 0.f, 0.f, 0.f};
        t = mfma16(sfx[ef][0], qy[0], t); t = mfma16(sfx[ef][1], qy[1], t);
        o[ef] = t * cf;
    }
    f32x4 st[8];
#pragma unroll
    for (int jf = 0; jf < 8; ++jf) {
        f32x4 t = {0.f, 0.f, 0.f, 0.f};
        t = mfma16(kx[jf][0], qy[0], t); t = mfma16(kx[jf][1], qy[1], t);
        st[jf] = t;
    }
    SB();
    bf16x8 sbx[8][2];
#pragma unroll
    for (int ef = 0; ef < 8; ++ef)
#pragma unroll
        for (int ks = 0; ks < 2; ++ks) sbx[ef][ks] = ld8(SBk + (size_t)ef * 16 * 64 + ks * 32);
    bf16x4 va[2][8][2];
#pragma unroll
    for (int pr = 0; pr < 2; ++pr)
#pragma unroll
        for (int ef = 0; ef < 8; ++ef) { va[pr][ef][0] = ld4s(vbase + (size_t)ef * 16 * LP + 32 * pr); va[pr][ef][1] = ld4s(vbase + (size_t)ef * 16 * LP + 32 * pr + 16); }
    SB();
#pragma unroll
    for (int ef = 0; ef < 8; ++ef) {
        f32x4 t = {0.f, 0.f, 0.f, 0.f};
        t = mfma16(sbx[ef][0], qy[0], t); t = mfma16(sbx[ef][1], qy[1], t);
        o[ef] += t * cb;
    }
    bf16x8 py[4];
#pragma unroll
    for (int pr = 0; pr < 4; ++pr) {
#pragma unroll
        for (int hh = 0; hh < 2; ++hh) {
            const int jf = 2 * pr + hh;
#pragma unroll
            for (int jj = 0; jj < 4; ++jj) {
                const int jv = 16 * jf + fq * 4 + jj; const int d = i - jv;
                float w = (d >= 0) ? __expf(lgf * (float)d) : __expf(lgb * (float)(-d));
                if (n == 0 && jv < 112) w = 0.f;
                st[jf][jj] *= w;
            }
        }
        py[pr] = pack8(st[2 * pr], st[2 * pr + 1]);
    }
    SB();
    bf16x4 vb[2][8][2];
#pragma unroll
    for (int pr = 0; pr < 2; ++pr)
#pragma unroll
        for (int ef = 0; ef < 8; ++ef) { vb[pr][ef][0] = ld4s(vbase + (size_t)ef * 16 * LP + 32 * (pr + 2)); vb[pr][ef][1] = ld4s(vbase + (size_t)ef * 16 * LP + 32 * (pr + 2) + 16); }
    u32x2 gx[8];
#pragma unroll
    for (int ef = 0; ef < 8; ++ef) gx[ef] = *(const u32x2*)(M.g_r + (size_t)rowq * 1024 + h * 128 + ef * 16 + fq * 4);
    SB();
#pragma unroll
    for (int pr = 0; pr < 2; ++pr)
#pragma unroll
        for (int ef = 0; ef < 8; ++ef) o[ef] = mfma16(cat8(va[pr][ef][0], va[pr][ef][1]), py[pr], o[ef]);
#pragma unroll
    for (int pr = 0; pr < 2; ++pr)
#pragma unroll
        for (int ef = 0; ef < 8; ++ef) o[ef] = mfma16(cat8(vb[pr][ef][0], vb[pr][ef][1]), py[pr + 2], o[ef]);
    float s = 0.f;
#pragma unroll
    for (int ef = 0; ef < 8; ++ef) s += (o[ef][0] + o[ef][1]) + (o[ef][2] + o[ef][3]);
    s += __shfl_xor(s, 16); s += __shfl_xor(s, 32);
    const float mean = s * (1.0f / 128.0f);
    float q = 0.f;
#pragma unroll
    for (int ef = 0; ef < 8; ++ef) { const f32x4 d = o[ef] - mean; q += (d[0] * d[0] + d[1] * d[1]) + (d[2] * d[2] + d[3] * d[3]); }
    q += __shfl_xor(q, 16); q += __shfl_xor(q, 32);
    const float rstd = rsqrtf(q * (1.0f / 128.0f) + EPS);
#pragma unroll
    for (int ef = 0; ef < 8; ++ef) {
        f32x4 gv; gv[0] = __uint_as_float(gx[ef].x << 16); gv[1] = __uint_as_float(gx[ef].x & 0xffff0000u); gv[2] = __uint_as_float(gx[ef].y << 16); gv[3] = __uint_as_float(gx[ef].y & 0xffff0000u);
        st4(M.ycat + (size_t)rowq * 1536 + h * 128 + ef * 16 + fq * 4, (o[ef] - mean) * rstd * gv);
    }
}

constexpr int RET_KP = 208, RET_SP = 160, RET_VP = 288;
constexpr int RET_SFOFF = 128 * RET_KP, RET_SBOFF = RET_SFOFF + 128 * RET_SP, RET_VOFF = RET_SBOFF + 128 * RET_SP;
static_assert(RET_VOFF + 128 * RET_VP <= LDS_MAIN, "lds");
struct RetPre { bf16x8 k[2], sf[2], sb[2], v[4], q[2]; };
DI void ret_prefetch(RetPre& R, const Mix& M, int t, int tid) {
    asm volatile("" : "+v"(tid));
    const int n = (t & 15) + 1, bh = t >> 4, b = bh >> 3, h = bh & 7;
    const int wid = tid >> 6, lane = tid & 63, fr = lane & 15, fq = lane >> 4;
    const bf16_t* SF = M.states + (((size_t)bh * NCH + n) * 2 + 0) * 128 * 64;
#pragma unroll
    for (int i = 0; i < 2; ++i) {
        const int c = tid + 512 * i;
        R.k[i] = ld8(M.k_r + (size_t)(b * 2048 + (n - 1) * 128 + (c >> 3)) * 512 + h * 64 + (c & 7) * 8);
        R.sf[i] = ld8(SF + (size_t)c * 8); R.sb[i] = ld8(SF + 128 * 64 + (size_t)c * 8);
    }
#pragma unroll
    for (int i = 0; i < 4; ++i) { const int c = tid + 512 * i; R.v[i] = ld8(M.v_rT + ((size_t)bh * 128 + (c >> 4)) * LP + 128 * n + (c & 15) * 8); }
    const int rowq = b * 2048 + (n - 1) * 128 + 16 * wid + fr;
    R.q[0] = ld8(M.q_r + (size_t)rowq * 512 + h * 64 + fq * 8); R.q[1] = ld8(M.q_r + (size_t)rowq * 512 + h * 64 + 32 + fq * 8);
}
DI void ret_commit(const RetPre& R, LAS unsigned char* lds, int tid) {
    asm volatile("" : "+v"(tid));
#pragma unroll
    for (int i = 0; i < 2; ++i) {
        const int c = tid + 512 * i;
        *(LAS bf16x8*)(lds + (c >> 3) * RET_KP + (c & 7) * 16) = R.k[i];
        *(LAS bf16x8*)(lds + RET_SFOFF + (c >> 3) * RET_SP + (c & 7) * 16) = R.sf[i];
        *(LAS bf16x8*)(lds + RET_SBOFF + (c >> 3) * RET_SP + (c & 7) * 16) = R.sb[i];
    }
#pragma unroll
    for (int i = 0; i < 4; ++i) { const int c = tid + 512 * i; *(LAS bf16x8*)(lds + RET_VOFF + (c >> 4) * RET_VP + (c & 15) * 16) = R.v[i]; }
}
DI void ret_wave(const Mix& M, const LAS unsigned char* lds, int b, int h, int n, int w, bf16x8 q0, bf16x8 q1, int lane) {
    asm volatile("" : "+v"(lane));
    const int fr = lane & 15, fq = lane >> 4;
    const int i = 16 * w + fr;
    const int rowq = b * 2048 + (n - 1) * 128 + i;
    u32x2 gx[8];
#pragma unroll
    for (int ef = 0; ef < 8; ++ef) gx[ef] = *(const u32x2*)(M.g_r + (size_t)rowq * 1024 + h * 128 + ef * 16 + fq * 4);
    const float lgf = -__expf(M.rd[h]), lgb = -__expf(M.rd[8 + h]);
    const float cf = __expf(lgf * (float)(i + 1)), cb = __expf(lgb * (float)(128 - i));
    f32x4 o[8];
    const LAS unsigned char* sfp = lds + RET_SFOFF + fr * RET_SP + fq * 16;
    const LAS unsigned char* sbp = lds + RET_SBOFF + fr * RET_SP + fq * 16;
#pragma unroll
    for (int e0 = 0; e0 < 8; e0 += 4) {
        bf16x8 xf[4][2], xb[4][2];
#pragma unroll
        for (int u = 0; u < 4; ++u) { const int ef = e0 + u;
            xf[u][0] = ldsr8(sfp + ef * 16 * RET_SP); xf[u][1] = ldsr8(sfp + ef * 16 * RET_SP + 64);
            xb[u][0] = ldsr8(sbp + ef * 16 * RET_SP); xb[u][1] = ldsr8(sbp + ef * 16 * RET_SP + 64); }
        SB();
#pragma unroll
        for (int u = 0; u < 4; ++u) {
            f32x4 t = {0.f, 0.f, 0.f, 0.f}, t2 = {0.f, 0.f, 0.f, 0.f};
            t = mfma16(xf[u][0], q0, t); t = mfma16(xf[u][1], q1, t);
            t2 = mfma16(xb[u][0], q0, t2); t2 = mfma16(xb[u][1], q1, t2);
            o[e0 + u] = t * cf + t2 * cb;
        }
        SB();
    }
    const LAS unsigned char* kb = lds + ((fr >> 2) * 8 + 2 * (fr & 3)) * RET_KP + fq * 16;
    bf16x8 py[4];
    bf16x8 kxa[4][2], kxc[4][2];
#pragma unroll
    for (int blk = 0; blk < 4; ++blk) {
        kxa[blk][0] = ldsr8(kb + blk * 32 * RET_KP); kxa[blk][1] = ldsr8(kb + blk * 32 * RET_KP + 64);
        kxc[blk][0] = ldsr8(kb + blk * 32 * RET_KP + RET_KP); kxc[blk][1] = ldsr8(kb + blk * 32 * RET_KP + RET_KP + 64);
    }
    SB();
#pragma unroll
    for (int blk = 0; blk < 4; ++blk) {
        f32x4 a = {0.f, 0.f, 0.f, 0.f}, c = {0.f, 0.f, 0.f, 0.f};
        a = mfma16(kxa[blk][0], q0, a); a = mfma16(kxa[blk][1], q1, a);
        c = mfma16(kxc[blk][0], q0, c); c = mfma16(kxc[blk][1], q1, c);
#pragma unroll
        for (int jj = 0; jj < 4; ++jj) {
            const int ja = 32 * blk + fq * 8 + 2 * jj; const int da = i - ja, db = da - 1;
            a[jj] *= (da >= 0) ? __expf(lgf * (float)da) : __expf(lgb * (float)(-da));
            c[jj] *= (db >= 0) ? __expf(lgf * (float)db) : __expf(lgb * (float)(-db));
        }
        py[blk] = pack8i(a, c);
    }
    const LAS unsigned char* vp = lds + RET_VOFF + fr * RET_VP + fq * 16;
    SB();
#pragma unroll
    for (int blk = 0; blk < 4; blk += 2) {
        bf16x8 vx[2][8];
#pragma unroll
        for (int u = 0; u < 2; ++u)
#pragma unroll
            for (int ef = 0; ef < 8; ++ef) vx[u][ef] = ldsr8(vp + ef * 16 * RET_VP + (blk + u) * 64);
        SB();
#pragma unroll
        for (int u = 0; u < 2; ++u)
#pragma unroll
            for (int ef = 0; ef < 8; ++ef) o[ef] = mfma16(vx[u][ef], py[blk + u], o[ef]);
        SB();
    }
    float s = 0.f;
#pragma unroll
    for (int ef = 0; ef < 8; ++ef) s += (o[ef][0] + o[ef][1]) + (o[ef][2] + o[ef][3]);
    s += __shfl_xor(s, 16); s += __shfl_xor(s, 32);
    const float mean = s * (1.0f / 128.0f);
    float q = 0.f;
#pragma unroll
    for (int ef = 0; ef < 8; ++ef) { const f32x4 d = o[ef] - mean; q += (d[0] * d[0] + d[1] * d[1]) + (d[2] * d[2] + d[3] * d[3]); }
    q += __shfl_xor(q, 16); q += __shfl_xor(q, 32);
    const float rstd = rsqrtf(q * (1.0f / 128.0f) + EPS);
#pragma unroll
    for (int ef = 0; ef < 8; ef += 2) {
        f32x4 gv, gw;
        gv[0] = __uint_as_float(gx[ef].x << 16); gv[1] = __uint_as_float(gx[ef].x & 0xffff0000u); gv[2] = __uint_as_float(gx[ef].y << 16); gv[3] = __uint_as_float(gx[ef].y & 0xffff0000u);
        gw[0] = __uint_as_float(gx[ef + 1].x << 16); gw[1] = __uint_as_float(gx[ef + 1].x & 0xffff0000u); gw[2] = __uint_as_float(gx[ef + 1].y << 16); gw[3] = __uint_as_float(gx[ef + 1].y & 0xffff0000u);
        st_pair16(M.ycat + (size_t)rowq * 1536 + h * 128 + ef * 16, (o[ef] - mean) * rstd * gv, (o[ef + 1] - mean) * rstd * gw, fq);
    }
}
DI void ret_phase(const Mix& M, LAS unsigned char* lds) {
    const int tid = otid(), wid = __builtin_amdgcn_readfirstlane(tid >> 6), lane = tid & 63;
    const int G = gridDim.x;
    int t = blockIdx.x;
    RetPre R;
    if (t < 1024) ret_prefetch(R, M, t, tid);
    for (; t < 1024; t += G) {
        __syncthreads();
        ret_commit(R, lds, tid);
        const bf16x8 q0 = R.q[0], q1 = R.q[1];
        __syncthreads();
        if (t + G < 1024) ret_prefetch(R, M, t + G, tid);
        const int n = (t & 15) + 1, bh = t >> 4;
        ret_wave(M, lds, bh >> 3, bh & 7, n, wid, q0, q1, lane);
    }
    __syncthreads();
}

DI bf16_t* hrow(const Params& P, int row) { return (bf16_t*)(P.ws + WS_ST) + (size_t)row * 1024; }
template <int NB>
DI void rowpass_rows(const Params& P, const bf16_t* t, const float* gpost, const float* gpre, float* rs, int row0, int rstride, int lane) {
    f32x4 hv[NB][4]; u32x2 tr[NB][4], hr[NB][4];
#pragma unroll
    for (int r = 0; r < NB; ++r) {
        const int row = row0 + r * rstride;
        const bf16_t* hp = hrow(P, row); const bf16_t* tp = t + (size_t)row * 1024;
#pragma unroll
        for (int k = 0; k < 4; ++k) { tr[r][k] = *(const u32x2*)(tp + (k * 64 + lane) * 4); hr[r][k] = *(const u32x2*)(hp + (k * 64 + lane) * 4); }
    }
    f32x4 gp[4];
#pragma unroll
    for (int k = 0; k < 4; ++k) gp[k] = *(const f32x4*)(gpost + (k * 64 + lane) * 4);
    SB();
    float s2[NB];
#pragma unroll
    for (int r = 0; r < NB; ++r) {
        f32x4 tv[4]; float ss = 0.f;
#pragma unroll
        for (int k = 0; k < 4; ++k) {
            tv[k][0] = __uint_as_float(tr[r][k].x << 16); tv[k][1] = __uint_as_float(tr[r][k].x & 0xffff0000u); tv[k][2] = __uint_as_float(tr[r][k].y << 16); tv[k][3] = __uint_as_float(tr[r][k].y & 0xffff0000u);
            hv[r][k][0] = __uint_as_float(hr[r][k].x << 16); hv[r][k][1] = __uint_as_float(hr[r][k].x & 0xffff0000u); hv[r][k][2] = __uint_as_float(hr[r][k].y << 16); hv[r][k][3] = __uint_as_float(hr[r][k].y & 0xffff0000u);
            ss += (tv[k][0] * tv[k][0] + tv[k][1] * tv[k][1]) + (tv[k][2] * tv[k][2] + tv[k][3] * tv[k][3]);
        }
        ss = wsum(ss);
        const float sc = rsqrtf(ss * (1.0f / 1024.0f) + EPS);
        const int row = row0 + r * rstride;
        bf16_t* hp = hrow(P, row);
        float q = 0.f;
#pragma unroll
        for (int k = 0; k < 4; ++k) { hv[r][k] += tv[k] * sc * gp[k];
            if (gpre) st4(hp + (k * 64 + lane) * 4, hv[r][k]); else if (row < RX) *(f32x4*)(P.out + (size_t)row * 1024 + (k * 64 + lane) * 4) = hv[r][k];
            q += (hv[r][k][0] * hv[r][k][0] + hv[r][k][1] * hv[r][k][1]) + (hv[r][k][2] * hv[r][k][2] + hv[r][k][3] * hv[r][k][3]); }
        s2[r] = q;
    }
    if (gpre) {
#pragma unroll
        for (int r = 0; r < NB; ++r) {
            const float sc2 = rsqrtf(wsum(s2[r]) * (1.0f / 1024.0f) + EPS);
            if (lane == 0) rs[row0 + r * rstride] = sc2;
        }
    }
}
DI void rowpass(const Params& P, const bf16_t* t, const float* gpost, const float* gpre, float* u, int gw, int nw) {
    const int lane = otid() & 63;
    for (int base = gw; base < RX; base += nw * 4) {
        if (base + 3 * nw < RX) rowpass_rows<4>(P, t, gpost, gpre, u, base, nw, lane);
        else for (int row = base; row < RX; row += nw) rowpass_rows<1>(P, t, gpost, gpre, u, row, 0, lane);
    }
    for (int row = RX + gw; row < RT; row += nw) rowpass_rows<1>(P, t, gpost, gpre, u, row, 0, lane);
}
DI void rowinit(const Params& P, float* rs, int gw, int nw) {
    const int lane = otid() & 63;
    for (int row = gw; row < RT; row += nw) {
        bf16_t* hp = hrow(P, row);
        const float* src = row < RX ? P.x + (size_t)row * 1024 : P.meta + (size_t)((row - RX) & 15) * 1024;
        f32x4 hv[4]; float s2 = 0.f;
#pragma unroll
        for (int k = 0; k < 4; ++k) hv[k] = *(const f32x4*)(src + (k * 64 + lane) * 4);
        SB();
#pragma unroll
        for (int k = 0; k < 4; ++k) { st4(hp + (k * 64 + lane) * 4, hv[k]);
            s2 += (hv[k][0] * hv[k][0] + hv[k][1] * hv[k][1]) + (hv[k][2] * hv[k][2] + hv[k][3] * hv[k][3]); }
        s2 = wsum(s2);
        if (lane == 0) rs[row] = rsqrtf(s2 * (1.0f / 1024.0f) + EPS);
    }
}

DI int perm64(int mode, int w) { return mode == 1 ? ((w >> 1) + 32 * (w & 1)) : (mode == 2 ? (w < 16 ? ((w >> 1) + 8 * (w & 1)) : w) : w); }
struct ConvJob { const float* W; bf16_t* Bt; const float* gain; int ncols, k0, n0, ldb, koff, mode; };
DI ConvJob conv_decode(const Params& P, int l, int job) {
    unsigned char* wb = P.ws + WS_W;
    ConvJob J; int j = job; J.gain = nullptr;
    if (j < 1472) { J.gain = P.n_mix_pre + l * 1024; const int nt = j % 92, kt = j / 92; const int c0 = nt * 64;
        J.W = P.w_in + (size_t)l * 1024 * DIN; J.ncols = DIN; J.k0 = kt * 64; J.n0 = c0; J.Bt = (bf16_t*)(wb + W_IN); J.ldb = 1024; J.koff = 0;
        J.mode = c0 < 1024 ? 1 : ((c0 >= 3072 && c0 < 3712) ? 2 : 0); return J; }
    j -= 1472; J.mode = 0; J.koff = 0; J.ncols = 1024;
    if (j < 256) { J.W = P.w_ret_o + (size_t)l * 1024 * 1024; J.k0 = (j >> 4) * 64; J.n0 = (j & 15) * 64; J.Bt = (bf16_t*)(wb + W_CAT); J.ldb = 1536; return J; }
    j -= 256;
    if (j < 128) { J.W = P.w_att_o + (size_t)l * 512 * 1024; J.k0 = (j >> 4) * 64; J.n0 = (j & 15) * 64; J.Bt = (bf16_t*)(wb + W_CAT); J.ldb = 1536; J.koff = 1024; return J; }
    j -= 128;
    if (j < 256) { J.W = P.w_mix_o + (size_t)l * 1024 * 1024; J.k0 = (j >> 4) * 64; J.n0 = (j & 15) * 64; J.Bt = (bf16_t*)(wb + W_MIX); J.ldb = 1024; return J; }
    j -= 256;
    if (j < 1024) { J.gain = P.n_ff_pre + l * 1024; J.W = P.w_ff1 + (size_t)l * 1024 * 4096; J.ncols = 4096; J.k0 = (j >> 6) * 64; J.n0 = (j & 63) * 64; J.Bt = (bf16_t*)(wb + W_FF1); J.ldb = 1024; return J; }
    j -= 1024;
    J.W = P.w_ff2 + (size_t)l * 4096 * 1024; J.k0 = (j >> 4) * 64; J.n0 = (j & 15) * 64; J.Bt = (bf16_t*)(wb + W_FF2); J.ldb = 4096; return J;
}
DI void convert_weights(const Params& P, int l, LAS unsigned char* lds) {
    LAS float* tiles = (LAS float*)lds;
    const int t = otid();
    const int G = gridDim.x;
    for (int base = blockIdx.x; base < 4160; base += 4 * G) {
        ConvJob J[4]; f32x4 v[4][2];
#pragma unroll
        for (int q = 0; q < 4; ++q) {
            const int job = base + q * G;
            if (job < 4160) {
                J[q] = conv_decode(P, l, job);
#pragma unroll
                for (int rep = 0; rep < 2; ++rep) { const int kk = (t >> 4) + 32 * rep, nn = (t & 15) * 4; v[q][rep] = *(const f32x4*)(J[q].W + (size_t)(J[q].k0 + kk) * J[q].ncols + J[q].n0 + nn);
                    if (J[q].gain) v[q][rep] *= J[q].gain[J[q].k0 + kk]; }
            }
        }
        SB();
#pragma unroll
        for (int q = 0; q < 4; ++q) {
            if (base + q * G < 4160) {
                LAS float* tile = tiles + q * 4160;
#pragma unroll
                for (int rep = 0; rep < 2; ++rep) { const int kk = (t >> 4) + 32 * rep, nn = (t & 15) * 4;
                    tile[kk * 65 + nn] = v[q][rep][0]; tile[kk * 65 + nn + 1] = v[q][rep][1]; tile[kk * 65 + nn + 2] = v[q][rep][2]; tile[kk * 65 + nn + 3] = v[q][rep][3]; }
            }
        }
        __syncthreads();
#pragma unroll
        for (int q = 0; q < 4; ++q) {
            if (base + q * G < 4160) {
                const LAS float* tile = tiles + q * 4160;
                const int nq = t >> 3, kk8 = (t & 7) * 8, sc = perm64(J[q].mode, nq);
                u32x4 w;
                w.x = pk2(tile[(kk8 + 0) * 65 + sc], tile[(kk8 + 1) * 65 + sc]); w.y = pk2(tile[(kk8 + 2) * 65 + sc], tile[(kk8 + 3) * 65 + sc]);
                w.z = pk2(tile[(kk8 + 4) * 65 + sc], tile[(kk8 + 5) * 65 + sc]); w.w = pk2(tile[(kk8 + 6) * 65 + sc], tile[(kk8 + 7) * 65 + sc]);
                *(u32x4*)(J[q].Bt + (size_t)(J[q].n0 + nq) * J[q].ldb + J[q].koff + J[q].k0 + kk8) = w;
            }
        }
        __syncthreads();
    }
}

DI void make_tables(const Params& P) {
    float* tabR = (float*)(P.ws + WS_TABR); float* tabA = (float*)(P.ws + WS_TABA);
    const int gt = blockIdx.x * blockDim.x + otid(), nth = gridDim.x * blockDim.x;
    for (int idx = gt; idx < 2064 * 40; idx += nth) {
        int p, i; float fr; float* dst;
        if (idx < 2064 * 32) { p = idx >> 5; i = idx & 31; fr = powf(10000.0f, -(float)(2 * i) / 64.0f); dst = tabR + (size_t)idx * 2; }
        else { const int k = idx - 2064 * 32; p = k >> 3; i = k & 7; fr = powf(500000.0f, -(float)(2 * i) / 16.0f); dst = tabA + (size_t)k * 2; }
        const float ang = (float)p * fr;
        double rev = (double)ang * 0.15915494309189533576888; rev -= floor(rev);
        const float r = (float)(rev * 6.283185307179586476925);
        dst[0] = __cosf(r); dst[1] = __sinf(r);
    }
}
DI void zero_pads(const Params& P) {
    unsigned char* proj = P.ws + WS_PROJ;
    const int gt = blockIdx.x * blockDim.x + otid(), nth = gridDim.x * blockDim.x;
    const u32x4 z = {0u, 0u, 0u, 0u};
    for (int idx = gt; idx < 17408 * 14; idx += nth) {
        int r = idx / 14; const int c = idx - r * 14;
        bf16_t* base;
        if (r < 4096) base = (bf16_t*)(proj + P_KDF); else if (r < 8192) { base = (bf16_t*)(proj + P_KDB); r -= 4096; }
        else if (r < 16384) { base = (bf16_t*)(proj + P_VRT); r -= 8192; } else { base = (bf16_t*)(proj + P_VAT); r -= 16384; }
        *(u32x4*)(base + (size_t)r * LP + c * 8) = z;
    }
}

#define XB_TMO      128
#define XB_XCNT(j)  (256  + 64 * (j))
#define XB_XSUB(j)  (1280 + 64 * (j))
#define XB_XGEN(j)  (2304 + 64 * (j))
#define XB_TOP      3328
#define XB_TOPGEN   3392
#define XCD_BAR_WORDS 3456
#define XB_SPIN_CAP (1u << 22)
DI unsigned xb_ld(unsigned* p)              { return __hip_atomic_load(p, __ATOMIC_RELAXED, __HIP_MEMORY_SCOPE_AGENT); }
DI unsigned xb_add(unsigned* p, unsigned v) { return __hip_atomic_fetch_add(p, v, __ATOMIC_RELAXED, __HIP_MEMORY_SCOPE_AGENT); }
DI unsigned xb_xcc_id() { return (unsigned)__builtin_amdgcn_s_getreg((3 << 11) | 20) & 0xFu; }
#define XB_SPIN(cond, bar) do { unsigned _sp = 0; while (cond) { __builtin_amdgcn_s_sleep(1); \
    if ((++_sp & 255u) == 0u) { if (xb_ld(&(bar)[XB_TMO])) break; if (_sp > XB_SPIN_CAP) { atomicAdd(&(bar)[XB_TMO], 1u); break; } } } } while (0)
struct XcdBarrier { unsigned* bar; unsigned x; volatile LAS unsigned* st; };
DI XcdBarrier xcd_barrier_post(unsigned* bar, volatile LAS unsigned* st) {
    XcdBarrier b; b.bar = bar; b.x = xb_xcc_id(); b.st = st;
    if (threadIdx.x == 0) (void)xb_add(&bar[XB_XCNT(b.x)], 1u);
    return b;
}
DI void xcd_barrier_complete(unsigned* bar, unsigned x, unsigned& nloc, unsigned& nx) {
    const unsigned G = gridDim.x * gridDim.y * gridDim.z;
    unsigned sum, cnt, mine, sp = 0u;
    for (;;) {
        sum = 0u; cnt = 0u; mine = 0u;
#pragma unroll
        for (unsigned j = 0; j < 16; ++j) { const unsigned c = xb_ld(&bar[XB_XCNT(j)]); sum += c; cnt += (c > 0u) ? 1u : 0u; mine = (j == x) ? c : mine; }
        if (sum == G) break;
        __builtin_amdgcn_s_sleep(1);
        if ((++sp & 255u) == 0u) { if (xb_ld(&bar[XB_TMO])) break; if (sp > XB_SPIN_CAP) { atomicAdd(&bar[XB_TMO], 1u); break; } }
    }
    nloc = mine > 0u ? mine : 1u; nx = cnt > 0u ? cnt : 1u;
}
DI void xcd_barrier(const XcdBarrier& b) {
    asm volatile("s_waitcnt vmcnt(0)" ::: "memory");
    __syncthreads();
    if (threadIdx.x == 0) {
        unsigned* bar = b.bar;
        __builtin_amdgcn_s_waitcnt(0);
        unsigned nloc = b.st[0], nx = b.st[1];
        if (nloc == 0u) { xcd_barrier_complete(bar, b.x, nloc, nx); b.st[0] = nloc; b.st[1] = nx; }
        const unsigned old = xb_add(&bar[XB_XSUB(b.x)], 1u);
        const unsigned gen = old / nloc;
        if (old + 1u == (gen + 1u) * nloc) {
            __builtin_amdgcn_fence(__ATOMIC_RELEASE, "agent");
            asm volatile("s_waitcnt vmcnt(0)" ::: "memory");
            const unsigned og = xb_add(&bar[XB_TOP], 1u);
            const unsigned tg = og / nx;
            if (og + 1u == (tg + 1u) * nx) xb_add(&bar[XB_TOPGEN], 1u);
            else XB_SPIN(xb_ld(&bar[XB_TOPGEN]) == tg, bar);
            __builtin_amdgcn_fence(__ATOMIC_ACQUIRE, "agent");
            xb_add(&bar[XB_XGEN(b.x)], 1u);
            asm volatile("s_waitcnt vmcnt(0)" ::: "memory");
        } else {
            XB_SPIN(xb_ld(&bar[XB_XGEN(b.x)]) == gen, bar);
            __builtin_amdgcn_fence(__ATOMIC_ACQUIRE, "agent");
            asm volatile("s_waitcnt vmcnt(0)" ::: "memory");
        }
    }
    __syncthreads();
}

__global__ void __launch_bounds__(512, 2) mega(Params P) {
    extern __shared__ __attribute__((aligned(16))) unsigned char lds_raw[];
    LAS unsigned char* lds = (LAS unsigned char*)lds_raw;
    cg::grid_group grid = cg::this_grid();
    if (threadIdx.x < 4) ((volatile LAS unsigned*)(lds + LDS_MAIN))[threadIdx.x] = 0u;
    __syncthreads();
    XcdBarrier xb = xcd_barrier_post((unsigned*)(P.ws + WS_BAR), (volatile LAS unsigned*)(lds + LDS_MAIN));
    const int wid = __builtin_amdgcn_readfirstlane(threadIdx.x >> 6);
    const int G = gridDim.x, nw = G * 8;
    const int gw = blockIdx.x * 8 + wid;
    const int gws = wid * G + blockIdx.x;
    unsigned char* ws = P.ws; unsigned char* proj = ws + WS_PROJ;
    bf16_t* U = (bf16_t*)(ws + WS_U); bf16_t* YC = (bf16_t*)(ws + WS_U);
    bf16_t* ST = (bf16_t*)P.out; bf16_t* Z = (bf16_t*)P.out;
    bf16_t* FFH = (bf16_t*)(proj + P_FFH); bf16_t* MIXF = (bf16_t*)(proj + P_MIX);
    const bf16_t* Win = (const bf16_t*)(ws + WS_W + W_IN); const bf16_t* Wcat = (const bf16_t*)(ws + WS_W + W_CAT);
    const bf16_t* Wmix = (const bf16_t*)(ws + WS_W + W_MIX); const bf16_t* Wff1 = (const bf16_t*)(ws + WS_W + W_FF1); const bf16_t* Wff2 = (const bf16_t*)(ws + WS_W + W_FF2);

    float* RS = (float*)(ws + WS_HMETA);
    const bf16_t* H16 = (const bf16_t*)(ws + WS_ST);
    if (P.ws == nullptr) grid.sync();

    for (int l = -1; l < 4; ++l) {
      if (l < 0) {
        make_tables(P);
        rowinit(P, RS, gw, nw);
      } else {
        for (int rep = 0; rep < REP_G1; ++rep) {
            zero_pads(P);
            EpiIn e; e.proj = proj; e.tabR = (const float*)(ws + WS_TABR); e.tabA = (const float*)(ws + WS_TABA); e.rd = P.ret_decay + l * 16; e.rs = RS;
            SchedPlain S; S.T.init(DIN); S.A = (const char*)H16; S.B = (const char*)Win; S.tstep = (size_t)256 * 1024 * 2; S.nt = 16;
            MainEpiIn me; me.e = e;
            gemm_main(lds, 1024, S, me);
            gemm_tail(lds, H16, Win, 1024, 1024, DIN, e);
        }
        xcd_barrier(xb);
        Mix M; M.q_r = (const bf16_t*)(proj + P_QR); M.k_r = (const bf16_t*)(proj + P_KR); M.kdF = (const bf16_t*)(proj + P_KDF); M.kdB = (const bf16_t*)(proj + P_KDB);
        M.v_rT = (const bf16_t*)(proj + P_VRT); M.g_r = (const bf16_t*)(proj + P_GR); M.q_a = (const bf16_t*)(proj + P_QA); M.k_a = (const bf16_t*)(proj + P_KA);
        M.v_aT = (const bf16_t*)(proj + P_VAT); M.states = ST; M.ycat = YC; M.rd = P.ret_decay + l * 16; M.sink = P.attn_sink + l * 8;
        for (int rep = 0; rep < REP_MX; ++rep) {
            for (int it = blockIdx.x; it < 256; it += G) scan_block(M, lds, it);
            attn_phase(M, lds, blockIdx.x, G, (256 - (int)blockIdx.x + G - 1) / G);
        }
        xcd_barrier(xb);
        for (int rep = 0; rep < REP_MX; ++rep) {
            ret_phase(M, lds);
            for (int it = gws; it < 64; it += nw) ret_item(M, it >> 3, it & 7, 0, 7);
        }
        xcd_barrier(xb);
        for (int rep = 0; rep < REP_G23; ++rep) {
            SchedGate S; S.T.init(1024); S.A = (const char*)YC; S.B = (const char*)Wcat; S.tstep = (size_t)256 * 1536 * 2;
            MainEpiGate me; me.gr = (const bf16_t*)(proj + P_GATER); me.ga = (const bf16_t*)(proj + P_GATEA); me.z = Z;
            gemm_main(lds, 1536, S, me);
            if (l < 3) gemm_tail_gate(lds, YC, Wcat, me.gr, me.ga, Z);
        }
        xcd_barrier(xb);
        for (int rep = 0; rep < REP_G23; ++rep) {
            SchedPlain S; S.T.init(1024); S.A = (const char*)Z; S.B = (const char*)Wmix; S.tstep = (size_t)256 * 1024 * 2; S.nt = 16;
            MainEpiBf16 me; me.out = MIXF; EpiF32 te; te.out = MIXF;
            gemm_main(lds, 1024, S, me);
            if (l < 3) gemm_tail(lds, Z, Wmix, 1024, 1024, 1024, te);
        }
        xcd_barrier(xb);
        rowpass(P, MIXF, P.n_mix_post + l * 1024, P.n_ff_pre + l * 1024, RS, gw, nw);
        xcd_barrier(xb);
        for (int rep = 0; rep < REP_FF; ++rep) {
            SchedPlain S; S.T.init(DFF); S.A = (const char*)H16; S.B = (const char*)Wff1; S.tstep = (size_t)256 * 1024 * 2; S.nt = 16;
            MainEpiRelu2 me; me.out = FFH; me.rs = RS; EpiRelu2 te; te.out = FFH; te.rs = RS;
            gemm_main(lds, 1024, S, me);
            if (l < 3) gemm_tail(lds, H16, Wff1, 1024, 1024, DFF, te);
        }
        xcd_barrier(xb);
        for (int rep = 0; rep < REP_FF; ++rep) {
            SchedPlain S; S.T.init(1024); S.A = (const char*)FFH; S.B = (const char*)Wff2; S.tstep = (size_t)256 * 4096 * 2; S.nt = 64;
            MainEpiBf16 me; me.out = MIXF; EpiF32 te; te.out = MIXF;
            gemm_main(lds, 4096, S, me);
            if (l < 3) gemm_tail(lds, FFH, Wff2, 4096, 4096, 1024, te);
        }
        xcd_barrier(xb);
        rowpass(P, MIXF, P.n_ff_post + l * 1024, l < 3 ? P.n_mix_pre + (l + 1) * 1024 : nullptr, RS, gw, nw);
      }
        if (l < 3) { convert_weights(P, l + 1, lds); xcd_barrier(xb); }
    }
}

extern "C" void kernel_launch(void* const* d_in, const int* in_sizes, int n_in, void* d_out, int out_size, void* d_ws, size_t ws_size, hipStream_t stream) {
    static int grid_blocks = 0;
    if (!grid_blocks) {
        int dev = 0, cus = 0, per_cu = 0;
        hipGetDevice(&dev);
        hipDeviceGetAttribute(&cus, hipDeviceAttributeMultiprocessorCount, dev);
        hipFuncSetAttribute((const void*)mega, hipFuncAttributeMaxDynamicSharedMemorySize, LDS_BYTES);
        hipOccupancyMaxActiveBlocksPerMultiprocessor(&per_cu, (const void*)mega, 512, LDS_BYTES);
        if (per_cu < 1) per_cu = 1;
        grid_blocks = cus * per_cu;
        if (ws_size < WS_END) fprintf(stderr, "kernel_launch: workspace too small: %zu < %zu\n", ws_size, (size_t)WS_END);
    }
    Params p{};
    p.x = (const float*)d_in[0]; p.meta = (const float*)d_in[1]; p.w_in = (const float*)d_in[2]; p.w_ret_o = (const float*)d_in[3];
    p.w_att_o = (const float*)d_in[4]; p.w_mix_o = (const float*)d_in[5]; p.w_ff1 = (const float*)d_in[6]; p.w_ff2 = (const float*)d_in[7];
    p.n_mix_pre = (const float*)d_in[8]; p.n_mix_post = (const float*)d_in[9]; p.n_ff_pre = (const float*)d_in[10]; p.n_ff_post = (const float*)d_in[11];
    p.ret_decay = (const float*)d_in[12]; p.attn_sink = (const float*)d_in[13];
    p.out = (float*)d_out; p.ws = (unsigned char*)d_ws;
    (void)hipMemsetAsync((unsigned char*)d_ws + WS_BAR, 0, 16384, stream);
    void* args[] = {&p};
    hipError_t e = hipLaunchCooperativeKernel((const void*)mega, dim3(grid_blocks), dim3(512), args, LDS_BYTES, stream);
    if (e != hipSuccess) fprintf(stderr, "cooperative launch failed: %s (grid %d)\n", hipGetErrorString(e), grid_blocks);
}
```

```cpp
#include <hip/hip_runtime.h>
#include <hip/hip_cooperative_groups.h>
#include <cstdio>
namespace cg = cooperative_groups;
#ifndef REP_G1
#define REP_G1 1
#endif
#ifndef REP_MX
#define REP_MX 1
#endif
#ifndef REP_FF
#define REP_FF 1
#endif
#ifndef REP_G23
#define REP_G23 1
#endif

#define LAS __attribute__((address_space(3)))
#define DI __device__ __forceinline__
typedef unsigned short bf16_t;
typedef short bf16x8 __attribute__((ext_vector_type(8)));
typedef short bf16x4 __attribute__((ext_vector_type(4)));
typedef float f32x4 __attribute__((ext_vector_type(4)));
typedef float f32x2 __attribute__((ext_vector_type(2)));
typedef unsigned u32x4 __attribute__((ext_vector_type(4)));
typedef unsigned u32x2 __attribute__((ext_vector_type(2)));
typedef __bf16 bfx2 __attribute__((ext_vector_type(2)));

constexpr int RX = 16384;
constexpr int RT = 16512;
constexpr int DM = 1024, DIN = 5888, DFF = 4096, LP = 2176, NCH = 17;
constexpr float EPS = 1e-6f;

constexpr size_t WS_HMETA = 0;
constexpr size_t WS_TABR = WS_HMETA + (size_t)128 * 1024 * 4;
constexpr size_t WS_TABA = WS_TABR + (size_t)2064 * 32 * 2 * 4;
constexpr size_t WS_W = WS_TABA + (size_t)2064 * 8 * 2 * 4;
constexpr size_t W_IN = 0;
constexpr size_t W_CAT = W_IN + (size_t)DIN * 1024 * 2;
constexpr size_t W_MIX = W_CAT + (size_t)1024 * 1536 * 2;
constexpr size_t W_FF1 = W_MIX + (size_t)1024 * 1024 * 2;
constexpr size_t W_FF2 = W_FF1 + (size_t)4096 * 1024 * 2;
constexpr size_t W_END = W_FF2 + (size_t)1024 * 4096 * 2;
constexpr size_t WS_U = WS_W + W_END;
constexpr size_t WS_ST = WS_U + (size_t)RT * 1536 * 2;
constexpr size_t WS_PROJ = WS_ST + (size_t)8 * 8 * 17 * 2 * 128 * 64 * 2;
constexpr size_t P_QR = 0;
constexpr size_t P_KR = P_QR + (size_t)RT * 512 * 2;
constexpr size_t P_KDF = P_KR + (size_t)RT * 512 * 2;
constexpr size_t P_KDB = P_KDF + (size_t)64 * 64 * LP * 2;
constexpr size_t P_VRT = P_KDB + (size_t)64 * 64 * LP * 2;
constexpr size_t P_GR = P_VRT + (size_t)64 * 128 * LP * 2;
constexpr size_t P_QA = P_GR + (size_t)RT * 1024 * 2;
constexpr size_t P_KA = P_QA + (size_t)RT * 512 * 2;
constexpr size_t P_VAT = P_KA + (size_t)RT * 128 * 2;
constexpr size_t P_GATER = P_VAT + (size_t)16 * 64 * LP * 2;
constexpr size_t P_GATEA = P_GATER + (size_t)RT * 1024 * 2;
constexpr size_t P_END = P_GATEA + (size_t)RT * 1024 * 2;
constexpr size_t P_FFH = 0;
constexpr size_t P_MIX = (size_t)RT * 4096 * 2;
static_assert(P_MIX + (size_t)RT * 1024 * 4 <= P_END, "alias");
constexpr size_t WS_BAR = WS_PROJ + P_END;
constexpr size_t WS_END = WS_BAR + 16384;

constexpr int LDS_MAIN = 134400;
constexpr int LDS_BYTES = LDS_MAIN + 16;

struct Params {
    const float *x, *meta, *w_in, *w_ret_o, *w_att_o, *w_mix_o, *w_ff1, *w_ff2;
    const float *n_mix_pre, *n_mix_post, *n_ff_pre, *n_ff_post, *ret_decay, *attn_sink;
    float* out; unsigned char* ws;
};

DI unsigned pk2(float lo, float hi) { f32x2 v = {lo, hi}; bfx2 b = __builtin_convertvector(v, bfx2); return __builtin_bit_cast(unsigned, b); }
DI u32x2 pk4(f32x4 v) { u32x2 r; r.x = pk2(v[0], v[1]); r.y = pk2(v[2], v[3]); return r; }
DI void st4(bf16_t* p, f32x4 v) { *(u32x2*)p = pk4(v); }
DI void st_pair16(bf16_t* p, f32x4 a, f32x4 b, int fq) {
    const u32x2 pa = pk4(a), pb = pk4(b);
    const auto r0 = __builtin_amdgcn_permlane16_swap(pa.x, pb.x, false, false);
    const auto r1 = __builtin_amdgcn_permlane16_swap(pa.y, pb.y, false, false);
    u32x4 w; w.x = r0[0]; w.y = r1[0]; w.z = r0[1]; w.w = r1[1];
    *(u32x4*)(p + (fq & 1) * 16 + (fq >> 1) * 8) = w;
}
DI bf16_t bf1(float x) { return (bf16_t)(pk2(x, x) & 0xffffu); }
DI f32x4 ld4(const bf16_t* p) {
    u32x2 w = *(const u32x2*)p; f32x4 r;
    r[0] = __uint_as_float(w.x << 16); r[1] = __uint_as_float(w.x & 0xffff0000u);
    r[2] = __uint_as_float(w.y << 16); r[3] = __uint_as_float(w.y & 0xffff0000u); return r;
}
DI bf16x8 pack8(f32x4 a, f32x4 b) { u32x4 w; w.x = pk2(a[0], a[1]); w.y = pk2(a[2], a[3]); w.z = pk2(b[0], b[1]); w.w = pk2(b[2], b[3]); return __builtin_bit_cast(bf16x8, w); }
DI bf16x8 cat8(bf16x4 lo, bf16x4 hi) { return __builtin_shufflevector(lo, hi, 0, 1, 2, 3, 4, 5, 6, 7); }
DI bf16x8 ld8(const bf16_t* p) { return *(const bf16x8*)p; }
DI bf16x4 ld4s(const bf16_t* p) { return *(const bf16x4*)p; }
DI f32x4 mfma16(bf16x8 a, bf16x8 b, f32x4 c) { return __builtin_amdgcn_mfma_f32_16x16x32_bf16(a, b, c, 0, 0, 0); }
DI float sigm(float x) { return __builtin_amdgcn_rcpf(1.0f + __expf(-x)); }
DI float wsum(float v) { v += __shfl_xor(v, 1); v += __shfl_xor(v, 2); v += __shfl_xor(v, 4); v += __shfl_xor(v, 8); v += __shfl_xor(v, 16); v += __shfl_xor(v, 32); return v; }
DI int otid() { int t = threadIdx.x; asm volatile("" : "+v"(t)); return t; }
DI void row_bp(int row, int& b, int& p, int& pp) {
    if (row < RX) { b = row >> 11; const int s = row & 2047; p = 16 + s; pp = 128 + s; }
    else { const int m = row - RX; b = m >> 4; p = m & 15; pp = 112 + p; }
}

DI void unpack8(u32x4 w, f32x4& lo, f32x4& hi) {
    lo[0] = __uint_as_float(w.x << 16); lo[1] = __uint_as_float(w.x & 0xffff0000u); lo[2] = __uint_as_float(w.y << 16); lo[3] = __uint_as_float(w.y & 0xffff0000u);
    hi[0] = __uint_as_float(w.z << 16); hi[1] = __uint_as_float(w.z & 0xffff0000u); hi[2] = __uint_as_float(w.w << 16); hi[3] = __uint_as_float(w.w & 0xffff0000u);
}
DI void st8(bf16_t* p, f32x4 a, f32x4 b) { u32x4 w; w.x = pk2(a[0], a[1]); w.y = pk2(a[2], a[3]); w.z = pk2(b[0], b[1]); w.w = pk2(b[2], b[3]); *(u32x4*)p = w; }
struct EpiIn {
    unsigned char* proj; const float* tabR; const float* tabA; const float* rd; const float* rs;
    template <int SEC> DI f32x4 load_cs(int row, int col) const {
        int b, p, pp; row_bp(row, b, p, pp);
        if (SEC == 0 || SEC == 1) { const int w = col & 63; return *(const f32x4*)(tabR + ((size_t)p * 32 + (w >> 1)) * 2); }
        if (SEC == 4 || SEC == 5) { const int w = col & 63; if (w < 16) return *(const f32x4*)(tabA + ((size_t)p * 8 + (w >> 1)) * 2); }
        return (f32x4){1.f, 0.f, 1.f, 0.f};
    }
    template <int SEC> DI f32x4 xform(f32x4 v, f32x4 cs) const {
        f32x4 o = v;
        if (SEC == 0 || SEC == 1 || SEC == 4 || SEC == 5) {
            o[0] = v[0] * cs[0] - v[1] * cs[1]; o[1] = v[1] * cs[0] + v[0] * cs[1];
            o[2] = v[2] * cs[2] - v[3] * cs[3]; o[3] = v[3] * cs[2] + v[2] * cs[3];
            if (SEC == 0 || SEC == 4) o *= 0.125f;
        } else if (SEC == 3) {
#pragma unroll
            for (int jj = 0; jj < 4; ++jj) o[jj] = v[jj] * sigm(v[jj]);
        } else if (SEC == 7 || SEC == 8) {
#pragma unroll
            for (int jj = 0; jj < 4; ++jj) o[jj] = sigm(v[jj]);
        }
        return o;
    }
    template <int SEC> DI bf16_t* dst(int row, int col) const {
        if (SEC == 0) return (bf16_t*)(proj + P_QR) + (size_t)row * 512 + col;
        if (SEC == 1) return (bf16_t*)(proj + P_KR) + (size_t)row * 512 + (col - 512);
        if (SEC == 3) return (bf16_t*)(proj + P_GR) + (size_t)row * 1024 + (col - 2048);
        if (SEC == 4) return (bf16_t*)(proj + P_QA) + (size_t)row * 512 + (col - 3072);
        if (SEC == 5) return (bf16_t*)(proj + P_KA) + (size_t)row * 128 + (col - 3584);
        if (SEC == 7) return (bf16_t*)(proj + P_GATER) + (size_t)row * 1024 + (col - 3840);
        if (SEC == 8) return (bf16_t*)(proj + P_GATEA) + (size_t)row * 1024 + (col - 4864);
        return nullptr;
    }
    template <int SEC> DI void scatter(int row, int col, f32x4 o, float lgf, float lgb) const {
        if (SEC != 1 && SEC != 2 && SEC != 6) return;
        int b, p, pp; row_bp(row, b, p, pp);
        if (SEC == 1) {
            const int c = col & 511, w = c & 63, h = c >> 6;
            const int j = pp & 127;
            const float df = __expf(lgf * (float)(127 - j)), db = __expf(lgb * (float)j);
            const size_t base = ((size_t)(b * 8 + h) * 64 + w) * LP + pp;
            bf16_t* kf = (bf16_t*)(proj + P_KDF) + base; bf16_t* kb = (bf16_t*)(proj + P_KDB) + base;
#pragma unroll
            for (int jj = 0; jj < 4; ++jj) { kf[(size_t)jj * LP] = bf1(o[jj] * df); kb[(size_t)jj * LP] = bf1(o[jj] * db); }
        } else if (SEC == 2) {
            const int c = col - 1024, h = c >> 7, e = c & 127;
            bf16_t* vt = (bf16_t*)(proj + P_VRT) + ((size_t)(b * 8 + h) * 128 + e) * LP + pp;
#pragma unroll
            for (int jj = 0; jj < 4; ++jj) vt[(size_t)jj * LP] = bf1(o[jj]);
        } else {
            const int c = col - 3712, g = c >> 6, d = c & 63;
            bf16_t* vt = (bf16_t*)(proj + P_VAT) + ((size_t)(b * 2 + g) * 64 + d) * LP + pp;
#pragma unroll
            for (int jj = 0; jj < 4; ++jj) vt[(size_t)jj * LP] = bf1(o[jj]);
        }
    }
    template <int SEC> DI void body(int row, int col, f32x4 v, f32x4 cs, float lgf, float lgb) const {
        const f32x4 o = xform<SEC>(v * rs[row], cs);
        if (SEC != 2 && SEC != 6) st4(dst<SEC>(row, col), o);
        scatter<SEC>(row, col, o, lgf, lgb);
    }
    template <int SEC> DI void body2(int row, int col, f32x4 v0, f32x4 v1, f32x4 cs0, f32x4 cs1, float lgf, float lgb, float rsv) const {
        const f32x4 o0 = xform<SEC>(v0 * rsv, cs0), o1 = xform<SEC>(v1 * rsv, cs1);
        if (SEC != 2 && SEC != 6) st8(dst<SEC>(row, col), o0, o1);
        scatter<SEC>(row, col, o0, lgf, lgb); scatter<SEC>(row, col + 4, o1, lgf, lgb);
    }
    static DI int section(int col) {
        return col < 512 ? 0 : col < 1024 ? 1 : col < 2048 ? 2 : col < 3072 ? 3 : col < 3584 ? 4 : col < 3712 ? 5 : col < 3840 ? 6 : col < 4864 ? 7 : 8;
    }
    template <int SEC> DI void one(int row, int col, f32x4 v) const {
        float lgf = 0.f, lgb = 0.f;
        if (SEC == 1) { const int h = (col & 511) >> 6; lgf = -__expf(rd[h]); lgb = -__expf(rd[8 + h]); }
        body<SEC>(row, col, v, load_cs<SEC>(row, col), lgf, lgb);
    }
    DI void operator()(int row, int col, f32x4 v) const {
        switch (section(col)) {
            case 0: one<0>(row, col, v); break; case 1: one<1>(row, col, v); break; case 2: one<2>(row, col, v); break;
            case 3: one<3>(row, col, v); break; case 4: one<4>(row, col, v); break; case 5: one<5>(row, col, v); break;
            case 6: one<6>(row, col, v); break; case 7: one<7>(row, col, v); break; default: one<8>(row, col, v); break;
        }
    }
};
struct EpiF32 { bf16_t* out; DI void operator()(int row, int col, f32x4 v) const { st4(out + (size_t)row * 1024 + col, v); } };
struct EpiRelu2 { bf16_t* out; const float* rs; DI void operator()(int row, int col, f32x4 v) const {
    f32x4 o; const float r = rs[row];
#pragma unroll
    for (int jj = 0; jj < 4; ++jj) { const float t = fmaxf(v[jj] * r, 0.f); o[jj] = t * t; }
    st4(out + (size_t)row * 4096 + col, o); } };

constexpr int HALF = 128, BK = 64, HTB = HALF * BK * 2;
DI int lds_byte(int r, int c) { const int st = (r >> 4) * 2 + (c >> 5), rr = r & 15, cc = c & 31, ob = rr * 64 + cc * 2; return st * 1024 + (ob ^ (((ob >> 9) & 1) << 5)); }
DI int perm32(int rho) { const int n = rho >> 4, i = rho & 15; return 8 * (i >> 2) + 4 * n + (i & 3); }
DI void stage_rc(int b, int& R, int& C) { const int st = b / 1024, sb = b % 1024, swz = sb ^ (((sb >> 9) & 1) << 5); R = (st >> 1) * 16 + swz / 64; C = (st & 1) * 32 + (swz % 64) / 2; }

struct Unit { const char* A; const char* B; int nt, pm, pn, kind; };
struct TileOrder {
    int nM, nN, nwg, G, c, extra;
    DI void init(int N, int extra_ = 0) { nM = RX / 256; nN = N / 256; nwg = nM * nN; G = gridDim.x; c = blockIdx.x; extra = extra_; }
    DI bool tile(int i, int& pm, int& pn) const {
        const long L = (long)i * G + c;
        if (L >= nwg) { if (extra && L < nwg + nN) { pm = nM; pn = (int)(L - nwg); return true; } return false; }
        int wgid = (int)L; { const int q = nwg / 8, r = nwg % 8, xcd = wgid % 8, off = wgid / 8; wgid = (xcd < r ? xcd * (q + 1) : r * (q + 1) + (xcd - r) * q) + off; }
        const int nig = 8 * nN, gid = wgid / nig, fm = gid * 8, gsz = (nM - fm) < 8 ? (nM - fm) : 8;
        pm = fm + ((wgid % nig) % gsz); pn = (wgid % nig) / gsz; return true;
    }
};
struct SchedPlain {
    TileOrder T; const char* A; const char* B; size_t tstep; int nt;
    DI bool next(int i, Unit& u) const { if (!T.tile(i, u.pm, u.pn)) return false; u.A = A + (size_t)u.pm * tstep; u.B = B + (size_t)u.pn * tstep; u.nt = nt; u.kind = 1; return true; }
};
struct SchedGate {
    TileOrder T; const char* A; const char* B; size_t tstep;
    DI bool next(int i, Unit& u) const { if (!T.tile(i >> 1, u.pm, u.pn)) return false; const int kind = i & 1; u.kind = kind;
        u.A = A + (size_t)u.pm * tstep + (kind ? 2048 : 0); u.B = B + (size_t)u.pn * tstep + (kind ? 2048 : 0); u.nt = kind ? 8 : 16; return true; }
};

template <class F> DI void for_acc(f32x4 (&acc)[2][2][4][2], const Unit& u, int wr, int wc, int fr, int fq, const F& f) {
#pragma unroll
    for (int bj = 0; bj < 2; ++bj)
#pragma unroll
        for (int ai = 0; ai < 2; ++ai)
#pragma unroll
            for (int m = 0; m < 4; ++m)
#pragma unroll
                for (int n = 0; n < 2; ++n)
                    f(u.pm * 256 + ai * HALF + wr * 64 + m * 16 + fr, u.pn * 256 + bj * HALF + wc * 32 + fq * 8 + n * 4, acc[ai][bj][m][n]);
}
template <class E> struct MainEpi { E e; DI bool run(f32x4 (&acc)[2][2][4][2], const Unit& u, int wr, int wc, int fr, int fq) const {
    for_acc(acc, u, wr, wc, fr, fq, [&](int row, int col, f32x4& v) { e(row, col, v); }); return false; } };
struct MainEpiIn { EpiIn e;
    template <int S> DI void sec_loop(f32x4 (&acc)[2][2][4][2], const Unit& u, int bj, int wr, int wc, int fr, int fq) const {
        const int colb = u.pn * 256 + bj * HALF + wc * 32 + fq * 8;
        float lgf = 0.f, lgb = 0.f;
        if (S == 1) { const int h = ((u.pn * 256 + bj * HALF + wc * 32) & 511) >> 6; lgf = -__expf(e.rd[h]); lgb = -__expf(e.rd[8 + h]); }
#pragma unroll
        for (int ai = 0; ai < 2; ++ai) {
            if (ai == 1 && u.pm == RX / 256) break;
            const int rowb = u.pm * 256 + ai * HALF + wr * 64 + fr;
            f32x4 cs[4][2]; float rsv[4];
#pragma unroll
            for (int m = 0; m < 4; ++m) { rsv[m] = e.rs[rowb + m * 16];
#pragma unroll
                for (int n = 0; n < 2; ++n) cs[m][n] = e.load_cs<S>(rowb + m * 16, colb + n * 4); }
#pragma unroll
            for (int m = 0; m < 4; ++m) e.body2<S>(rowb + m * 16, colb, acc[ai][bj][m][0], acc[ai][bj][m][1], cs[m][0], cs[m][1], lgf, lgb, rsv[m]);
        }
    }
    DI bool run(f32x4 (&acc)[2][2][4][2], const Unit& u, int wr, int wc, int fr, int fq) const {
        {
            const int sec0 = EpiIn::section(u.pn * 256);
#define SECCASE(S, BJ) case S: sec_loop<S>(acc, u, BJ, wr, wc, fr, fq); break;
            switch (sec0) { SECCASE(0, 0) SECCASE(1, 0) SECCASE(2, 0) SECCASE(3, 0) SECCASE(4, 0) SECCASE(5, 0) SECCASE(6, 0) SECCASE(7, 0) default: sec_loop<8>(acc, u, 0, wr, wc, fr, fq); break; }
            const int sec1 = EpiIn::section(u.pn * 256 + HALF);
            switch (sec1) { SECCASE(0, 1) SECCASE(1, 1) SECCASE(2, 1) SECCASE(3, 1) SECCASE(4, 1) SECCASE(5, 1) SECCASE(6, 1) SECCASE(7, 1) default: sec_loop<8>(acc, u, 1, wr, wc, fr, fq); break; }
#undef SECCASE
        }
        return false; } };
struct MainEpiGate { const bf16_t* gr; const bf16_t* ga; bf16_t* z;
    DI bool run(f32x4 (&acc)[2][2][4][2], const Unit& u, int wr, int wc, int fr, int fq) const {
        const bool k0 = (u.kind == 0);
#pragma unroll
        for (int bj = 0; bj < 2; ++bj)
#pragma unroll
            for (int ai = 0; ai < 2; ++ai) {
                const size_t base = (size_t)(u.pm * 256 + ai * HALF + wr * 64 + fr) * 1024 + (u.pn * 256 + bj * HALF + wc * 32 + fq * 8);
                u32x4 ra[4], rb[4];
#pragma unroll
                for (int m = 0; m < 4; ++m) { rb[m] = *(const u32x4*)(ga + base + (size_t)m * 16 * 1024); if (k0) ra[m] = *(const u32x4*)(gr + base + (size_t)m * 16 * 1024); else ra[m] = rb[m]; }
#pragma unroll
                for (int m = 0; m < 4; ++m) {
                    f32x4 a0, a1, b0, b1; unpack8(ra[m], a0, a1); unpack8(rb[m], b0, b1);
                    f32x4& v0 = acc[ai][bj][m][0]; f32x4& v1 = acc[ai][bj][m][1];
                    if (k0) {
#pragma unroll
                        for (int jj = 0; jj < 4; ++jj) { v0[jj] *= a0[jj] * __builtin_amdgcn_rcpf(fmaxf(b0[jj], 1e-30f)); v1[jj] *= a1[jj] * __builtin_amdgcn_rcpf(fmaxf(b1[jj], 1e-30f)); }
                    } else st8(z + base + (size_t)m * 16 * 1024, v0 * b0, v1 * b1);
                }
            }
        return k0;
    } };
template <class F> DI void for_acc2(f32x4 (&acc)[2][2][4][2], const Unit& u, int wr, int wc, int fr, int fq, const F& f) {
#pragma unroll
    for (int bj = 0; bj < 2; ++bj)
#pragma unroll
        for (int ai = 0; ai < 2; ++ai)
#pragma unroll
            for (int m = 0; m < 4; ++m)
                f(u.pm * 256 + ai * HALF + wr * 64 + m * 16 + fr, u.pn * 256 + bj * HALF + wc * 32 + fq * 8, acc[ai][bj][m][0], acc[ai][bj][m][1]);
}
struct MainEpiBf16 { bf16_t* out; DI bool run(f32x4 (&acc)[2][2][4][2], const Unit& u, int wr, int wc, int fr, int fq) const {
    for_acc2(acc, u, wr, wc, fr, fq, [&](int row, int col, const f32x4& a, const f32x4& b) { st8(out + (size_t)row * 1024 + col, a, b); }); return false; } };
struct MainEpiRelu2 { bf16_t* out; const float* rs; DI bool run(f32x4 (&acc)[2][2][4][2], const Unit& u, int wr, int wc, int fr, int fq) const {
    float rsv[2][4];
#pragma unroll
    for (int ai = 0; ai < 2; ++ai)
#pragma unroll
        for (int m = 0; m < 4; ++m) rsv[ai][m] = rs[u.pm * 256 + ai * HALF + wr * 64 + m * 16 + fr];
#pragma unroll
    for (int bj = 0; bj < 2; ++bj)
#pragma unroll
        for (int ai = 0; ai < 2; ++ai)
#pragma unroll
            for (int m = 0; m < 4; ++m) {
                const int row = u.pm * 256 + ai * HALF + wr * 64 + m * 16 + fr, col = u.pn * 256 + bj * HALF + wc * 32 + fq * 8;
                const f32x4 a = acc[ai][bj][m][0] * rsv[ai][m], b = acc[ai][bj][m][1] * rsv[ai][m];
                f32x4 x, y;
#pragma unroll
                for (int jj = 0; jj < 4; ++jj) { const float t = fmaxf(a[jj], 0.f), w = fmaxf(b[jj], 0.f); x[jj] = t * t; y[jj] = w * w; }
                st8(out + (size_t)row * 4096 + col, x, y);
            }
    return false; } };

template <class Sched, class Epi>
DI void gemm_main(LAS unsigned char* lds, int pitch, const Sched& S, const Epi& E) {
    const int tid = otid(), wid = __builtin_amdgcn_readfirstlane(tid >> 6), lane = tid & 63, wr = wid >> 2, wc = wid & 3, fr = lane & 15, fq = lane >> 4;
    unsigned voff[2], voffB[2];
#pragma unroll
    for (int i = 0; i < 2; ++i) { int R, C; stage_rc(tid * 16 + i * 8192, R, C); voff[i] = (unsigned)(R * pitch + C) * 2u;
        const int Rb = (R & ~31) + perm32(R & 31); voffB[i] = (unsigned)(Rb * pitch + C) * 2u; }
    const size_t kstep = (size_t)(BK * 2);
    const size_t hstep = (size_t)HALF * pitch * 2;
    const unsigned ldsw = (unsigned)wid * 1024u;
    const int aoff = lds_byte(wr * 64 + fr, fq * 8), boff = lds_byte(wc * 32 + fr, fq * 8);
#define G_SA(b, h) (((b) * 2 + (h)) * HTB)
#define G_SB(b, h) ((4 + (b) * 2 + (h)) * HTB)
#define G_STAGEV(bufoff, gbase, VO) do { _Pragma("unroll") for (int _i = 0; _i < 2; ++_i) \
        __builtin_amdgcn_global_load_lds((const unsigned*)((const char*)(gbase) + VO[_i]), (LAS unsigned*)(lds + (bufoff) + ldsw + _i * 8192), 16, 0, 0); } while (0)
#define G_STAGE(bufoff, gbase) G_STAGEV(bufoff, gbase, voff)
#define G_STAGEB(bufoff, gbase) G_STAGEV(bufoff, gbase, voffB)
#define G_LDA(dst, b, h) do { _Pragma("unroll") for (int m = 0; m < 4; ++m) _Pragma("unroll") for (int k = 0; k < 2; ++k) dst[m][k] = *(const LAS bf16x8*)(lds + G_SA(b, h) + aoff + m * 2048 + k * 1024); } while (0)
#define G_LDB(dst, b, h) do { _Pragma("unroll") for (int n = 0; n < 2; ++n) _Pragma("unroll") for (int k = 0; k < 2; ++k) dst[n][k] = *(const LAS bf16x8*)(lds + G_SB(b, h) + boff + n * 2048 + k * 1024); } while (0)
#define G_MMA(ai, bj, At, Bt) do { __builtin_amdgcn_s_setprio(1); _Pragma("unroll") for (int m = 0; m < 4; ++m) _Pragma("unroll") for (int n = 0; n < 2; ++n) _Pragma("unroll") for (int k = 0; k < 2; ++k) \
        acc[ai][bj][m][n] = __builtin_amdgcn_mfma_f32_16x16x32_bf16(Bt[n][k], At[m][k], acc[ai][bj][m][n], 0, 0, 0); __builtin_amdgcn_s_setprio(0); } while (0)
#define G_WAIT_V(n) asm volatile("s_waitcnt vmcnt(" #n ")" ::: "memory")
#define G_WAIT_L(n) asm volatile("s_waitcnt lgkmcnt(" #n ")" ::: "memory")
#define G_BAR __builtin_amdgcn_s_barrier()
#define G_SCHED __builtin_amdgcn_sched_barrier(0)
    Unit cur, nxt; int ui = 0;
    if (!S.next(0, cur)) return;
    f32x4 acc[2][2][4][2];
#pragma unroll
    for (int a = 0; a < 2; ++a)
#pragma unroll
        for (int b = 0; b < 2; ++b)
#pragma unroll
            for (int m = 0; m < 4; ++m)
#pragma unroll
                for (int n = 0; n < 2; ++n) acc[a][b][m][n] = (f32x4){0.f, 0.f, 0.f, 0.f};
    bf16x8 At[4][2], B0[2][2], B1[2][2];
    const char* cA = cur.A; const char* cB = cur.B;
    G_STAGEB(G_SB(0, 0), cB); G_STAGE(G_SA(0, 0), cA); G_STAGEB(G_SB(0, 1), cB + hstep); G_STAGE(G_SA(0, 1), cA + hstep);
    if (wr == 1) G_BAR;
    G_WAIT_V(4); G_BAR;
    G_STAGEB(G_SB(1, 0), cB + kstep); G_STAGE(G_SA(1, 0), cA + kstep); G_STAGEB(G_SB(1, 1), cB + hstep + kstep);
    G_WAIT_V(6); G_BAR;
    for (;;) {
        const bool has_next = S.next(ui + 1, nxt);
        const char* nA = has_next ? nxt.A : cA; const char* nB = has_next ? nxt.B : cB;
        const int nt = cur.nt;
        for (int t = 0; t < nt; t += 2) {
            const bool last = (t == nt - 2);
            const char* a1 = cA + (size_t)(t + 1) * kstep;
            const char* a2 = last ? nA : cA + (size_t)(t + 2) * kstep; const char* b2 = last ? nB : cB + (size_t)(t + 2) * kstep;
            const char* a3 = a2 + kstep; const char* b3 = b2 + kstep;
            G_LDB(B0, 0, 0); G_SCHED; G_LDA(At, 0, 0); G_STAGE(G_SA(1, 1), a1 + hstep);
            G_WAIT_L(8); G_BAR; G_WAIT_L(0); G_MMA(0, 0, At, B0); G_BAR; G_SCHED;
            G_LDB(B1, 0, 1); G_STAGEB(G_SB(0, 0), b2);
            G_BAR; G_WAIT_L(0); G_MMA(0, 1, At, B1); G_BAR;
            G_LDA(At, 0, 1); G_STAGE(G_SA(0, 0), a2);
            G_BAR; G_WAIT_L(0); G_MMA(1, 0, At, B0); G_BAR; G_SCHED;
            G_STAGEB(G_SB(0, 1), b2 + hstep);
            G_WAIT_V(6); G_BAR; G_MMA(1, 1, At, B1); G_BAR;
            G_LDB(B0, 1, 0); G_SCHED; G_LDA(At, 1, 0); G_STAGE(G_SA(0, 1), a2 + hstep);
            G_WAIT_L(8); G_BAR; G_WAIT_L(0); G_MMA(0, 0, At, B0); G_BAR; G_SCHED;
            G_LDB(B1, 1, 1); G_STAGEB(G_SB(1, 0), b3);
            G_BAR; G_WAIT_L(0); G_MMA(0, 1, At, B1); G_BAR;
            G_LDA(At, 1, 1); G_STAGE(G_SA(1, 0), a3);
            G_BAR; G_WAIT_L(0); G_MMA(1, 0, At, B0); G_BAR; G_SCHED;
            G_STAGEB(G_SB(1, 1), b3 + hstep);
            G_WAIT_V(6); G_BAR; G_MMA(1, 1, At, B1); G_BAR;
        }
        const bool keep = E.run(acc, cur, wr, wc, fr, fq);
        if (!has_next) break;
        if (!keep) {
#pragma unroll
            for (int a = 0; a < 2; ++a)
#pragma unroll
                for (int b = 0; b < 2; ++b)
#pragma unroll
                    for (int m = 0; m < 4; ++m)
#pragma unroll
                        for (int n = 0; n < 2; ++n) acc[a][b][m][n] = (f32x4){0.f, 0.f, 0.f, 0.f};
        }
        cur = nxt; cA = nA; cB = nB; ++ui;
    }
    G_WAIT_V(0);
    if (wr == 0) G_BAR;
    G_BAR;
#undef G_SA
#undef G_SB
#undef G_STAGE
#undef G_STAGEV
#undef G_STAGEB
#undef G_LDA
#undef G_LDB
#undef G_MMA
}

#define SB() __builtin_amdgcn_sched_barrier(0)
template <class Epi>
DI void gemm_tail(LAS unsigned char* lds, const bf16_t* A, const bf16_t* Bt, int pitch, int K, int N, const Epi& epi) {
    const int tid = otid(), wid = __builtin_amdgcn_readfirstlane(tid >> 6), lane = tid & 63, fr = lane & 15, fq = lane >> 4;
    LAS f32x4* red = (LAS f32x4*)lds;
    const int nitems = 8 * (N >> 6);
    const int kslice = K >> 3;
    for (int it = blockIdx.x; it < nitems; it += gridDim.x) {
        const int rt = it & 7, cg = it >> 3;
        const bf16_t* ap = A + (size_t)(RX + rt * 16 + fr) * pitch + fq * 8 + wid * kslice;
        const bf16_t* bp = Bt + (size_t)(cg * 64 + fr) * pitch + fq * 8 + wid * kslice;
        f32x4 acc[4];
#pragma unroll
        for (int cf = 0; cf < 4; ++cf) acc[cf] = (f32x4){0.f, 0.f, 0.f, 0.f};
        for (int k0 = 0; k0 < kslice; k0 += 128) {
            bf16x8 av[4], bv[4][4];
#pragma unroll
            for (int s4 = 0; s4 < 4; ++s4) { av[s4] = ld8(ap + k0 + s4 * 32);
#pragma unroll
                for (int cf = 0; cf < 4; ++cf) bv[s4][cf] = ld8(bp + (size_t)cf * 16 * pitch + k0 + s4 * 32); }
            SB();
#pragma unroll
            for (int s4 = 0; s4 < 4; ++s4)
#pragma unroll
                for (int cf = 0; cf < 4; ++cf) acc[cf] = mfma16(bv[s4][cf], av[s4], acc[cf]);
        }
#pragma unroll
        for (int cf = 0; cf < 4; ++cf) red[(wid * 4 + cf) * 64 + lane] = acc[cf];
        __syncthreads();
        if (wid < 4) {
            f32x4 v = red[(0 * 4 + wid) * 64 + lane];
#pragma unroll
            for (int w = 1; w < 8; ++w) v += red[(w * 4 + wid) * 64 + lane];
            epi(RX + rt * 16 + fr, cg * 64 + wid * 16 + fq * 4, v);
        }
        __syncthreads();
    }
}
DI void gemm_tail_gate(LAS unsigned char* lds, const bf16_t* A, const bf16_t* Bt, const bf16_t* gr, const bf16_t* ga, bf16_t* z) {
    const int tid = otid(), wid = __builtin_amdgcn_readfirstlane(tid >> 6), lane = tid & 63, fr = lane & 15, fq = lane >> 4;
    LAS f32x4* red = (LAS f32x4*)lds;
    for (int it = blockIdx.x; it < 128; it += gridDim.x) {
        const int rt = it & 7, cg = it >> 3;
        const bf16_t* ap = A + (size_t)(RX + rt * 16 + fr) * 1536 + fq * 8;
        const bf16_t* bp = Bt + (size_t)(cg * 64 + fr) * 1536 + fq * 8;
        bf16x8 av[6], bv[6][4];
#pragma unroll
        for (int s6 = 0; s6 < 6; ++s6) { const int ko = s6 < 4 ? wid * 128 + s6 * 32 : 1024 + wid * 64 + (s6 - 4) * 32; av[s6] = ld8(ap + ko);
#pragma unroll
            for (int cf = 0; cf < 4; ++cf) bv[s6][cf] = ld8(bp + (size_t)cf * 16 * 1536 + ko); }
        SB();
        f32x4 a0[4], a1[4];
#pragma unroll
        for (int cf = 0; cf < 4; ++cf) { a0[cf] = (f32x4){0.f, 0.f, 0.f, 0.f}; a1[cf] = (f32x4){0.f, 0.f, 0.f, 0.f}; }
#pragma unroll
        for (int s6 = 0; s6 < 6; ++s6)
#pragma unroll
            for (int cf = 0; cf < 4; ++cf) { if (s6 < 4) a0[cf] = mfma16(bv[s6][cf], av[s6], a0[cf]); else a1[cf] = mfma16(bv[s6][cf], av[s6], a1[cf]); }
#pragma unroll
        for (int cf = 0; cf < 4; ++cf) { red[(wid * 4 + cf) * 64 + lane] = a0[cf]; red[2048 + (wid * 4 + cf) * 64 + lane] = a1[cf]; }
        __syncthreads();
        if (wid < 4) {
            f32x4 v0 = red[(0 * 4 + wid) * 64 + lane], v1 = red[2048 + (0 * 4 + wid) * 64 + lane];
#pragma unroll
            for (int w = 1; w < 8; ++w) { v0 += red[(w * 4 + wid) * 64 + lane]; v1 += red[2048 + (w * 4 + wid) * 64 + lane]; }
            const int row = RX + rt * 16 + fr, col = cg * 64 + wid * 16 + fq * 4;
            const f32x4 sr = ld4(gr + (size_t)row * 1024 + col), sa = ld4(ga + (size_t)row * 1024 + col);
            st4(z + (size_t)row * 1024 + col, sr * v0 + sa * v1);
        }
        __syncthreads();
    }
}

struct Mix {
    const bf16_t *q_r, *k_r, *kdF, *kdB, *v_rT, *g_r, *q_a, *k_a, *v_aT;
    bf16_t* states; bf16_t* ycat; const float* rd; const float* sink;
};

DI bf16x8 ldsr8(const LAS unsigned char* p) { return *(const LAS bf16x8*)p; }
DI bf16x4 ldsr4(const LAS unsigned char* p) { return *(const LAS bf16x4*)p; }
DI bf16x8 pack8i(f32x4 a, f32x4 b) { u32x4 w; w.x = pk2(a[0], b[0]); w.y = pk2(a[1], b[1]); w.z = pk2(a[2], b[2]); w.w = pk2(a[3], b[3]); return __builtin_bit_cast(bf16x8, w); }

constexpr int ATT_KP = 208, ATT_VP = 800, ATT_VOFF = 400 * ATT_KP;
struct AttPre { bf16x8 k[7]; bf16x8 v[7]; };
template <bool DOK, bool DOV> DI void attn_prefetch(AttPre& R, const Mix& M, int t, int tid) {
    asm volatile("" : "+v"(tid));
    const int b = t & 7, qb = (t >> 3) & 15, g = t >> 7, s0 = qb * 128;
    if (DOK) {
#pragma unroll
    for (int i = 0; i < 7; ++i) {
        const int c = tid + 512 * i;
        if (c < 3200) {
            const int lk = c >> 3, c16 = c & 7;
            int row;
            if (lk < 384) { int sk = s0 - 128 + lk; sk = sk < 0 ? 0 : (sk > 2047 ? 2047 : sk); row = b * 2048 + sk; } else row = RX + b * 16 + (lk - 384);
            R.k[i] = ld8(M.k_a + (size_t)row * 128 + g * 64 + c16 * 8);
        }
    }
    }
    if (DOV) {
#pragma unroll
    for (int i = 0; i < 7; ++i) {
        const int c = tid + 512 * i;
        if (c < 3200) {
            const int e = c / 50, c16 = c - e * 50;
            int pp = (c16 < 48) ? (s0 + c16 * 8) : (112 + (c16 - 48) * 8);
            pp = pp > LP - 8 ? LP - 8 : pp;
            R.v[i] = ld8(M.v_aT + ((size_t)(b * 2 + g) * 64 + e) * LP + pp);
        }
    }
    }
}
DI void attn_commit(const AttPre& R, LAS unsigned char* lds, int tid) {
    asm volatile("" : "+v"(tid));
#pragma unroll
    for (int i = 0; i < 7; ++i) { const int c = tid + 512 * i; if (c < 3200) *(LAS bf16x8*)(lds + (c >> 3) * ATT_KP + (c & 7) * 16) = R.k[i]; }
#pragma unroll
    for (int i = 0; i < 7; ++i) { const int c = tid + 512 * i; if (c < 3200) { const int e = c / 50, c16 = c - e * 50; *(LAS bf16x8*)(lds + ATT_VOFF + e * ATT_VP + c16 * 16) = R.v[i]; } }
}
template <class Hook> DI void attn_wave(const Mix& M, const LAS unsigned char* lds, int b, int hq, int s0, int w, bf16x8 q0, bf16x8 q1, int lane, const Hook& hook) {
    asm volatile("" : "+v"(lane));
    const int fr = lane & 15, fq = lane >> 4;
    const int s = s0 + 16 * w + fr;
    const int rowq = (w >= 0) ? (b * 2048 + s) : (RX + b * 16 + fr);
    const int blk_lo = (w >= 0) ? (w >> 1) : 0;
    const LAS unsigned char* kb = lds + (32 * blk_lo + (fr >> 2) * 8 + 2 * (fr & 3)) * ATT_KP + fq * 16;
    f32x4 sa[9], sb[9], sm;
#pragma unroll
    for (int i0 = 0; i0 < 9; i0 += 3) {
        bf16x8 ka[3][2], kc[3][2];
#pragma unroll
        for (int u = 0; u < 3; ++u) {
            const int i = i0 + u;
            ka[u][0] = ldsr8(kb + i * 32 * ATT_KP); ka[u][1] = ldsr8(kb + i * 32 * ATT_KP + 64);
            kc[u][0] = ldsr8(kb + i * 32 * ATT_KP + ATT_KP); kc[u][1] = ldsr8(kb + i * 32 * ATT_KP + ATT_KP + 64);
        }
        SB();
#pragma unroll
        for (int u = 0; u < 3; ++u) {
            f32x4 a = {0.f, 0.f, 0.f, 0.f}, c = {0.f, 0.f, 0.f, 0.f};
            a = mfma16(ka[u][0], q0, a); a = mfma16(ka[u][1], q1, a);
            c = mfma16(kc[u][0], q0, c); c = mfma16(kc[u][1], q1, c);
            sa[i0 + u] = a; sb[i0 + u] = c;
        }
        SB();
    }
    {
        const LAS unsigned char* km = lds + (384 + fr) * ATT_KP + fq * 16;
        const bf16x8 k0 = ldsr8(km), k1 = ldsr8(km + 64);
        f32x4 a = {0.f, 0.f, 0.f, 0.f};
        a = mfma16(k0, q0, a); a = mfma16(k1, q1, a); sm = a;
    }
    const float sink = M.sink[hq];
    float mx = sink;
#pragma unroll
    for (int i = 0; i < 9; ++i)
#pragma unroll
        for (int jj = 0; jj < 4; ++jj) {
            const int ska = s0 - 128 + 32 * (blk_lo + i) + fq * 8 + 2 * jj; const int da = s - ska;
            const bool oka = (ska >= 0) && (ska < 2048) && (da <= 128) && (da >= -128);
            const bool okb = (ska + 1 >= 0) && (ska + 1 < 2048) && (da - 1 <= 128) && (da - 1 >= -128);
            const float va = oka ? sa[i][jj] : -1e30f, vb = okb ? sb[i][jj] : -1e30f;
            sa[i][jj] = va; sb[i][jj] = vb; mx = fmaxf(mx, fmaxf(va, vb));
        }
#pragma unroll
    for (int jj = 0; jj < 4; ++jj) mx = fmaxf(mx, sm[jj]);
    mx = fmaxf(mx, __shfl_xor(mx, 16)); mx = fmaxf(mx, __shfl_xor(mx, 32));
    float sum = 0.f;
    bf16x8 py[9], pym;
#pragma unroll
    for (int i = 0; i < 9; ++i) {
#pragma unroll
        for (int jj = 0; jj < 4; ++jj) { const float p0 = __expf(sa[i][jj] - mx), p1 = __expf(sb[i][jj] - mx); sa[i][jj] = p0; sb[i][jj] = p1; sum += p0 + p1; }
        py[i] = pack8i(sa[i], sb[i]);
    }
    {
#pragma unroll
        for (int jj = 0; jj < 4; ++jj) { const float p0 = __expf(sm[jj] - mx); sm[jj] = p0; sum += p0; }
        pym = pack8(sm, (f32x4){0.f, 0.f, 0.f, 0.f});
    }
    sum += __shfl_xor(sum, 16); sum += __shfl_xor(sum, 32);
    sum += __expf(sink - mx);
    SB(); hook(); SB();
    f32x4 o[4];
#pragma unroll
    for (int ef = 0; ef < 4; ++ef) o[ef] = (f32x4){0.f, 0.f, 0.f, 0.f};
    const LAS unsigned char* vb = lds + ATT_VOFF + fr * ATT_VP + (32 * blk_lo + fq * 8) * 2;
#pragma unroll
    for (int i0 = 0; i0 < 9; i0 += 3) {
        bf16x8 vx[3][4];
#pragma unroll
        for (int u = 0; u < 3; ++u)
#pragma unroll
            for (int ef = 0; ef < 4; ++ef) vx[u][ef] = ldsr8(vb + ef * 16 * ATT_VP + (i0 + u) * 64);
        SB();
#pragma unroll
        for (int u = 0; u < 3; ++u)
#pragma unroll
            for (int ef = 0; ef < 4; ++ef) o[ef] = mfma16(vx[u][ef], py[i0 + u], o[ef]);
        SB();
    }
    {
        const LAS unsigned char* vm = lds + ATT_VOFF + fr * ATT_VP + (384 + fq * 4) * 2;
        const bf16x4 z4 = {0, 0, 0, 0};
#pragma unroll
        for (int ef = 0; ef < 4; ++ef) o[ef] = mfma16(cat8(ldsr4(vm + ef * 16 * ATT_VP), z4), pym, o[ef]);
    }
    const float inv = 1.0f / sum;
#pragma unroll
    for (int ef = 0; ef < 4; ef += 2) st_pair16(M.ycat + (size_t)rowq * 1536 + 1024 + hq * 64 + ef * 16, o[ef] * inv, o[ef + 1] * inv, fq);
}
DI void attn_phase(const Mix& M, LAS unsigned char* lds, int first, int step, int count) {
    const int tid = otid(), wid = __builtin_amdgcn_readfirstlane(tid >> 6), lane = tid & 63, fr = lane & 15, fq = lane >> 4;
    AttPre R;
    if (count > 0) attn_prefetch<true, true>(R, M, first, tid);
    for (int k = 0; k < count; ++k) {
        const int t = first + k * step;
        const int b = t & 7, qb = (t >> 3) & 15, g = t >> 7;
        const int rowq = b * 2048 + qb * 128 + 16 * wid + fr;
        bf16x8 q[4][2];
#pragma unroll
        for (int hh = 0; hh < 4; ++hh) { q[hh][0] = ld8(M.q_a + (size_t)rowq * 512 + (g * 4 + hh) * 64 + fq * 8); q[hh][1] = ld8(M.q_a + (size_t)rowq * 512 + (g * 4 + hh) * 64 + 32 + fq * 8); }
        __syncthreads();
        attn_commit(R, lds, tid);
        __syncthreads();
        const bool more = (k + 1 < count);
        if (more) attn_prefetch<true, true>(R, M, t + step, tid);
#pragma unroll
        for (int hh = 0; hh < 4; ++hh) attn_wave(M, lds, b, g * 4 + hh, qb * 128, wid, q[hh][0], q[hh][1], lane, [] {});
        if (qb == 0 && wid < 4) {
            const int rowm = RX + b * 16 + fr; const int hq = g * 4 + wid;
            const bf16x8 m0 = ld8(M.q_a + (size_t)rowm * 512 + hq * 64 + fq * 8), m1 = ld8(M.q_a + (size_t)rowm * 512 + hq * 64 + 32 + fq * 8);
            attn_wave(M, lds, b, hq, 0, -1, m0, m1, lane, [] {});
        }
    }
    __syncthreads();
}

constexpr int SC_P = 288, SC_KB = 64 * SC_P, SC_BUF = SC_KB + 64 * SC_P;
static_assert(2 * SC_BUF <= LDS_MAIN, "lds");
struct ScanPre { bf16x8 k[2]; bf16x8 v[2]; };
DI void scan_prefetch(ScanPre& R, const bf16_t* kd, const bf16_t* vt, int n, int tid) {
    asm volatile("" : "+v"(tid));
#pragma unroll
    for (int i = 0; i < 2; ++i) { const int c = tid + 512 * i; R.k[i] = ld8(kd + (size_t)(c >> 4) * LP + 128 * n + (c & 15) * 8); R.v[i] = ld8(vt + (size_t)(c >> 4) * LP + 128 * n + (c & 15) * 8); }
}
DI void scan_commit(const ScanPre& R, LAS unsigned char* buf, int tid) {
    asm volatile("" : "+v"(tid));
#pragma unroll
    for (int i = 0; i < 2; ++i) { const int c = tid + 512 * i; *(LAS bf16x8*)(buf + (c >> 4) * SC_P + (c & 15) * 16) = R.k[i]; *(LAS bf16x8*)(buf + SC_KB + (c >> 4) * SC_P + (c & 15) * 16) = R.v[i]; }
}
DI void scan_block(const Mix& M, LAS unsigned char* lds, int item) {
    const int tid = otid(), wid = __builtin_amdgcn_readfirstlane(tid >> 6), lane = tid & 63, fr = lane & 15, fq = lane >> 4;
    const int xq = item & 7, yq = item >> 3;
    const int eh = yq & 1, dir = (yq >> 1) & 1, bh = (yq >> 2) * 8 + xq, h = bh & 7;
    const int efl = wid & 3, dh = wid >> 2;
    const bf16_t* kd = (dir ? M.kdB : M.kdF) + (size_t)bh * 64 * LP;
    const bf16_t* vt = M.v_rT + ((size_t)bh * 128 + eh * 64) * LP;
    const float lg = -__expf(M.rd[dir * 8 + h]); const float gC = __expf(lg * 128.0f);
    bf16_t* sbase = M.states + (((size_t)bh * NCH) * 2 + dir) * 128 * 64 + (size_t)(eh * 64 + efl * 16 + fr) * 64 + dh * 32 + fq * 4;
    f32x4 acc[2];
#pragma unroll
    for (int df = 0; df < 2; ++df) acc[df] = (f32x4){0.f, 0.f, 0.f, 0.f};
    ScanPre ring[4];
#pragma unroll
    for (int s0 = 0; s0 < 4; ++s0) scan_prefetch(ring[s0], kd, vt, dir ? (16 - s0) : s0, tid);
    __syncthreads();
#pragma unroll
    for (int s = 0; s < 16; ++s) {
        LAS unsigned char* buf = lds + (s & 1) * SC_BUF;
        scan_commit(ring[s & 3], buf, tid);
        if (s + 4 < 16) scan_prefetch(ring[s & 3], kd, vt, dir ? (16 - (s + 4)) : (s + 4), tid);
        __syncthreads();
        const int n = dir ? (16 - s) : s;
        bf16_t* sp = sbase + (size_t)n * 2 * 128 * 64;
        st_pair16(sp - fq * 4, acc[0], acc[1], fq);
#pragma unroll
        for (int df = 0; df < 2; ++df) acc[df] *= gC;
        const LAS unsigned char* kp = buf + (dh * 32 + fr) * SC_P + fq * 16;
        const LAS unsigned char* vp = buf + SC_KB + (efl * 16 + fr) * SC_P + fq * 16;
        bf16x8 vy[4], kx[4][2];
#pragma unroll
        for (int ks = 0; ks < 4; ++ks) { vy[ks] = ldsr8(vp + ks * 64);
#pragma unroll
            for (int df = 0; df < 2; ++df) kx[ks][df] = ldsr8(kp + df * 16 * SC_P + ks * 64); }
        SB();
#pragma unroll
        for (int ks = 0; ks < 4; ++ks)
#pragma unroll
            for (int df = 0; df < 2; ++df) acc[df] = mfma16(kx[ks][df], vy[ks], acc[df]);
        SB();
    }
    {
        bf16_t* sp = sbase + (size_t)(dir ? 0 : 16) * 2 * 128 * 64;
        st_pair16(sp - fq * 4, acc[0], acc[1], fq);
    }
    __syncthreads();
}

DI void ret_item(const Mix& M, int b, int h, int n, int iq) {
    const int lane = otid() & 63, fr = lane & 15, fq = lane >> 4;
    const int i = 16 * iq + fr;
    const int rowq = n ? (b * 2048 + (n - 1) * 128 + i) : (RX + b * 16 + (i - 112));
    bf16x8 qy[2];
#pragma unroll
    for (int ks = 0; ks < 2; ++ks) qy[ks] = ld8(M.q_r + (size_t)rowq * 512 + h * 64 + ks * 32 + fq * 8);
    const float lgf = -__expf(M.rd[h]), lgb = -__expf(M.rd[8 + h]);
    const float cf = __expf(lgf * (float)(i + 1)), cb = __expf(lgb * (float)(128 - i));
    const bf16_t* SF = M.states + (((size_t)(b * 8 + h) * NCH + n) * 2 + 0) * 128 * 64 + (size_t)fr * 64 + fq * 8;
    const bf16_t* SBk = SF + 128 * 64;
    const bf16_t* vbase = M.v_rT + ((size_t)(b * 8 + h) * 128 + fr) * LP + 128 * n + fq * 4;
    bf16x8 sfx[8][2], kx[8][2];
#pragma unroll
    for (int ef = 0; ef < 8; ++ef)
#pragma unroll
        for (int ks = 0; ks < 2; ++ks) sfx[ef][ks] = ld8(SF + (size_t)ef * 16 * 64 + ks * 32);
#pragma unroll
    for (int jf = 0; jf < 8; ++jf) {
        const int j = 16 * jf + fr;
        int jm = j - 112; jm = jm < 0 ? 0 : jm;
        const int rowk = n ? (b * 2048 + (n - 1) * 128 + j) : (RX + b * 16 + jm);
        const bf16_t* kp = M.k_r + (size_t)rowk * 512 + h * 64 + fq * 8;
        kx[jf][0] = ld8(kp); kx[jf][1] = ld8(kp + 32);
    }
    SB();
    f32x4 o[8];
#pragma unroll
    for (int ef = 0; ef < 8; ++ef) {
        f32x4 t = {0.f, 0.f, 0.f, 0.f};
        t = mfma16(sfx[ef][0], qy[0], t); t = mfma16(sfx[ef][1], qy[1], t);
        o[ef] = t * cf;
    }
    f32x4 st[8];
#pragma unroll
    for (int jf = 0; jf < 8; ++jf) {
        f32x4 t = {0.f, 0.f, 0.f, 0.f};
        t = mfma16(kx[jf][0], qy[0], t); t = mfma16(kx[jf][1], qy[1], t);
        st[jf] = t;
    }
    SB();
    bf16x8 sbx[8][2];
#pragma unroll
    for (int ef = 0; ef < 8; ++ef)
#pragma unroll
        for (int ks = 0; ks < 2; ++ks) sbx[ef][ks] = ld8(SBk + (size_t)ef * 16 * 64 + ks * 32);
    bf16x4 va[2][8][2];
#pragma unroll
    for (int pr = 0; pr < 2; ++pr)
#pragma unroll
        for (int ef = 0; ef < 8; ++ef) { va[pr][ef][0] = ld4s(vbase + (size_t)ef * 16 * LP + 32 * pr); va[pr][ef][1] = ld4s(vbase + (size_t)ef * 16 * LP + 32 * pr + 16); }
    SB();
#pragma unroll
    for (int ef = 0; ef < 8; ++ef) {
        f32x4 t = {0.f, 0.f, 0.f, 0.f};
        t = mfma16(sbx[ef][0], qy[0], t); t = mfma16(sbx[ef][1], qy[1], t);
        o[ef] += t * cb;
    }
    bf16x8 py[4];
#pragma unroll
    for (int pr = 0; pr < 4; ++pr) {
#pragma unroll
        for (int hh = 0; hh < 2; ++hh) {
            const int jf = 2 * pr + hh;
#pragma unroll
            for (int jj = 0; jj < 4; ++jj) {
                const int jv = 16 * jf + fq * 4 + jj; const int d = i - jv;
                float w = (d >= 0) ? __expf(lgf * (float)d) : __expf(lgb * (float)(-d));
                if (n == 0 && jv < 112) w = 0.f;
                st[jf][jj] *= w;
            }
        }
        py[pr] = pack8(st[2 * pr], st[2 * pr + 1]);
    }
    SB();
    bf16x4 vb[2][8][2];
#pragma unroll
    for (int pr = 0; pr < 2; ++pr)
#pragma unroll
        for (int ef = 0; ef < 8; ++ef) { vb[pr][ef][0] = ld4s(vbase + (size_t)ef * 16 * LP + 32 * (pr + 2)); vb[pr][ef][1] = ld4s(vbase + (size_t)ef * 16 * LP + 32 * (pr + 2) + 16); }
    u32x2 gx[8];
#pragma unroll
    for (int ef = 0; ef < 8; ++ef) gx[ef] = *(const u32x2*)(M.g_r + (size_t)rowq * 1024 + h * 128 + ef * 16 + fq * 4);
    SB();
#pragma unroll
    for (int pr = 0; pr < 2; ++pr)
#pragma unroll
        for (int ef = 0; ef < 8; ++ef) o[ef] = mfma16(cat8(va[pr][ef][0], va[pr][ef][1]), py[pr], o[ef]);
#pragma unroll
    for (int pr = 0; pr < 2; ++pr)
#pragma unroll
        for (int ef = 0; ef < 8; ++ef) o[ef] = mfma16(cat8(vb[pr][ef][0], vb[pr][ef][1]), py[pr + 2], o[ef]);
    float s = 0.f;
#pragma unroll
    for (int ef = 0; ef < 8; ++ef) s += (o[ef][0] + o[ef][1]) + (o[ef][2] + o[ef][3]);
    s += __shfl_xor(s, 16); s += __shfl_xor(s, 32);
    const float mean = s * (1.0f / 128.0f);
    float q = 0.f;
#pragma unroll
    for (int ef = 0; ef < 8; ++ef) { const f32x4 d = o[ef] - mean; q += (d[0] * d[0] + d[1] * d[1]) + (d[2] * d[2] + d[3] * d[3]); }
    q += __shfl_xor(q, 16); q += __shfl_xor(q, 32);
    const float rstd = rsqrtf(q * (1.0f / 128.0f) + EPS);
#pragma unroll
    for (int ef = 0; ef < 8; ++ef) {
        f32x4 gv; gv[0] = __uint_as_float(gx[ef].x << 16); gv[1] = __uint_as_float(gx[ef].x & 0xffff0000u); gv[2] = __uint_as_float(gx[ef].y << 16); gv[3] = __uint_as_float(gx[ef].y & 0xffff0000u);
        st4(M.ycat + (size_t)rowq * 1536 + h * 128 + ef * 16 + fq * 4, (o[ef] - mean) * rstd * gv);
    }
}

constexpr int RET_KP = 208, RET_SP = 160, RET_VP = 288;
constexpr int RET_SFOFF = 128 * RET_KP, RET_SBOFF = RET_SFOFF + 128 * RET_SP, RET_VOFF = RET_SBOFF + 128 * RET_SP;
static_assert(RET_VOFF + 128 * RET_VP <= LDS_MAIN, "lds");
struct RetPre { bf16x8 k[2], sf[2], sb[2], v[4], q[2]; };
DI void ret_prefetch(RetPre& R, const Mix& M, int t, int tid) {
    asm volatile("" : "+v"(tid));
    const int n = (t & 15) + 1, bh = t >> 4, b = bh >> 3, h = bh & 7;
    const int wid = tid >> 6, lane = tid & 63, fr = lane & 15, fq = lane >> 4;
    const bf16_t* SF = M.states + (((size_t)bh * NCH + n) * 2 + 0) * 128 * 64;
#pragma unroll
    for (int i = 0; i < 2; ++i) {
        const int c = tid + 512 * i;
        R.k[i] = ld8(M.k_r + (size_t)(b * 2048 + (n - 1) * 128 + (c >> 3)) * 512 + h * 64 + (c & 7) * 8);
        R.sf[i] = ld8(SF + (size_t)c * 8); R.sb[i] = ld8(SF + 128 * 64 + (size_t)c * 8);
    }
#pragma unroll
    for (int i = 0; i < 4; ++i) { const int c = tid + 512 * i; R.v[i] = ld8(M.v_rT + ((size_t)bh * 128 + (c >> 4)) * LP + 128 * n + (c & 15) * 8); }
    const int rowq = b * 2048 + (n - 1) * 128 + 16 * wid + fr;
    R.q[0] = ld8(M.q_r + (size_t)rowq * 512 + h * 64 + fq * 8); R.q[1] = ld8(M.q_r + (size_t)rowq * 512 + h * 64 + 32 + fq * 8);
}
DI void ret_commit(const RetPre& R, LAS unsigned char* lds, int tid) {
    asm volatile("" : "+v"(tid));
#pragma unroll
    for (int i = 0; i < 2; ++i) {
        const int c = tid + 512 * i;
        *(LAS bf16x8*)(lds + (c >> 3) * RET_KP + (c & 7) * 16) = R.k[i];
        *(LAS bf16x8*)(lds + RET_SFOFF + (c >> 3) * RET_SP + (c & 7) * 16) = R.sf[i];
        *(LAS bf16x8*)(lds + RET_SBOFF + (c >> 3) * RET_SP + (c & 7) * 16) = R.sb[i];
    }
#pragma unroll
    for (int i = 0; i < 4; ++i) { const int c = tid + 512 * i; *(LAS bf16x8*)(lds + RET_VOFF + (c >> 4) * RET_VP + (c & 15) * 16) = R.v[i]; }
}
DI void ret_wave(const Mix& M, const LAS unsigned char* lds, int b, int h, int n, int w, bf16x8 q0, bf16x8 q1, int lane) {
    asm volatile("" : "+v"(lane));
    const int fr = lane & 15, fq = lane >> 4;
    const int i = 16 * w + fr;
    const int rowq = b * 2048 + (n - 1) * 128 + i;
    u32x2 gx[8];
#pragma unroll
    for (int ef = 0; ef < 8; ++ef) gx[ef] = *(const u32x2*)(M.g_r + (size_t)rowq * 1024 + h * 128 + ef * 16 + fq * 4);
    const float lgf = -__expf(M.rd[h]), lgb = -__expf(M.rd[8 + h]);
    const float cf = __expf(lgf * (float)(i + 1)), cb = __expf(lgb * (float)(128 - i));
    f32x4 o[8];
    const LAS unsigned char* sfp = lds + RET_SFOFF + fr * RET_SP + fq * 16;
    const LAS unsigned char* sbp = lds + RET_SBOFF + fr * RET_SP + fq * 16;
#pragma unroll
    for (int e0 = 0; e0 < 8; e0 += 4) {
        bf16x8 xf[4][2], xb[4][2];
#pragma unroll
        for (int u = 0; u < 4; ++u) { const int ef = e0 + u;
            xf[u][0] = ldsr8(sfp + ef * 16 * RET_SP); xf[u][1] = ldsr8(sfp + ef * 16 * RET_SP + 64);
            xb[u][0] = ldsr8(sbp + ef * 16 * RET_SP); xb[u][1] = ldsr8(sbp + ef * 16 * RET_SP + 64); }
        SB();
#pragma unroll
        for (int u = 0; u < 4; ++u) {
            f32x4 t = {0.f, 0.f, 0.f, 0.f}, t2 = {0.f, 0.f, 0.f, 0.f};
            t = mfma16(xf[u][0], q0, t); t = mfma16(xf[u][1], q1, t);
            t2 = mfma16(xb[u][0], q0, t2); t2 = mfma16(xb[u][1], q1, t2);
            o[e0 + u] = t * cf + t2 * cb;
        }
        SB();
    }
    const LAS unsigned char* kb = lds + ((fr >> 2) * 8 + 2 * (fr & 3)) * RET_KP + fq * 16;
    bf16x8 py[4];
    bf16x8 kxa[4][2], kxc[4][2];
#pragma unroll
    for (int blk = 0; blk < 4; ++blk) {
        kxa[blk][0] = ldsr8(kb + blk * 32 * RET_KP); kxa[blk][1] = ldsr8(kb + blk * 32 * RET_KP + 64);
        kxc[blk][0] = ldsr8(kb + blk * 32 * RET_KP + RET_KP); kxc[blk][1] = ldsr8(kb + blk * 32 * RET_KP + RET_KP + 64);
    }
    SB();
#pragma unroll
    for (int blk = 0; blk < 4; ++blk) {
        f32x4 a = {0.f, 0.f, 0.f, 0.f}, c = {0.f, 0.f, 0.f, 0.f};
        a = mfma16(kxa[blk][0], q0, a); a = mfma16(kxa[blk][1], q1, a);
        c = mfma16(kxc[blk][0], q0, c); c = mfma16(kxc[blk][1], q1, c);
#pragma unroll
        for (int jj = 0; jj < 4; ++jj) {
            const int ja = 32 * blk + fq * 8 + 2 * jj; const int da = i - ja, db = da - 1;
            a[jj] *= (da >= 0) ? __expf(lgf * (float)da) : __expf(lgb * (float)(-da));
            c[jj] *= (db >= 0) ? __expf(lgf * (float)db) : __expf(lgb * (float)(-db));
        }
        py[blk] = pack8i(a, c);
    }
    const LAS unsigned char* vp = lds + RET_VOFF + fr * RET_VP + fq * 16;
    SB();
#pragma unroll
    for (int blk = 0; blk < 4; blk += 2) {
        bf16x8 vx[2][8];
#pragma unroll
        for (int u = 0; u < 2; ++u)
#pragma unroll
            for (int ef = 0; ef < 8; ++ef) vx[u][ef] = ldsr8(vp + ef * 16 * RET_VP + (blk + u) * 64);
        SB();
#pragma unroll
        for (int u = 0; u < 2; ++u)
#pragma unroll
            for (int ef = 0; ef < 8; ++ef) o[ef] = mfma16(vx[u][ef], py[blk + u], o[ef]);
        SB();
    }
    float s = 0.f;
#pragma unroll
    for (int ef = 0; ef < 8; ++ef) s += (o[ef][0] + o[ef][1]) + (o[ef][2] + o[ef][3]);
    s += __shfl_xor(s, 16); s += __shfl_xor(s, 32);
    const float mean = s * (1.0f / 128.0f);
    float q = 0.f;
#pragma unroll
    for (int ef = 0; ef < 8; ++ef) { const f32x4 d = o[ef] - mean; q += (d[0] * d[0] + d[1] * d[1]) + (d[2] * d[2] + d[3] * d[3]); }
    q += __shfl_xor(q, 16); q += __shfl_xor(q, 32);
    const float rstd = rsqrtf(q * (1.0f / 128.0f) + EPS);
#pragma unroll
    for (int ef = 0; ef < 8; ef += 2) {
        f32x4 gv, gw;
        gv[0] = __uint_as_float(gx[ef].x << 16); gv[1] = __uint_as_float(gx[ef].x & 0xffff0000u); gv[2] = __uint_as_float(gx[ef].y << 16); gv[3] = __uint_as_float(gx[ef].y & 0xffff0000u);
        gw[0] = __uint_as_float(gx[ef + 1].x << 16); gw[1] = __uint_as_float(gx[ef + 1].x & 0xffff0000u); gw[2] = __uint_as_float(gx[ef + 1].y << 16); gw[3] = __uint_as_float(gx[ef + 1].y & 0xffff0000u);
        st_pair16(M.ycat + (size_t)rowq * 1536 + h * 128 + ef * 16, (o[ef] - mean) * rstd * gv, (o[ef + 1] - mean) * rstd * gw, fq);
    }
}
DI void ret_phase(const Mix& M, LAS unsigned char* lds) {
    const int tid = otid(), wid = __builtin_amdgcn_readfirstlane(tid >> 6), lane = tid & 63;
    const int G = gridDim.x;
    int t = blockIdx.x;
    RetPre R;
    if (t < 1024) ret_prefetch(R, M, t, tid);
    for (; t < 1024; t += G) {
        __syncthreads();
        ret_commit(R, lds, tid);
        const bf16x8 q0 = R.q[0], q1 = R.q[1];
        __syncthreads();
        if (t + G < 1024) ret_prefetch(R, M, t + G, tid);
        const int n = (t & 15) + 1, bh = t >> 4;
        ret_wave(M, lds, bh >> 3, bh & 7, n, wid, q0, q1, lane);
    }
    __syncthreads();
}

DI bf16_t* hrow(const Params& P, int row) { return (bf16_t*)(P.ws + WS_ST) + (size_t)row * 1024; }
template <int NB>
DI void rowpass_rows(const Params& P, const bf16_t* t, const float* gpost, const float* gpre, float* rs, int row0, int rstride, int lane) {
    f32x4 hv[NB][4]; u32x2 tr[NB][4], hr[NB][4];
#pragma unroll
    for (int r = 0; r < NB; ++r) {
        const int row = row0 + r * rstride;
        const bf16_t* hp = hrow(P, row); const bf16_t* tp = t + (size_t)row * 1024;
#pragma unroll
        for (int k = 0; k < 4; ++k) { tr[r][k] = *(const u32x2*)(tp + (k * 64 + lane) * 4); hr[r][k] = *(const u32x2*)(hp + (k * 64 + lane) * 4); }
    }
    f32x4 gp[4];
#pragma unroll
    for (int k = 0; k < 4; ++k) gp[k] = *(const f32x4*)(gpost + (k * 64 + lane) * 4);
    SB();
    float s2[NB];
#pragma unroll
    for (int r = 0; r < NB; ++r) {
        f32x4 tv[4]; float ss = 0.f;
#pragma unroll
        for (int k = 0; k < 4; ++k) {
            tv[k][0] = __uint_as_float(tr[r][k].x << 16); tv[k][1] = __uint_as_float(tr[r][k].x & 0xffff0000u); tv[k][2] = __uint_as_float(tr[r][k].y << 16); tv[k][3] = __uint_as_float(tr[r][k].y & 0xffff0000u);
            hv[r][k][0] = __uint_as_float(hr[r][k].x << 16); hv[r][k][1] = __uint_as_float(hr[r][k].x & 0xffff0000u); hv[r][k][2] = __uint_as_float(hr[r][k].y << 16); hv[r][k][3] = __uint_as_float(hr[r][k].y & 0xffff0000u);
            ss += (tv[k][0] * tv[k][0] + tv[k][1] * tv[k][1]) + (tv[k][2] * tv[k][2] + tv[k][3] * tv[k][3]);
        }
        ss = wsum(ss);
        const float sc = rsqrtf(ss * (1.0f / 1024.0f) + EPS);
        const int row = row0 + r * rstride;
        bf16_t* hp = hrow(P, row);
        float q = 0.f;
#pragma unroll
        for (int k = 0; k < 4; ++k) { hv[r][k] += tv[k] * sc * gp[k];
            if (gpre) st4(hp + (k * 64 + lane) * 4, hv[r][k]); else if (row < RX) *(f32x4*)(P.out + (size_t)row * 1024 + (k * 64 + lane) * 4) = hv[r][k];
            q += (hv[r][k][0] * hv[r][k][0] + hv[r][k][1] * hv[r][k][1]) + (hv[r][k][2] * hv[r][k][2] + hv[r][k][3] * hv[r][k][3]); }
        s2[r] = q;
    }
    if (gpre) {
#pragma unroll
        for (int r = 0; r < NB; ++r) {
            const float sc2 = rsqrtf(wsum(s2[r]) * (1.0f / 1024.0f) + EPS);
            if (lane == 0) rs[row0 + r * rstride] = sc2;
        }
    }
}
DI void rowpass(const Params& P, const bf16_t* t, const float* gpost, const float* gpre, float* u, int gw, int nw) {
    const int lane = otid() & 63;
    for (int base = gw; base < RX; base += nw * 4) {
        if (base + 3 * nw < RX) rowpass_rows<4>(P, t, gpost, gpre, u, base, nw, lane);
        else for (int row = base; row < RX; row += nw) rowpass_rows<1>(P, t, gpost, gpre, u, row, 0, lane);
    }
    for (int row = RX + gw; row < RT; row += nw) rowpass_rows<1>(P, t, gpost, gpre, u, row, 0, lane);
}
DI void rowinit(const Params& P, float* rs, int gw, int nw) {
    const int lane = otid() & 63;
    for (int row = gw; row < RT; row += nw) {
        bf16_t* hp = hrow(P, row);
        const float* src = row < RX ? P.x + (size_t)row * 1024 : P.meta + (size_t)((row - RX) & 15) * 1024;
        f32x4 hv[4]; float s2 = 0.f;
#pragma unroll
        for (int k = 0; k < 4; ++k) hv[k] = *(const f32x4*)(src + (k * 64 + lane) * 4);
        SB();
#pragma unroll
        for (int k = 0; k < 4; ++k) { st4(hp + (k * 64 + lane) * 4, hv[k]);
            s2 += (hv[k][0] * hv[k][0] + hv[k][1] * hv[k][1]) + (hv[k][2] * hv[k][2] + hv[k][3] * hv[k][3]); }
        s2 = wsum(s2);
        if (lane == 0) rs[row] = rsqrtf(s2 * (1.0f / 1024.0f) + EPS);
    }
}

DI int perm64(int mode, int w) { return mode == 1 ? ((w >> 1) + 32 * (w & 1)) : (mode == 2 ? (w < 16 ? ((w >> 1) + 8 * (w & 1)) : w) : w); }
struct ConvJob { const float* W; bf16_t* Bt; const float* gain; int ncols, k0, n0, ldb, koff, mode; };
DI ConvJob conv_decode(const Params& P, int l, int job) {
    unsigned char* wb = P.ws + WS_W;
    ConvJob J; int j = job; J.gain = nullptr;
    if (j < 1472) { J.gain = P.n_mix_pre + l * 1024; const int nt = j % 92, kt = j / 92; const int c0 = nt * 64;
        J.W = P.w_in + (size_t)l * 1024 * DIN; J.ncols = DIN; J.k0 = kt * 64; J.n0 = c0; J.Bt = (bf16_t*)(wb + W_IN); J.ldb = 1024; J.koff = 0;
        J.mode = c0 < 1024 ? 1 : ((c0 >= 3072 && c0 < 3712) ? 2 : 0); return J; }
    j -= 1472; J.mode = 0; J.koff = 0; J.ncols = 1024;
    if (j < 256) { J.W = P.w_ret_o + (size_t)l * 1024 * 1024; J.k0 = (j >> 4) * 64; J.n0 = (j & 15) * 64; J.Bt = (bf16_t*)(wb + W_CAT); J.ldb = 1536; return J; }
    j -= 256;
    if (j < 128) { J.W = P.w_att_o + (size_t)l * 512 * 1024; J.k0 = (j >> 4) * 64; J.n0 = (j & 15) * 64; J.Bt = (bf16_t*)(wb + W_CAT); J.ldb = 1536; J.koff = 1024; return J; }
    j -= 128;
    if (j < 256) { J.W = P.w_mix_o + (size_t)l * 1024 * 1024; J.k0 = (j >> 4) * 64; J.n0 = (j & 15) * 64; J.Bt = (bf16_t*)(wb + W_MIX); J.ldb = 1024; return J; }
    j -= 256;
    if (j < 1024) { J.gain = P.n_ff_pre + l * 1024; J.W = P.w_ff1 + (size_t)l * 1024 * 4096; J.ncols = 4096; J.k0 = (j >> 6) * 64; J.n0 = (j & 63) * 64; J.Bt = (bf16_t*)(wb + W_FF1); J.ldb = 1024; return J; }
    j -= 1024;
    J.W = P.w_ff2 + (size_t)l * 4096 * 1024; J.k0 = (j >> 4) * 64; J.n0 = (j & 15) * 64; J.Bt = (bf16_t*)(wb + W_FF2); J.ldb = 4096; return J;
}
DI void convert_weights(const Params& P, int l, LAS unsigned char* lds) {
    LAS float* tiles = (LAS float*)lds;
    const int t = otid();
    const int G = gridDim.x;
    for (int base = blockIdx.x; base < 4160; base += 4 * G) {
        ConvJob J[4]; f32x4 v[4][2];
#pragma unroll
        for (int q = 0; q < 4; ++q) {
            const int job = base + q * G;
            if (job < 4160) {
                J[q] = conv_decode(P, l, job);
#pragma unroll
                for (int rep = 0; rep < 2; ++rep) { const int kk = (t >> 4) + 32 * rep, nn = (t & 15) * 4; v[q][rep] = *(const f32x4*)(J[q].W + (size_t)(J[q].k0 + kk) * J[q].ncols + J[q].n0 + nn);
                    if (J[q].gain) v[q][rep] *= J[q].gain[J[q].k0 + kk]; }
            }
        }
        SB();
#pragma unroll
        for (int q = 0; q < 4; ++q) {
            if (base + q * G < 4160) {
                LAS float* tile = tiles + q * 4160;
#pragma unroll
                for (int rep = 0; rep < 2; ++rep) { const int kk = (t >> 4) + 32 * rep, nn = (t & 15) * 4;
                    tile[kk * 65 + nn] = v[q][rep][0]; tile[kk * 65 + nn + 1] = v[q][rep][1]; tile[kk * 65 + nn + 2] = v[q][rep][2]; tile[kk * 65 + nn + 3] = v[q][rep][3]; }
            }
        }
        __syncthreads();
#pragma unroll
        for (int q = 0; q < 4; ++q) {
            if (base + q * G < 4160) {
                const LAS float* tile = tiles + q * 4160;
                const int nq = t >> 3, kk8 = (t & 7) * 8, sc = perm64(J[q].mode, nq);
                u32x4 w;
                w.x = pk2(tile[(kk8 + 0) * 65 + sc], tile[(kk8 + 1) * 65 + sc]); w.y = pk2(tile[(kk8 + 2) * 65 + sc], tile[(kk8 + 3) * 65 + sc]);
                w.z = pk2(tile[(kk8 + 4) * 65 + sc], tile[(kk8 + 5) * 65 + sc]); w.w = pk2(tile[(kk8 + 6) * 65 + sc], tile[(kk8 + 7) * 65 + sc]);
                *(u32x4*)(J[q].Bt + (size_t)(J[q].n0 + nq) * J[q].ldb + J[q].koff + J[q].k0 + kk8) = w;
            }
        }
        __syncthreads();
    }
}

DI void make_tables(const Params& P) {
    float* tabR = (float*)(P.ws + WS_TABR); float* tabA = (float*)(P.ws + WS_TABA);
    const int gt = blockIdx.x * blockDim.x + otid(), nth = gridDim.x * blockDim.x;
    for (int idx = gt; idx < 2064 * 40; idx += nth) {
        int p, i; float fr; float* dst;
        if (idx < 2064 * 32) { p = idx >> 5; i = idx & 31; fr = powf(10000.0f, -(float)(2 * i) / 64.0f); dst = tabR + (size_t)idx * 2; }
        else { const int k = idx - 2064 * 32; p = k >> 3; i = k & 7; fr = powf(500000.0f, -(float)(2 * i) / 16.0f); dst = tabA + (size_t)k * 2; }
        const float ang = (float)p * fr;
        double rev = (double)ang * 0.15915494309189533576888; rev -= floor(rev);
        const float r = (float)(rev * 6.283185307179586476925);
        dst[0] = __cosf(r); dst[1] = __sinf(r);
    }
}
DI void zero_pads(const Params& P) {
    unsigned char* proj = P.ws + WS_PROJ;
    const int gt = blockIdx.x * blockDim.x + otid(), nth = gridDim.x * blockDim.x;
    const u32x4 z = {0u, 0u, 0u, 0u};
    for (int idx = gt; idx < 17408 * 14; idx += nth) {
        int r = idx / 14; const int c = idx - r * 14;
        bf16_t* base;
        if (r < 4096) base = (bf16_t*)(proj + P_KDF); else if (r < 8192) { base = (bf16_t*)(proj + P_KDB); r -= 4096; }
        else if (r < 16384) { base = (bf16_t*)(proj + P_VRT); r -= 8192; } else { base = (bf16_t*)(proj + P_VAT); r -= 16384; }
        *(u32x4*)(base + (size_t)r * LP + c * 8) = z;
    }
}

#define XB_TMO      128
#define XB_XCNT(j)  (256  + 64 * (j))
#define XB_XSUB(j)  (1280 + 64 * (j))
#define XB_XGEN(j)  (2304 + 64 * (j))
#define XB_TOP      3328
#define XB_TOPGEN   3392
#define XCD_BAR_WORDS 3456
#define XB_SPIN_CAP (1u << 22)
DI unsigned xb_ld(unsigned* p)              { return __hip_atomic_load(p, __ATOMIC_RELAXED, __HIP_MEMORY_SCOPE_AGENT); }
DI unsigned xb_add(unsigned* p, unsigned v) { return __hip_atomic_fetch_add(p, v, __ATOMIC_RELAXED, __HIP_MEMORY_SCOPE_AGENT); }
DI unsigned xb_xcc_id() { return (unsigned)__builtin_amdgcn_s_getreg((3 << 11) | 20) & 0xFu; }
#define XB_SPIN(cond, bar) do { unsigned _sp = 0; while (cond) { __builtin_amdgcn_s_sleep(1); \
    if ((++_sp & 255u) == 0u) { if (xb_ld(&(bar)[XB_TMO])) break; if (_sp > XB_SPIN_CAP) { atomicAdd(&(bar)[XB_TMO], 1u); break; } } } } while (0)
struct XcdBarrier { unsigned* bar; unsigned x; volatile LAS unsigned* st; };
DI XcdBarrier xcd_barrier_post(unsigned* bar, volatile LAS unsigned* st) {
    XcdBarrier b; b.bar = bar; b.x = xb_xcc_id(); b.st = st;
    if (threadIdx.x == 0) (void)xb_add(&bar[XB_XCNT(b.x)], 1u);
    return b;
}
DI void xcd_barrier_complete(unsigned* bar, unsigned x, unsigned& nloc, unsigned& nx) {
    const unsigned G = gridDim.x * gridDim.y * gridDim.z;
    unsigned sum, cnt, mine, sp = 0u;
    for (;;) {
        sum = 0u; cnt = 0u; mine = 0u;
#pragma unroll
        for (unsigned j = 0; j < 16; ++j) { const unsigned c = xb_ld(&bar[XB_XCNT(j)]); sum += c; cnt += (c > 0u) ? 1u : 0u; mine = (j == x) ? c : mine; }
        if (sum == G) break;
        __builtin_amdgcn_s_sleep(1);
        if ((++sp & 255u) == 0u) { if (xb_ld(&bar[XB_TMO])) break; if (sp > XB_SPIN_CAP) { atomicAdd(&bar[XB_TMO], 1u); break; } }
    }
    nloc = mine > 0u ? mine : 1u; nx = cnt > 0u ? cnt : 1u;
}
DI void xcd_barrier(const XcdBarrier& b) {
    asm volatile("s_waitcnt vmcnt(0)" ::: "memory");
    __syncthreads();
    if (threadIdx.x == 0) {
        unsigned* bar = b.bar;
        __builtin_amdgcn_s_waitcnt(0);
        unsigned nloc = b.st[0], nx = b.st[1];
        if (nloc == 0u) { xcd_barrier_complete(bar, b.x, nloc, nx); b.st[0] = nloc; b.st[1] = nx; }
        const unsigned old = xb_add(&bar[XB_XSUB(b.x)], 1u);
        const unsigned gen = old / nloc;
        if (old + 1u == (gen + 1u) * nloc) {
            __builtin_amdgcn_fence(__ATOMIC_RELEASE, "agent");
            asm volatile("s_waitcnt vmcnt(0)" ::: "memory");
            const unsigned og = xb_add(&bar[XB_TOP], 1u);
            const unsigned tg = og / nx;
            if (og + 1u == (tg + 1u) * nx) xb_add(&bar[XB_TOPGEN], 1u);
            else XB_SPIN(xb_ld(&bar[XB_TOPGEN]) == tg, bar);
            __builtin_amdgcn_fence(__ATOMIC_ACQUIRE, "agent");
            xb_add(&bar[XB_XGEN(b.x)], 1u);
            asm volatile("s_waitcnt vmcnt(0)" ::: "memory");
        } else {
            XB_SPIN(xb_ld(&bar[XB_XGEN(b.x)]) == gen, bar);
            __builtin_amdgcn_fence(__ATOMIC_ACQUIRE, "agent");
            asm volatile("s_waitcnt vmcnt(0)" ::: "memory");
        }
    }
    __syncthreads();
}

__global__ void __launch_bounds__(512, 2) mega(Params P) {
    extern __shared__ __attribute__((aligned(16))) unsigned char lds_raw[];
    LAS unsigned char* lds = (LAS unsigned char*)lds_raw;
    cg::grid_group grid = cg::this_grid();
    if (threadIdx.x < 4) ((volatile LAS unsigned*)(lds + LDS_MAIN))[threadIdx.x] = 0u;
    __syncthreads();
    XcdBarrier xb = xcd_barrier_post((unsigned*)(P.ws + WS_BAR), (volatile LAS unsigned*)(lds + LDS_MAIN));
    const int wid = __builtin_amdgcn_readfirstlane(threadIdx.x >> 6);
    const int G = gridDim.x, nw = G * 8;
    const int gw = blockIdx.x * 8 + wid;
    const int gws = wid * G + blockIdx.x;
    unsigned char* ws = P.ws; unsigned char* proj = ws + WS_PROJ;
    bf16_t* U = (bf16_t*)(ws + WS_U); bf16_t* YC = (bf16_t*)(ws + WS_U);
    bf16_t* ST = (bf16_t*)P.out; bf16_t* Z = (bf16_t*)P.out;
    bf16_t* FFH = (bf16_t*)(proj + P_FFH); bf16_t* MIXF = (bf16_t*)(proj + P_MIX);
    const bf16_t* Win = (const bf16_t*)(ws + WS_W + W_IN); const bf16_t* Wcat = (const bf16_t*)(ws + WS_W + W_CAT);
    const bf16_t* Wmix = (const bf16_t*)(ws + WS_W + W_MIX); const bf16_t* Wff1 = (const bf16_t*)(ws + WS_W + W_FF1); const bf16_t* Wff2 = (const bf16_t*)(ws + WS_W + W_FF2);

    float* RS = (float*)(ws + WS_HMETA);
    const bf16_t* H16 = (const bf16_t*)(ws + WS_ST);
    if (P.ws == nullptr) grid.sync();

    for (int l = -1; l < 4; ++l) {
      if (l < 0) {
        make_tables(P);
        rowinit(P, RS, gw, nw);
      } else {
        for (int rep = 0; rep < REP_G1; ++rep) {
            zero_pads(P);
            EpiIn e; e.proj = proj; e.tabR = (const float*)(ws + WS_TABR); e.tabA = (const float*)(ws + WS_TABA); e.rd = P.ret_decay + l * 16; e.rs = RS;
            const int rem = 1472 % G; const bool fold = rem && (G - rem) >= 23;
            SchedPlain S; S.T.init(DIN, fold ? 1 : 0); S.A = (const char*)H16; S.B = (const char*)Win; S.tstep = (size_t)256 * 1024 * 2; S.nt = 16;
            MainEpiIn me; me.e = e;
            gemm_main(lds, 1024, S, me);
            if (!fold) gemm_tail(lds, H16, Win, 1024, 1024, DIN, e);
        }
        xcd_barrier(xb);
        Mix M; M.q_r = (const bf16_t*)(proj + P_QR); M.k_r = (const bf16_t*)(proj + P_KR); M.kdF = (const bf16_t*)(proj + P_KDF); M.kdB = (const bf16_t*)(proj + P_KDB);
        M.v_rT = (const bf16_t*)(proj + P_VRT); M.g_r = (const bf16_t*)(proj + P_GR); M.q_a = (const bf16_t*)(proj + P_QA); M.k_a = (const bf16_t*)(proj + P_KA);
        M.v_aT = (const bf16_t*)(proj + P_VAT); M.states = ST; M.ycat = YC; M.rd = P.ret_decay + l * 16; M.sink = P.attn_sink + l * 8;
        for (int rep = 0; rep < REP_MX; ++rep) {
            for (int it = blockIdx.x; it < 256; it += G) scan_block(M, lds, it);
            attn_phase(M, lds, blockIdx.x, G, (256 - (int)blockIdx.x + G - 1) / G);
        }
        xcd_barrier(xb);
        for (int rep = 0; rep < REP_MX; ++rep) {
            ret_phase(M, lds);
            for (int it = gws; it < 64; it += nw) ret_item(M, it >> 3, it & 7, 0, 7);
        }
        xcd_barrier(xb);
        for (int rep = 0; rep < REP_G23; ++rep) {
            SchedGate S; S.T.init(1024); S.A = (const char*)YC; S.B = (const char*)Wcat; S.tstep = (size_t)256 * 1536 * 2;
            MainEpiGate me; me.gr = (const bf16_t*)(proj + P_GATER); me.ga = (const bf16_t*)(proj + P_GATEA); me.z = Z;
            gemm_main(lds, 1536, S, me);
            if (l < 3) gemm_tail_gate(lds, YC, Wcat, me.gr, me.ga, Z);
        }
        xcd_barrier(xb);
        for (int rep = 0; rep < REP_G23; ++rep) {
            SchedPlain S; S.T.init(1024); S.A = (const char*)Z; S.B = (const char*)Wmix; S.tstep = (size_t)256 * 1024 * 2; S.nt = 16;
            MainEpiBf16 me; me.out = MIXF; EpiF32 te; te.out = MIXF;
            gemm_main(lds, 1024, S, me);
            if (l < 3) gemm_tail(lds, Z, Wmix, 1024, 1024, 1024, te);
        }
        xcd_barrier(xb);
        rowpass(P, MIXF, P.n_mix_post + l * 1024, P.n_ff_pre + l * 1024, RS, gw, nw);
        xcd_barrier(xb);
        for (int rep = 0; rep < REP_FF; ++rep) {
            SchedPlain S; S.T.init(DFF); S.A = (const char*)H16; S.B = (const char*)Wff1; S.tstep = (size_t)256 * 1024 * 2; S.nt = 16;
            MainEpiRelu2 me; me.out = FFH; me.rs = RS; EpiRelu2 te; te.out = FFH; te.rs = RS;
            gemm_main(lds, 1024, S, me);
            if (l < 3) gemm_tail(lds, H16, Wff1, 1024, 1024, DFF, te);
        }
        xcd_barrier(xb);
        for (int rep = 0; rep < REP_FF; ++rep) {
            SchedPlain S; S.T.init(1024); S.A = (const char*)FFH; S.B = (const char*)Wff2; S.tstep = (size_t)256 * 4096 * 2; S.nt = 64;
            MainEpiBf16 me; me.out = MIXF; EpiF32 te; te.out = MIXF;
            gemm_main(lds, 4096, S, me);
            if (l < 3) gemm_tail(lds, FFH, Wff2, 4096, 4096, 1024, te);
        }
        xcd_barrier(xb);
        rowpass(P, MIXF, P.n_ff_post + l * 1024, l < 3 ? P.n_mix_pre + (l + 1) * 1024 : nullptr, RS, gw, nw);
      }
        if (l < 3) { convert_weights(P, l + 1, lds); xcd_barrier(xb); }
    }
}

extern "C" void kernel_launch(void* const* d_in, const int* in_sizes, int n_in, void* d_out, int out_size, void* d_ws, size_t ws_size, hipStream_t stream) {
    static int grid_blocks = 0;
    if (!grid_blocks) {
        int dev = 0, cus = 0, per_cu = 0;
        hipGetDevice(&dev);
        hipDeviceGetAttribute(&cus, hipDeviceAttributeMultiprocessorCount, dev);
        hipFuncSetAttribute((const void*)mega, hipFuncAttributeMaxDynamicSharedMemorySize, LDS_BYTES);
        hipOccupancyMaxActiveBlocksPerMultiprocessor(&per_cu, (const void*)mega, 512, LDS_BYTES);
        if (per_cu < 1) per_cu = 1;
        grid_blocks = cus * per_cu;
        if (ws_size < WS_END) fprintf(stderr, "kernel_launch: workspace too small: %zu < %zu\n", ws_size, (size_t)WS_END);
    }
    Params p{};
    p.x = (const float*)d_in[0]; p.meta = (const float*)d_in[1]; p.w_in = (const float*)d_in[2]; p.w_ret_o = (const float*)d_in[3];
    p.w_att_o = (const float*)d_in[4]; p.w_mix_o = (const float*)d_in[5]; p.w_ff1 = (const float*)d_in[6]; p.w_ff2 = (const float*)d_in[7];
    p.n_mix_pre = (const float*)d_in[8]; p.n_mix_post = (const float*)d_in[9]; p.n_ff_pre = (const float*)d_in[10]; p.n_ff_post = (const float*)d_in[11];
    p.ret_decay = (const float*)d_in[12]; p.attn_sink = (const float*)d_in[13];
    p.out = (float*)d_out; p.ws = (unsigned char*)d_ws;
    (void)hipMemsetAsync((unsigned char*)d_ws + WS_BAR, 0, 16384, stream);
    void* args[] = {&p};
    hipError_t e = hipLaunchCooperativeKernel((const void*)mega, dim3(grid_blocks), dim3(512), args, LDS_BYTES, stream);
    if (e != hipSuccess) fprintf(stderr, "cooperative launch failed: %s (grid %d)\n", hipGetErrorString(e), grid_blocks);
}
```

```cpp
#include <hip/hip_runtime.h>
#include <hip/hip_cooperative_groups.h>
#include <cstdio>
namespace cg = cooperative_groups;
#ifndef REP_G1
#define REP_G1 1
#endif
#ifndef REP_MX
#define REP_MX 1
#endif
#ifndef REP_FF
#define REP_FF 1
#endif
#ifndef REP_G23
#define REP_G23 1
#endif

#define LAS __attribute__((address_space(3)))
#define DI __device__ __forceinline__
typedef unsigned short bf16_t;
typedef short bf16x8 __attribute__((ext_vector_type(8)));
typedef short bf16x4 __attribute__((ext_vector_type(4)));
typedef float f32x4 __attribute__((ext_vector_type(4)));
typedef float f32x2 __attribute__((ext_vector_type(2)));
typedef unsigned u32x4 __attribute__((ext_vector_type(4)));
typedef unsigned u32x2 __attribute__((ext_vector_type(2)));
typedef __bf16 bfx2 __attribute__((ext_vector_type(2)));

constexpr int RX = 16384;
constexpr int RT = 16512;
constexpr int DM = 1024, DIN = 5888, DFF = 4096, LP = 2176, NCH = 17;
constexpr float EPS = 1e-6f;

constexpr size_t WS_HMETA = 0;
constexpr size_t WS_TABR = WS_HMETA + (size_t)128 * 1024 * 4;
constexpr size_t WS_TABA = WS_TABR + (size_t)2064 * 32 * 2 * 4;
constexpr size_t WS_W = WS_TABA + (size_t)2064 * 8 * 2 * 4;
constexpr size_t W_IN = 0;
constexpr size_t W_CAT = W_IN + (size_t)DIN * 1024 * 2;
constexpr size_t W_MIX = W_CAT + (size_t)1024 * 1536 * 2;
constexpr size_t W_FF1 = W_MIX + (size_t)1024 * 1024 * 2;
constexpr size_t W_FF2 = W_FF1 + (size_t)4096 * 1024 * 2;
constexpr size_t W_END = W_FF2 + (size_t)1024 * 4096 * 2;
constexpr size_t WS_U = WS_W + W_END;
constexpr size_t WS_ST = WS_U + (size_t)RT * 1536 * 2;
constexpr size_t WS_PROJ = WS_ST + (size_t)8 * 8 * 17 * 2 * 128 * 64 * 2;
constexpr size_t P_QR = 0;
constexpr size_t P_KR = P_QR + (size_t)RT * 512 * 2;
constexpr size_t P_KDF = P_KR + (size_t)RT * 512 * 2;
constexpr size_t P_KDB = P_KDF + (size_t)64 * 64 * LP * 2;
constexpr size_t P_VRT = P_KDB + (size_t)64 * 64 * LP * 2;
constexpr size_t P_GR = P_VRT + (size_t)64 * 128 * LP * 2;
constexpr size_t P_QA = P_GR + (size_t)RT * 1024 * 2;
constexpr size_t P_KA = P_QA + (size_t)RT * 512 * 2;
constexpr size_t P_VAT = P_KA + (size_t)RT * 128 * 2;
constexpr size_t P_GATER = P_VAT + (size_t)16 * 64 * LP * 2;
constexpr size_t P_GATEA = P_GATER + (size_t)RT * 1024 * 2;
constexpr size_t P_END = P_GATEA + (size_t)RT * 1024 * 2;
constexpr size_t P_FFH = 0;
constexpr size_t P_MIX = (size_t)RT * 4096 * 2;
static_assert(P_MIX + (size_t)RT * 1024 * 4 <= P_END, "alias");
constexpr size_t WS_BAR = WS_PROJ + P_END;
constexpr size_t WS_END = WS_BAR + 16384;

constexpr int LDS_MAIN = 134400;
constexpr int LDS_BYTES = LDS_MAIN + 16;

struct Params {
    const float *x, *meta, *w_in, *w_ret_o, *w_att_o, *w_mix_o, *w_ff1, *w_ff2;
    const float *n_mix_pre, *n_mix_post, *n_ff_pre, *n_ff_post, *ret_decay, *attn_sink;
    float* out; unsigned char* ws;
};

DI unsigned pk2(float lo, float hi) { f32x2 v = {lo, hi}; bfx2 b = __builtin_convertvector(v, bfx2); return __builtin_bit_cast(unsigned, b); }
DI u32x2 pk4(f32x4 v) { u32x2 r; r.x = pk2(v[0], v[1]); r.y = pk2(v[2], v[3]); return r; }
DI void st4(bf16_t* p, f32x4 v) { *(u32x2*)p = pk4(v); }
DI void st_pair16(bf16_t* p, f32x4 a, f32x4 b, int fq) {
    const u32x2 pa = pk4(a), pb = pk4(b);
    const auto r0 = __builtin_amdgcn_permlane16_swap(pa.x, pb.x, false, false);
    const auto r1 = __builtin_amdgcn_permlane16_swap(pa.y, pb.y, false, false);
    u32x4 w; w.x = r0[0]; w.y = r1[0]; w.z = r0[1]; w.w = r1[1];
    *(u32x4*)(p + (fq & 1) * 16 + (fq >> 1) * 8) = w;
}
DI bf16_t bf1(float x) { return (bf16_t)(pk2(x, x) & 0xffffu); }
DI f32x4 ld4(const bf16_t* p) {
    u32x2 w = *(const u32x2*)p; f32x4 r;
    r[0] = __uint_as_float(w.x << 16); r[1] = __uint_as_float(w.x & 0xffff0000u);
    r[2] = __uint_as_float(w.y << 16); r[3] = __uint_as_float(w.y & 0xffff0000u); return r;
}
DI bf16x8 pack8(f32x4 a, f32x4 b) { u32x4 w; w.x = pk2(a[0], a[1]); w.y = pk2(a[2], a[3]); w.z = pk2(b[0], b[1]); w.w = pk2(b[2], b[3]); return __builtin_bit_cast(bf16x8, w); }
DI bf16x8 cat8(bf16x4 lo, bf16x4 hi) { return __builtin_shufflevector(lo, hi, 0, 1, 2, 3, 4, 5, 6, 7); }
DI bf16x8 ld8(const bf16_t* p) { return *(const bf16x8*)p; }
DI bf16x4 ld4s(const bf16_t* p) { return *(const bf16x4*)p; }
DI f32x4 mfma16(bf16x8 a, bf16x8 b, f32x4 c) { return __builtin_amdgcn_mfma_f32_16x16x32_bf16(a, b, c, 0, 0, 0); }
DI float sigm(float x) { return __builtin_amdgcn_rcpf(1.0f + __expf(-x)); }
DI float wsum(float v) { v += __shfl_xor(v, 1); v += __shfl_xor(v, 2); v += __shfl_xor(v, 4); v += __shfl_xor(v, 8); v += __shfl_xor(v, 16); v += __shfl_xor(v, 32); return v; }
DI int otid() { int t = threadIdx.x; asm volatile("" : "+v"(t)); return t; }
DI void row_bp(int row, int& b, int& p, int& pp) {
    if (row < RX) { b = row >> 11; const int s = row & 2047; p = 16 + s; pp = 128 + s; }
    else { const int m = row - RX; b = m >> 4; p = m & 15; pp = 112 + p; }
}

DI void unpack8(u32x4 w, f32x4& lo, f32x4& hi) {
    lo[0] = __uint_as_float(w.x << 16); lo[1] = __uint_as_float(w.x & 0xffff0000u); lo[2] = __uint_as_float(w.y << 16); lo[3] = __uint_as_float(w.y & 0xffff0000u);
    hi[0] = __uint_as_float(w.z << 16); hi[1] = __uint_as_float(w.z & 0xffff0000u); hi[2] = __uint_as_float(w.w << 16); hi[3] = __uint_as_float(w.w & 0xffff0000u);
}
DI void st8(bf16_t* p, f32x4 a, f32x4 b) { u32x4 w; w.x = pk2(a[0], a[1]); w.y = pk2(a[2], a[3]); w.z = pk2(b[0], b[1]); w.w = pk2(b[2], b[3]); *(u32x4*)p = w; }
struct EpiIn {
    unsigned char* proj; const float* tabR; const float* tabA; const float* rd; const float* rs;
    template <int SEC> DI f32x4 load_cs(int row, int col) const {
        int b, p, pp; row_bp(row, b, p, pp);
        if (SEC == 0 || SEC == 1) { const int w = col & 63; return *(const f32x4*)(tabR + ((size_t)p * 32 + (w >> 1)) * 2); }
        if (SEC == 4 || SEC == 5) { const int w = col & 63; if (w < 16) return *(const f32x4*)(tabA + ((size_t)p * 8 + (w >> 1)) * 2); }
        return (f32x4){1.f, 0.f, 1.f, 0.f};
    }
    template <int SEC> DI f32x4 xform(f32x4 v, f32x4 cs) const {
        f32x4 o = v;
        if (SEC == 0 || SEC == 1 || SEC == 4 || SEC == 5) {
            o[0] = v[0] * cs[0] - v[1] * cs[1]; o[1] = v[1] * cs[0] + v[0] * cs[1];
            o[2] = v[2] * cs[2] - v[3] * cs[3]; o[3] = v[3] * cs[2] + v[2] * cs[3];
            if (SEC == 0 || SEC == 4) o *= 0.125f;
        } else if (SEC == 3) {
#pragma unroll
            for (int jj = 0; jj < 4; ++jj) o[jj] = v[jj] * sigm(v[jj]);
        } else if (SEC == 7 || SEC == 8) {
#pragma unroll
            for (int jj = 0; jj < 4; ++jj) o[jj] = sigm(v[jj]);
        }
        return o;
    }
    template <int SEC> DI bf16_t* dst(int row, int col) const {
        if (SEC == 0) return (bf16_t*)(proj + P_QR) + (size_t)row * 512 + col;
        if (SEC == 1) return (bf16_t*)(proj + P_KR) + (size_t)row * 512 + (col - 512);
        if (SEC == 3) return (bf16_t*)(proj + P_GR) + (size_t)row * 1024 + (col - 2048);
        if (SEC == 4) return (bf16_t*)(proj + P_QA) + (size_t)row * 512 + (col - 3072);
        if (SEC == 5) return (bf16_t*)(proj + P_KA) + (size_t)row * 128 + (col - 3584);
        if (SEC == 7) return (bf16_t*)(proj + P_GATER) + (size_t)row * 1024 + (col - 3840);
        if (SEC == 8) return (bf16_t*)(proj + P_GATEA) + (size_t)row * 1024 + (col - 4864);
        return nullptr;
    }
    template <int SEC> DI void scatter(int row, int col, f32x4 o, float lgf, float lgb) const {
        if (SEC != 1 && SEC != 2 && SEC != 6) return;
        int b, p, pp; row_bp(row, b, p, pp);
        if (SEC == 1) {
            const int c = col & 511, w = c & 63, h = c >> 6;
            const int j = pp & 127;
            const float df = __expf(lgf * (float)(127 - j)), db = __expf(lgb * (float)j);
            const size_t base = ((size_t)(b * 8 + h) * 64 + w) * LP + pp;
            bf16_t* kf = (bf16_t*)(proj + P_KDF) + base; bf16_t* kb = (bf16_t*)(proj + P_KDB) + base;
#pragma unroll
            for (int jj = 0; jj < 4; ++jj) { kf[(size_t)jj * LP] = bf1(o[jj] * df); kb[(size_t)jj * LP] = bf1(o[jj] * db); }
        } else if (SEC == 2) {
            const int c = col - 1024, h = c >> 7, e = c & 127;
            bf16_t* vt = (bf16_t*)(proj + P_VRT) + ((size_t)(b * 8 + h) * 128 + e) * LP + pp;
#pragma unroll
            for (int jj = 0; jj < 4; ++jj) vt[(size_t)jj * LP] = bf1(o[jj]);
        } else {
            const int c = col - 3712, g = c >> 6, d = c & 63;
            bf16_t* vt = (bf16_t*)(proj + P_VAT) + ((size_t)(b * 2 + g) * 64 + d) * LP + pp;
#pragma unroll
            for (int jj = 0; jj < 4; ++jj) vt[(size_t)jj * LP] = bf1(o[jj]);
        }
    }
    template <int SEC> DI void body(int row, int col, f32x4 v, f32x4 cs, float lgf, float lgb) const {
        const f32x4 o = xform<SEC>(v * rs[row], cs);
        if (SEC != 2 && SEC != 6) st4(dst<SEC>(row, col), o);
        scatter<SEC>(row, col, o, lgf, lgb);
    }
    template <int SEC> DI void body2(int row, int col, f32x4 v0, f32x4 v1, f32x4 cs0, f32x4 cs1, float lgf, float lgb, float rsv) const {
        const f32x4 o0 = xform<SEC>(v0 * rsv, cs0), o1 = xform<SEC>(v1 * rsv, cs1);
        if (SEC != 2 && SEC != 6) st8(dst<SEC>(row, col), o0, o1);
        scatter<SEC>(row, col, o0, lgf, lgb); scatter<SEC>(row, col + 4, o1, lgf, lgb);
    }
    static DI int section(int col) {
        return col < 512 ? 0 : col < 1024 ? 1 : col < 2048 ? 2 : col < 3072 ? 3 : col < 3584 ? 4 : col < 3712 ? 5 : col < 3840 ? 6 : col < 4864 ? 7 : 8;
    }
    template <int SEC> DI void one(int row, int col, f32x4 v) const {
        float lgf = 0.f, lgb = 0.f;
        if (SEC == 1) { const int h = (col & 511) >> 6; lgf = -__expf(rd[h]); lgb = -__expf(rd[8 + h]); }
        body<SEC>(row, col, v, load_cs<SEC>(row, col), lgf, lgb);
    }
    DI void operator()(int row, int col, f32x4 v) const {
        switch (section(col)) {
            case 0: one<0>(row, col, v); break; case 1: one<1>(row, col, v); break; case 2: one<2>(row, col, v); break;
            case 3: one<3>(row, col, v); break; case 4: one<4>(row, col, v); break; case 5: one<5>(row, col, v); break;
            case 6: one<6>(row, col, v); break; case 7: one<7>(row, col, v); break; default: one<8>(row, col, v); break;
        }
    }
};
struct EpiF32 { bf16_t* out; DI void operator()(int row, int col, f32x4 v) const { st4(out + (size_t)row * 1024 + col, v); } };
struct EpiRelu2 { bf16_t* out; const float* rs; DI void operator()(int row, int col, f32x4 v) const {
    f32x4 o; const float r = rs[row];
#pragma unroll
    for (int jj = 0; jj < 4; ++jj) { const float t = fmaxf(v[jj] * r, 0.f); o[jj] = t * t; }
    st4(out + (size_t)row * 4096 + col, o); } };

constexpr int HALF = 128, BK = 64, HTB = HALF * BK * 2;
DI int lds_byte(int r, int c) { const int st = (r >> 4) * 2 + (c >> 5), rr = r & 15, cc = c & 31, ob = rr * 64 + cc * 2; return st * 1024 + (ob ^ (((ob >> 9) & 1) << 5)); }
DI int perm32(int rho) { const int n = rho >> 4, i = rho & 15; return 8 * (i >> 2) + 4 * n + (i & 3); }
DI void stage_rc(int b, int& R, int& C) { const int st = b / 1024, sb = b % 1024, swz = sb ^ (((sb >> 9) & 1) << 5); R = (st >> 1) * 16 + swz / 64; C = (st & 1) * 32 + (swz % 64) / 2; }

struct Unit { const char* A; const char* B; int nt, pm, pn, kind; };
struct TileOrder {
    int nM, nN, nwg, G, c, extra;
    DI void init(int N, int extra_ = 0) { nM = RX / 256; nN = N / 256; nwg = nM * nN; G = gridDim.x; c = blockIdx.x; extra = extra_; }
    DI bool tile(int i, int& pm, int& pn) const {
        const long L = (long)i * G + c;
        if (L >= nwg) { if (extra && L < nwg + nN) { pm = nM; pn = (int)(L - nwg); return true; } return false; }
        int wgid = (int)L; { const int q = nwg / 8, r = nwg % 8, xcd = wgid % 8, off = wgid / 8; wgid = (xcd < r ? xcd * (q + 1) : r * (q + 1) + (xcd - r) * q) + off; }
        const int nig = 8 * nN, gid = wgid / nig, fm = gid * 8, gsz = (nM - fm) < 8 ? (nM - fm) : 8;
        pm = fm + ((wgid % nig) % gsz); pn = (wgid % nig) / gsz; return true;
    }
};
struct SchedPlain {
    TileOrder T; const char* A; const char* B; size_t tstep; int nt;
    DI bool next(int i, Unit& u) const { if (!T.tile(i, u.pm, u.pn)) return false; u.A = A + (size_t)u.pm * tstep; u.B = B + (size_t)u.pn * tstep; u.nt = nt; u.kind = 1; return true; }
};
struct SchedGate {
    TileOrder T; const char* A; const char* B; size_t tstep;
    DI bool next(int i, Unit& u) const { if (!T.tile(i >> 1, u.pm, u.pn)) return false; const int kind = i & 1; u.kind = kind;
        u.A = A + (size_t)u.pm * tstep + (kind ? 2048 : 0); u.B = B + (size_t)u.pn * tstep + (kind ? 2048 : 0); u.nt = kind ? 8 : 16; return true; }
};

template <class F> DI void for_acc(f32x4 (&acc)[2][2][4][2], const Unit& u, int wr, int wc, int fr, int fq, const F& f) {
#pragma unroll
    for (int bj = 0; bj < 2; ++bj)
#pragma unroll
        for (int ai = 0; ai < 2; ++ai)
#pragma unroll
            for (int m = 0; m < 4; ++m)
#pragma unroll
                for (int n = 0; n < 2; ++n)
                    f(u.pm * 256 + ai * HALF + wr * 64 + m * 16 + fr, u.pn * 256 + bj * HALF + wc * 32 + fq * 8 + n * 4, acc[ai][bj][m][n]);
}
template <class E> struct MainEpi { E e; DI bool run(f32x4 (&acc)[2][2][4][2], const Unit& u, int wr, int wc, int fr, int fq) const {
    for_acc(acc, u, wr, wc, fr, fq, [&](int row, int col, f32x4& v) { e(row, col, v); }); return false; } };
struct MainEpiIn { EpiIn e;
    template <int S> DI void sec_loop(f32x4 (&acc)[2][2][4][2], const Unit& u, int bj, int wr, int wc, int fr, int fq) const {
        const int colb = u.pn * 256 + bj * HALF + wc * 32 + fq * 8;
        float lgf = 0.f, lgb = 0.f;
        if (S == 1) { const int h = ((u.pn * 256 + bj * HALF + wc * 32) & 511) >> 6; lgf = -__expf(e.rd[h]); lgb = -__expf(e.rd[8 + h]); }
#pragma unroll
        for (int ai = 0; ai < 2; ++ai) {
            if (ai == 1 && u.pm == RX / 256) break;
            const int rowb = u.pm * 256 + ai * HALF + wr * 64 + fr;
            f32x4 cs[4][2]; float rsv[4];
#pragma unroll
            for (int m = 0; m < 4; ++m) { rsv[m] = e.rs[rowb + m * 16];
#pragma unroll
                for (int n = 0; n < 2; ++n) cs[m][n] = e.load_cs<S>(rowb + m * 16, colb + n * 4); }
#pragma unroll
            for (int m = 0; m < 4; ++m) e.body2<S>(rowb + m * 16, colb, acc[ai][bj][m][0], acc[ai][bj][m][1], cs[m][0], cs[m][1], lgf, lgb, rsv[m]);
        }
    }
    DI bool run(f32x4 (&acc)[2][2][4][2], const Unit& u, int wr, int wc, int fr, int fq) const {
        {
            const int sec0 = EpiIn::section(u.pn * 256);
#define SECCASE(S, BJ) case S: sec_loop<S>(acc, u, BJ, wr, wc, fr, fq); break;
            switch (sec0) { SECCASE(0, 0) SECCASE(1, 0) SECCASE(2, 0) SECCASE(3, 0) SECCASE(4, 0) SECCASE(5, 0) SECCASE(6, 0) SECCASE(7, 0) default: sec_loop<8>(acc, u, 0, wr, wc, fr, fq); break; }
            const int sec1 = EpiIn::section(u.pn * 256 + HALF);
            switch (sec1) { SECCASE(0, 1) SECCASE(1, 1) SECCASE(2, 1) SECCASE(3, 1) SECCASE(4, 1) SECCASE(5, 1) SECCASE(6, 1) SECCASE(7, 1) default: sec_loop<8>(acc, u, 1, wr, wc, fr, fq); break; }
#undef SECCASE
        }
        return false; } };
struct MainEpiGate { const bf16_t* gr; const bf16_t* ga; bf16_t* z;
    DI bool run(f32x4 (&acc)[2][2][4][2], const Unit& u, int wr, int wc, int fr, int fq) const {
        const bool k0 = (u.kind == 0);
#pragma unroll
        for (int bj = 0; bj < 2; ++bj)
#pragma unroll
            for (int ai = 0; ai < 2; ++ai) {
                const size_t base = (size_t)(u.pm * 256 + ai * HALF + wr * 64 + fr) * 1024 + (u.pn * 256 + bj * HALF + wc * 32 + fq * 8);
                u32x4 ra[4], rb[4];
#pragma unroll
                for (int m = 0; m < 4; ++m) { rb[m] = *(const u32x4*)(ga + base + (size_t)m * 16 * 1024); if (k0) ra[m] = *(const u32x4*)(gr + base + (size_t)m * 16 * 1024); else ra[m] = rb[m]; }
#pragma unroll
                for (int m = 0; m < 4; ++m) {
                    f32x4 a0, a1, b0, b1; unpack8(ra[m], a0, a1); unpack8(rb[m], b0, b1);
                    f32x4& v0 = acc[ai][bj][m][0]; f32x4& v1 = acc[ai][bj][m][1];
                    if (k0) {
#pragma unroll
                        for (int jj = 0; jj < 4; ++jj) { v0[jj] *= a0[jj] * __builtin_amdgcn_rcpf(fmaxf(b0[jj], 1e-30f)); v1[jj] *= a1[jj] * __builtin_amdgcn_rcpf(fmaxf(b1[jj], 1e-30f)); }
                    } else st8(z + base + (size_t)m * 16 * 1024, v0 * b0, v1 * b1);
                }
            }
        return k0;
    } };
template <class F> DI void for_acc2(f32x4 (&acc)[2][2][4][2], const Unit& u, int wr, int wc, int fr, int fq, const F& f) {
#pragma unroll
    for (int bj = 0; bj < 2; ++bj)
#pragma unroll
        for (int ai = 0; ai < 2; ++ai)
#pragma unroll
            for (int m = 0; m < 4; ++m)
                f(u.pm * 256 + ai * HALF + wr * 64 + m * 16 + fr, u.pn * 256 + bj * HALF + wc * 32 + fq * 8, acc[ai][bj][m][0], acc[ai][bj][m][1]);
}
struct MainEpiBf16 { bf16_t* out; DI bool run(f32x4 (&acc)[2][2][4][2], const Unit& u, int wr, int wc, int fr, int fq) const {
    for_acc2(acc, u, wr, wc, fr, fq, [&](int row, int col, const f32x4& a, const f32x4& b) { st8(out + (size_t)row * 1024 + col, a, b); }); return false; } };
struct MainEpiRelu2 { bf16_t* out; const float* rs; DI bool run(f32x4 (&acc)[2][2][4][2], const Unit& u, int wr, int wc, int fr, int fq) const {
    float rsv[2][4];
#pragma unroll
    for (int ai = 0; ai < 2; ++ai)
#pragma unroll
        for (int m = 0; m < 4; ++m) rsv[ai][m] = rs[u.pm * 256 + ai * HALF + wr * 64 + m * 16 + fr];
#pragma unroll
    for (int bj = 0; bj < 2; ++bj)
#pragma unroll
        for (int ai = 0; ai < 2; ++ai)
#pragma unroll
            for (int m = 0; m < 4; ++m) {
                const int row = u.pm * 256 + ai * HALF + wr * 64 + m * 16 + fr, col = u.pn * 256 + bj * HALF + wc * 32 + fq * 8;
                const f32x4 a = acc[ai][bj][m][0] * rsv[ai][m], b = acc[ai][bj][m][1] * rsv[ai][m];
                f32x4 x, y;
#pragma unroll
                for (int jj = 0; jj < 4; ++jj) { const float t = fmaxf(a[jj], 0.f), w = fmaxf(b[jj], 0.f); x[jj] = t * t; y[jj] = w * w; }
                st8(out + (size_t)row * 4096 + col, x, y);
            }
    return false; } };

template <class Sched, class Epi>
DI void gemm_main(LAS unsigned char* lds, int pitch, const Sched& S, const Epi& E) {
    const int tid = otid(), wid = __builtin_amdgcn_readfirstlane(tid >> 6), lane = tid & 63, wr = wid >> 2, wc = wid & 3, fr = lane & 15, fq = lane >> 4;
    unsigned voff[2], voffB[2];
#pragma unroll
    for (int i = 0; i < 2; ++i) { int R, C; stage_rc(tid * 16 + i * 8192, R, C); voff[i] = (unsigned)(R * pitch + C) * 2u;
        const int Rb = (R & ~31) + perm32(R & 31); voffB[i] = (unsigned)(Rb * pitch + C) * 2u; }
    const size_t kstep = (size_t)(BK * 2);
    const size_t hstep = (size_t)HALF * pitch * 2;
    const unsigned ldsw = (unsigned)wid * 1024u;
    const int aoff = lds_byte(wr * 64 + fr, fq * 8), boff = lds_byte(wc * 32 + fr, fq * 8);
#define G_SA(b, h) (((b) * 2 + (h)) * HTB)
#define G_SB(b, h) ((4 + (b) * 2 + (h)) * HTB)
#define G_STAGEV(bufoff, gbase, VO) do { _Pragma("unroll") for (int _i = 0; _i < 2; ++_i) \
        __builtin_amdgcn_global_load_lds((const unsigned*)((const char*)(gbase) + VO[_i]), (LAS unsigned*)(lds + (bufoff) + ldsw + _i * 8192), 16, 0, 0); } while (0)
#define G_STAGE(bufoff, gbase) G_STAGEV(bufoff, gbase, voff)
#define G_STAGEB(bufoff, gbase) G_STAGEV(bufoff, gbase, voffB)
#define G_LDA(dst, b, h) do { _Pragma("unroll") for (int m = 0; m < 4; ++m) _Pragma("unroll") for (int k = 0; k < 2; ++k) dst[m][k] = *(const LAS bf16x8*)(lds + G_SA(b, h) + aoff + m * 2048 + k * 1024); } while (0)
#define G_LDB(dst, b, h) do { _Pragma("unroll") for (int n = 0; n < 2; ++n) _Pragma("unroll") for (int k = 0; k < 2; ++k) dst[n][k] = *(const LAS bf16x8*)(lds + G_SB(b, h) + boff + n * 2048 + k * 1024); } while (0)
#define G_MMA(ai, bj, At, Bt) do { __builtin_amdgcn_s_setprio(1); _Pragma("unroll") for (int m = 0; m < 4; ++m) _Pragma("unroll") for (int n = 0; n < 2; ++n) _Pragma("unroll") for (int k = 0; k < 2; ++k) \
        acc[ai][bj][m][n] = __builtin_amdgcn_mfma_f32_16x16x32_bf16(Bt[n][k], At[m][k], acc[ai][bj][m][n], 0, 0, 0); __builtin_amdgcn_s_setprio(0); } while (0)
#define G_WAIT_V(n) asm volatile("s_waitcnt vmcnt(" #n ")" ::: "memory")
#define G_WAIT_L(n) asm volatile("s_waitcnt lgkmcnt(" #n ")" ::: "memory")
#define G_BAR __builtin_amdgcn_s_barrier()
#define G_SCHED __builtin_amdgcn_sched_barrier(0)
    Unit cur, nxt; int ui = 0;
    if (!S.next(0, cur)) return;
    f32x4 acc[2][2][4][2];
#pragma unroll
    for (int a = 0; a < 2; ++a)
#pragma unroll
        for (int b = 0; b < 2; ++b)
#pragma unroll
            for (int m = 0; m < 4; ++m)
#pragma unroll
                for (int n = 0; n < 2; ++n) acc[a][b][m][n] = (f32x4){0.f, 0.f, 0.f, 0.f};
    bf16x8 At[4][2], B0[2][2], B1[2][2];
    const char* cA = cur.A; const char* cB = cur.B;
    G_STAGEB(G_SB(0, 0), cB); G_STAGE(G_SA(0, 0), cA); G_STAGEB(G_SB(0, 1), cB + hstep); G_STAGE(G_SA(0, 1), cA + hstep);
    if (wr == 1) G_BAR;
    G_WAIT_V(4); G_BAR;
    G_STAGEB(G_SB(1, 0), cB + kstep); G_STAGE(G_SA(1, 0), cA + kstep); G_STAGEB(G_SB(1, 1), cB + hstep + kstep);
    G_WAIT_V(6); G_BAR;
    for (;;) {
        const bool has_next = S.next(ui + 1, nxt);
        const char* nA = has_next ? nxt.A : cA; const char* nB = has_next ? nxt.B : cB;
        const int nt = cur.nt;
        for (int t = 0; t < nt; t += 2) {
            const bool last = (t == nt - 2);
            const char* a1 = cA + (size_t)(t + 1) * kstep;
            const char* a2 = last ? nA : cA + (size_t)(t + 2) * kstep; const char* b2 = last ? nB : cB + (size_t)(t + 2) * kstep;
            const char* a3 = a2 + kstep; const char* b3 = b2 + kstep;
            G_LDB(B0, 0, 0); G_SCHED; G_LDA(At, 0, 0); G_STAGE(G_SA(1, 1), a1 + hstep);
            G_WAIT_L(8); G_BAR; G_WAIT_L(0); G_MMA(0, 0, At, B0); G_BAR; G_SCHED;
            G_LDB(B1, 0, 1); G_STAGEB(G_SB(0, 0), b2);
            G_BAR; G_WAIT_L(0); G_MMA(0, 1, At, B1); G_BAR;
            G_LDA(At, 0, 1); G_STAGE(G_SA(0, 0), a2);
            G_BAR; G_WAIT_L(0); G_MMA(1, 0, At, B0); G_BAR; G_SCHED;
            G_STAGEB(G_SB(0, 1), b2 + hstep);
            G_WAIT_V(6); G_BAR; G_MMA(1, 1, At, B1); G_BAR;
            G_LDB(B0, 1, 0); G_SCHED; G_LDA(At, 1, 0); G_STAGE(G_SA(0, 1), a2 + hstep);
            G_WAIT_L(8); G_BAR; G_WAIT_L(0); G_MMA(0, 0, At, B0); G_BAR; G_SCHED;
            G_LDB(B1, 1, 1); G_STAGEB(G_SB(1, 0), b3);
            G_BAR; G_WAIT_L(0); G_MMA(0, 1, At, B1); G_BAR;
            G_LDA(At, 1, 1); G_STAGE(G_SA(1, 0), a3);
            G_BAR; G_WAIT_L(0); G_MMA(1, 0, At, B0); G_BAR; G_SCHED;
            G_STAGEB(G_SB(1, 1), b3 + hstep);
            G_WAIT_V(6); G_BAR; G_MMA(1, 1, At, B1); G_BAR;
        }
        const bool keep = E.run(acc, cur, wr, wc, fr, fq);
        if (!has_next) break;
        if (!keep) {
#pragma unroll
            for (int a = 0; a < 2; ++a)
#pragma unroll
                for (int b = 0; b < 2; ++b)
#pragma unroll
                    for (int m = 0; m < 4; ++m)
#pragma unroll
                        for (int n = 0; n < 2; ++n) acc[a][b][m][n] = (f32x4){0.f, 0.f, 0.f, 0.f};
        }
        cur = nxt; cA = nA; cB = nB; ++ui;
    }
    G_WAIT_V(0);
    if (wr == 0) G_BAR;
    G_BAR;
#undef G_SA
#undef G_SB
#undef G_STAGE
#undef G_STAGEV
#undef G_STAGEB
#undef G_LDA
#undef G_LDB
#undef G_MMA
}

#define SB() __builtin_amdgcn_sched_barrier(0)
template <class Epi>
DI void gemm_tail(LAS unsigned char* lds, const bf16_t* A, const bf16_t* Bt, int pitch, int K, int N, const Epi& epi) {
    const int tid = otid(), wid = __builtin_amdgcn_readfirstlane(tid >> 6), lane = tid & 63, fr = lane & 15, fq = lane >> 4;
    LAS f32x4* red = (LAS f32x4*)lds;
    const int nitems = 8 * (N >> 6);
    const int kslice = K >> 3;
    for (int it = blockIdx.x; it < nitems; it += gridDim.x) {
        const int rt = it & 7, cg = it >> 3;
        const bf16_t* ap = A + (size_t)(RX + rt * 16 + fr) * pitch + fq * 8 + wid * kslice;
        const bf16_t* bp = Bt + (size_t)(cg * 64 + fr) * pitch + fq * 8 + wid * kslice;
        f32x4 acc[4];
#pragma unroll
        for (int cf = 0; cf < 4; ++cf) acc[cf] = (f32x4){0.f, 0.f, 0.f, 0.f};
        for (int k0 = 0; k0 < kslice; k0 += 128) {
            bf16x8 av[4], bv[4][4];
#pragma unroll
            for (int s4 = 0; s4 < 4; ++s4) { av[s4] = ld8(ap + k0 + s4 * 32);
#pragma unroll
                for (int cf = 0; cf < 4; ++cf) bv[s4][cf] = ld8(bp + (size_t)cf * 16 * pitch + k0 + s4 * 32); }
            SB();
#pragma unroll
            for (int s4 = 0; s4 < 4; ++s4)
#pragma unroll
                for (int cf = 0; cf < 4; ++cf) acc[cf] = mfma16(bv[s4][cf], av[s4], acc[cf]);
        }
#pragma unroll
        for (int cf = 0; cf < 4; ++cf) red[(wid * 4 + cf) * 64 + lane] = acc[cf];
        __syncthreads();
        if (wid < 4) {
            f32x4 v = red[(0 * 4 + wid) * 64 + lane];
#pragma unroll
            for (int w = 1; w < 8; ++w) v += red[(w * 4 + wid) * 64 + lane];
            epi(RX + rt * 16 + fr, cg * 64 + wid * 16 + fq * 4, v);
        }
        __syncthreads();
    }
}
DI void gemm_tail_gate(LAS unsigned char* lds, const bf16_t* A, const bf16_t* Bt, const bf16_t* gr, const bf16_t* ga, bf16_t* z) {
    const int tid = otid(), wid = __builtin_amdgcn_readfirstlane(tid >> 6), lane = tid & 63, fr = lane & 15, fq = lane >> 4;
    LAS f32x4* red = (LAS f32x4*)lds;
    for (int it = blockIdx.x; it < 128; it += gridDim.x) {
        const int rt = it & 7, cg = it >> 3;
        const bf16_t* ap = A + (size_t)(RX + rt * 16 + fr) * 1536 + fq * 8;
        const bf16_t* bp = Bt + (size_t)(cg * 64 + fr) * 1536 + fq * 8;
        bf16x8 av[6], bv[6][4];
#pragma unroll
        for (int s6 = 0; s6 < 6; ++s6) { const int ko = s6 < 4 ? wid * 128 + s6 * 32 : 1024 + wid * 64 + (s6 - 4) * 32; av[s6] = ld8(ap + ko);
#pragma unroll
            for (int cf = 0; cf < 4; ++cf) bv[s6][cf] = ld8(bp + (size_t)cf * 16 * 1536 + ko); }
        SB();
        f32x4 a0[4], a1[4];
#pragma unroll
        for (int cf = 0; cf < 4; ++cf) { a0[cf] = (f32x4){0.f, 0.f, 0.f, 0.f}; a1[cf] = (f32x4){0.f, 0.f, 0.f, 0.f}; }
#pragma unroll
        for (int s6 = 0; s6 < 6; ++s6)
#pragma unroll
            for (int cf = 0; cf < 4; ++cf) { if (s6 < 4) a0[cf] = mfma16(bv[s6][cf], av[s6], a0[cf]); else a1[cf] = mfma16(bv[s6][cf], av[s6], a1[cf]); }
#pragma unroll
        for (int cf = 0; cf < 4; ++cf) { red[(wid * 4 + cf) * 64 + lane] = a0[cf]; red[2048 + (wid * 4 + cf) * 64 + lane] = a1[cf]; }
        __syncthreads();
        if (wid < 4) {
            f32x4 v0 = red[(0 * 4 + wid) * 64 + lane], v1 = red[2048 + (0 * 4 + wid) * 64 + lane];
#pragma unroll
            for (int w = 1; w < 8; ++w) { v0 += red[(w * 4 + wid) * 64 + lane]; v1 += red[2048 + (w * 4 + wid) * 64 + lane]; }
            const int row = RX + rt * 16 + fr, col = cg * 64 + wid * 16 + fq * 4;
            const f32x4 sr = ld4(gr + (size_t)row * 1024 + col), sa = ld4(ga + (size_t)row * 1024 + col);
            st4(z + (size_t)row * 1024 + col, sr * v0 + sa * v1);
        }
        __syncthreads();
    }
}

struct Mix {
    const bf16_t *q_r, *k_r, *kdF, *kdB, *v_rT, *g_r, *q_a, *k_a, *v_aT;
    bf16_t* states; bf16_t* ycat; const float* rd; const float* sink; int last;
};

DI bf16x8 ldsr8(const LAS unsigned char* p) { return *(const LAS bf16x8*)p; }
DI bf16x4 ldsr4(const LAS unsigned char* p) { return *(const LAS bf16x4*)p; }
DI bf16x8 pack8i(f32x4 a, f32x4 b) { u32x4 w; w.x = pk2(a[0], b[0]); w.y = pk2(a[1], b[1]); w.z = pk2(a[2], b[2]); w.w = pk2(a[3], b[3]); return __builtin_bit_cast(bf16x8, w); }

constexpr int ATT_KP = 208, ATT_VP = 800, ATT_VOFF = 400 * ATT_KP;
struct AttPre { bf16x8 k[7]; bf16x8 v[7]; };
template <bool DOK, bool DOV> DI void attn_prefetch(AttPre& R, const Mix& M, int t, int tid) {
    asm volatile("" : "+v"(tid));
    const int b = t & 7, qb = (t >> 3) & 15, g = t >> 7, s0 = qb * 128;
    if (DOK) {
#pragma unroll
    for (int i = 0; i < 7; ++i) {
        const int c = tid + 512 * i;
        if (c < 3200) {
            const int lk = c >> 3, c16 = c & 7;
            int row;
            if (lk < 384) { int sk = s0 - 128 + lk; sk = sk < 0 ? 0 : (sk > 2047 ? 2047 : sk); row = b * 2048 + sk; } else row = RX + b * 16 + (lk - 384);
            R.k[i] = ld8(M.k_a + (size_t)row * 128 + g * 64 + c16 * 8);
        }
    }
    }
    if (DOV) {
#pragma unroll
    for (int i = 0; i < 7; ++i) {
        const int c = tid + 512 * i;
        if (c < 3200) {
            const int e = c / 50, c16 = c - e * 50;
            int pp = (c16 < 48) ? (s0 + c16 * 8) : (112 + (c16 - 48) * 8);
            pp = pp > LP - 8 ? LP - 8 : pp;
            R.v[i] = ld8(M.v_aT + ((size_t)(b * 2 + g) * 64 + e) * LP + pp);
        }
    }
    }
}
DI void attn_commit(const AttPre& R, LAS unsigned char* lds, int tid) {
    asm volatile("" : "+v"(tid));
#pragma unroll
    for (int i = 0; i < 7; ++i) { const int c = tid + 512 * i; if (c < 3200) *(LAS bf16x8*)(lds + (c >> 3) * ATT_KP + (c & 7) * 16) = R.k[i]; }
#pragma unroll
    for (int i = 0; i < 7; ++i) { const int c = tid + 512 * i; if (c < 3200) { const int e = c / 50, c16 = c - e * 50; *(LAS bf16x8*)(lds + ATT_VOFF + e * ATT_VP + c16 * 16) = R.v[i]; } }
}
template <class Hook> DI void attn_wave(const Mix& M, const LAS unsigned char* lds, int b, int hq, int s0, int w, bf16x8 q0, bf16x8 q1, int lane, const Hook& hook) {
    asm volatile("" : "+v"(lane));
    const int fr = lane & 15, fq = lane >> 4;
    const int s = s0 + 16 * w + fr;
    const int rowq = (w >= 0) ? (b * 2048 + s) : (RX + b * 16 + fr);
    const int blk_lo = (w >= 0) ? (w >> 1) : 0;
    const LAS unsigned char* kb = lds + (32 * blk_lo + (fr >> 2) * 8 + 2 * (fr & 3)) * ATT_KP + fq * 16;
    f32x4 sa[9], sb[9], sm;
#pragma unroll
    for (int i0 = 0; i0 < 9; i0 += 3) {
        bf16x8 ka[3][2], kc[3][2];
#pragma unroll
        for (int u = 0; u < 3; ++u) {
            const int i = i0 + u;
            ka[u][0] = ldsr8(kb + i * 32 * ATT_KP); ka[u][1] = ldsr8(kb + i * 32 * ATT_KP + 64);
            kc[u][0] = ldsr8(kb + i * 32 * ATT_KP + ATT_KP); kc[u][1] = ldsr8(kb + i * 32 * ATT_KP + ATT_KP + 64);
        }
        SB();
#pragma unroll
        for (int u = 0; u < 3; ++u) {
            f32x4 a = {0.f, 0.f, 0.f, 0.f}, c = {0.f, 0.f, 0.f, 0.f};
            a = mfma16(ka[u][0], q0, a); a = mfma16(ka[u][1], q1, a);
            c = mfma16(kc[u][0], q0, c); c = mfma16(kc[u][1], q1, c);
            sa[i0 + u] = a; sb[i0 + u] = c;
        }
        SB();
    }
    {
        const LAS unsigned char* km = lds + (384 + fr) * ATT_KP + fq * 16;
        const bf16x8 k0 = ldsr8(km), k1 = ldsr8(km + 64);
        f32x4 a = {0.f, 0.f, 0.f, 0.f};
        a = mfma16(k0, q0, a); a = mfma16(k1, q1, a); sm = a;
    }
    const float sink = M.sink[hq];
    float mx = sink;
#pragma unroll
    for (int i = 0; i < 9; ++i)
#pragma unroll
        for (int jj = 0; jj < 4; ++jj) {
            const int ska = s0 - 128 + 32 * (blk_lo + i) + fq * 8 + 2 * jj; const int da = s - ska;
            const bool oka = (ska >= 0) && (ska < 2048) && (da <= 128) && (da >= -128);
            const bool okb = (ska + 1 >= 0) && (ska + 1 < 2048) && (da - 1 <= 128) && (da - 1 >= -128);
            const float va = oka ? sa[i][jj] : -1e30f, vb = okb ? sb[i][jj] : -1e30f;
            sa[i][jj] = va; sb[i][jj] = vb; mx = fmaxf(mx, fmaxf(va, vb));
        }
#pragma unroll
    for (int jj = 0; jj < 4; ++jj) mx = fmaxf(mx, sm[jj]);
    mx = fmaxf(mx, __shfl_xor(mx, 16)); mx = fmaxf(mx, __shfl_xor(mx, 32));
    float sum = 0.f;
    bf16x8 py[9], pym;
#pragma unroll
    for (int i = 0; i < 9; ++i) {
#pragma unroll
        for (int jj = 0; jj < 4; ++jj) { const float p0 = __expf(sa[i][jj] - mx), p1 = __expf(sb[i][jj] - mx); sa[i][jj] = p0; sb[i][jj] = p1; sum += p0 + p1; }
        py[i] = pack8i(sa[i], sb[i]);
    }
    {
#pragma unroll
        for (int jj = 0; jj < 4; ++jj) { const float p0 = __expf(sm[jj] - mx); sm[jj] = p0; sum += p0; }
        pym = pack8(sm, (f32x4){0.f, 0.f, 0.f, 0.f});
    }
    sum += __shfl_xor(sum, 16); sum += __shfl_xor(sum, 32);
    sum += __expf(sink - mx);
    SB(); hook(); SB();
    f32x4 o[4];
#pragma unroll
    for (int ef = 0; ef < 4; ++ef) o[ef] = (f32x4){0.f, 0.f, 0.f, 0.f};
    const LAS unsigned char* vb = lds + ATT_VOFF + fr * ATT_VP + (32 * blk_lo + fq * 8) * 2;
#pragma unroll
    for (int i0 = 0; i0 < 9; i0 += 3) {
        bf16x8 vx[3][4];
#pragma unroll
        for (int u = 0; u < 3; ++u)
#pragma unroll
            for (int ef = 0; ef < 4; ++ef) vx[u][ef] = ldsr8(vb + ef * 16 * ATT_VP + (i0 + u) * 64);
        SB();
#pragma unroll
        for (int u = 0; u < 3; ++u)
#pragma unroll
            for (int ef = 0; ef < 4; ++ef) o[ef] = mfma16(vx[u][ef], py[i0 + u], o[ef]);
        SB();
    }
    {
        const LAS unsigned char* vm = lds + ATT_VOFF + fr * ATT_VP + (384 + fq * 4) * 2;
        const bf16x4 z4 = {0, 0, 0, 0};
#pragma unroll
        for (int ef = 0; ef < 4; ++ef) o[ef] = mfma16(cat8(ldsr4(vm + ef * 16 * ATT_VP), z4), pym, o[ef]);
    }
    const float inv = 1.0f / sum;
#pragma unroll
    for (int ef = 0; ef < 4; ef += 2) st_pair16(M.ycat + (size_t)rowq * 1536 + 1024 + hq * 64 + ef * 16, o[ef] * inv, o[ef + 1] * inv, fq);
}
DI void attn_phase(const Mix& M, LAS unsigned char* lds, int first, int step, int count) {
    const int tid = otid(), wid = __builtin_amdgcn_readfirstlane(tid >> 6), lane = tid & 63, fr = lane & 15, fq = lane >> 4;
    AttPre R;
    if (count > 0) attn_prefetch<true, true>(R, M, first, tid);
    for (int k = 0; k < count; ++k) {
        const int t = first + k * step;
        const int b = t & 7, qb = (t >> 3) & 15, g = t >> 7;
        const int rowq = b * 2048 + qb * 128 + 16 * wid + fr;
        bf16x8 q[4][2];
#pragma unroll
        for (int hh = 0; hh < 4; ++hh) { q[hh][0] = ld8(M.q_a + (size_t)rowq * 512 + (g * 4 + hh) * 64 + fq * 8); q[hh][1] = ld8(M.q_a + (size_t)rowq * 512 + (g * 4 + hh) * 64 + 32 + fq * 8); }
        __syncthreads();
        attn_commit(R, lds, tid);
        __syncthreads();
        const bool more = (k + 1 < count);
        if (more) attn_prefetch<true, true>(R, M, t + step, tid);
#pragma unroll
        for (int hh = 0; hh < 4; ++hh) attn_wave(M, lds, b, g * 4 + hh, qb * 128, wid, q[hh][0], q[hh][1], lane, [] {});
        if (qb == 0 && wid < 4) {
            const int rowm = RX + b * 16 + fr; const int hq = g * 4 + wid;
            const bf16x8 m0 = ld8(M.q_a + (size_t)rowm * 512 + hq * 64 + fq * 8), m1 = ld8(M.q_a + (size_t)rowm * 512 + hq * 64 + 32 + fq * 8);
            attn_wave(M, lds, b, hq, 0, -1, m0, m1, lane, [] {});
        }
    }
    __syncthreads();
}

constexpr int SC_P = 288, SC_KB = 64 * SC_P, SC_BUF = SC_KB + 64 * SC_P;
static_assert(2 * SC_BUF <= LDS_MAIN, "lds");
struct ScanPre { bf16x8 k[2]; bf16x8 v[2]; };
DI void scan_prefetch(ScanPre& R, const bf16_t* kd, const bf16_t* vt, int n, int tid) {
    asm volatile("" : "+v"(tid));
#pragma unroll
    for (int i = 0; i < 2; ++i) { const int c = tid + 512 * i; R.k[i] = ld8(kd + (size_t)(c >> 4) * LP + 128 * n + (c & 15) * 8); R.v[i] = ld8(vt + (size_t)(c >> 4) * LP + 128 * n + (c & 15) * 8); }
}
DI void scan_commit(const ScanPre& R, LAS unsigned char* buf, int tid) {
    asm volatile("" : "+v"(tid));
#pragma unroll
    for (int i = 0; i < 2; ++i) { const int c = tid + 512 * i; *(LAS bf16x8*)(buf + (c >> 4) * SC_P + (c & 15) * 16) = R.k[i]; *(LAS bf16x8*)(buf + SC_KB + (c >> 4) * SC_P + (c & 15) * 16) = R.v[i]; }
}
DI void scan_block(const Mix& M, LAS unsigned char* lds, int item) {
    const int tid = otid(), wid = __builtin_amdgcn_readfirstlane(tid >> 6), lane = tid & 63, fr = lane & 15, fq = lane >> 4;
    const int xq = item & 7, yq = item >> 3;
    const int eh = yq & 1, dir = (yq >> 1) & 1, bh = (yq >> 2) * 8 + xq, h = bh & 7;
    const int efl = wid & 3, dh = wid >> 2;
    const bf16_t* kd = (dir ? M.kdB : M.kdF) + (size_t)bh * 64 * LP;
    const bf16_t* vt = M.v_rT + ((size_t)bh * 128 + eh * 64) * LP;
    const float lg = -__expf(M.rd[dir * 8 + h]); const float gC = __expf(lg * 128.0f);
    bf16_t* sbase = M.states + (((size_t)bh * NCH) * 2 + dir) * 128 * 64 + (size_t)(eh * 64 + efl * 16 + fr) * 64 + dh * 32 + fq * 4;
    f32x4 acc[2];
#pragma unroll
    for (int df = 0; df < 2; ++df) acc[df] = (f32x4){0.f, 0.f, 0.f, 0.f};
    ScanPre ring[4];
#pragma unroll
    for (int s0 = 0; s0 < 4; ++s0) scan_prefetch(ring[s0], kd, vt, dir ? (16 - s0) : s0, tid);
    __syncthreads();
#pragma unroll
    for (int s = 0; s < 16; ++s) {
        LAS unsigned char* buf = lds + (s & 1) * SC_BUF;
        scan_commit(ring[s & 3], buf, tid);
        if (s + 4 < 16) scan_prefetch(ring[s & 3], kd, vt, dir ? (16 - (s + 4)) : (s + 4), tid);
        __syncthreads();
        const int n = dir ? (16 - s) : s;
        bf16_t* sp = sbase + (size_t)n * 2 * 128 * 64;
        st_pair16(sp - fq * 4, acc[0], acc[1], fq);
#pragma unroll
        for (int df = 0; df < 2; ++df) acc[df] *= gC;
        const LAS unsigned char* kp = buf + (dh * 32 + fr) * SC_P + fq * 16;
        const LAS unsigned char* vp = buf + SC_KB + (efl * 16 + fr) * SC_P + fq * 16;
        bf16x8 vy[4], kx[4][2];
#pragma unroll
        for (int ks = 0; ks < 4; ++ks) { vy[ks] = ldsr8(vp + ks * 64);
#pragma unroll
            for (int df = 0; df < 2; ++df) kx[ks][df] = ldsr8(kp + df * 16 * SC_P + ks * 64); }
        SB();
#pragma unroll
        for (int ks = 0; ks < 4; ++ks)
#pragma unroll
            for (int df = 0; df < 2; ++df) acc[df] = mfma16(kx[ks][df], vy[ks], acc[df]);
        SB();
    }
    {
        bf16_t* sp = sbase + (size_t)(dir ? 0 : 16) * 2 * 128 * 64;
        st_pair16(sp - fq * 4, acc[0], acc[1], fq);
    }
    __syncthreads();
}

DI void ret_item(const Mix& M, int b, int h, int n, int iq) {
    const int lane = otid() & 63, fr = lane & 15, fq = lane >> 4;
    const int i = 16 * iq + fr;
    const int rowq = n ? (b * 2048 + (n - 1) * 128 + i) : (RX + b * 16 + (i - 112));
    bf16x8 qy[2];
#pragma unroll
    for (int ks = 0; ks < 2; ++ks) qy[ks] = ld8(M.q_r + (size_t)rowq * 512 + h * 64 + ks * 32 + fq * 8);
    const float lgf = -__expf(M.rd[h]), lgb = -__expf(M.rd[8 + h]);
    const float cf = __expf(lgf * (float)(i + 1)), cb = __expf(lgb * (float)(128 - i));
    const bf16_t* SF = M.states + (((size_t)(b * 8 + h) * NCH + n) * 2 + 0) * 128 * 64 + (size_t)fr * 64 + fq * 8;
    const bf16_t* SBk = SF + 128 * 64;
    const bf16_t* vbase = M.v_rT + ((size_t)(b * 8 + h) * 128 + fr) * LP + 128 * n + fq * 4;
    bf16x8 sfx[8][2], kx[8][2];
#pragma unroll
    for (int ef = 0; ef < 8; ++ef)
#pragma unroll
        for (int ks = 0; ks < 2; ++ks) sfx[ef][ks] = ld8(SF + (size_t)ef * 16 * 64 + ks * 32);
#pragma unroll
    for (int jf = 0; jf < 8; ++jf) {
        const int j = 16 * jf + fr;
        int jm = j - 112; jm = jm < 0 ? 0 : jm;
        const int rowk = n ? (b * 2048 + (n - 1) * 128 + j) : (RX + b * 16 + jm);
        const bf16_t* kp = M.k_r + (size_t)rowk * 512 + h * 64 + fq * 8;
        kx[jf][0] = ld8(kp); kx[jf][1] = ld8(kp + 32);
    }
    SB();
    f32x4 o[8];
#pragma unroll
    for (int ef = 0; ef < 8; ++ef) {
        f32x4 t = {0.f, 0.f, 0.f, 0.f};
        t = mfma16(sfx[ef][0], qy[0], t); t = mfma16(sfx[ef][1], qy[1], t);
        o[ef] = t * cf;
    }
    f32x4 st[8];
#pragma unroll
    for (int jf = 0; jf < 8; ++jf) {
        f32x4 t = {0.f, 0.f, 0.f, 0.f};
        t = mfma16(kx[jf][0], qy[0], t); t = mfma16(kx[jf][1], qy[1], t);
        st[jf] = t;
    }
    SB();
    bf16x8 sbx[8][2];
#pragma unroll
    for (int ef = 0; ef < 8; ++ef)
#pragma unroll
        for (int ks = 0; ks < 2; ++ks) sbx[ef][ks] = ld8(SBk + (size_t)ef * 16 * 64 + ks * 32);
    bf16x4 va[2][8][2];
#pragma unroll
    for (int pr = 0; pr < 2; ++pr)
#pragma unroll
        for (int ef = 0; ef < 8; ++ef) { va[pr][ef][0] = ld4s(vbase + (size_t)ef * 16 * LP + 32 * pr); va[pr][ef][1] = ld4s(vbase + (size_t)ef * 16 * LP + 32 * pr + 16); }
    SB();
#pragma unroll
    for (int ef = 0; ef < 8; ++ef) {
        f32x4 t = {0.f, 0.f, 0.f, 0.f};
        t = mfma16(sbx[ef][0], qy[0], t); t = mfma16(sbx[ef][1], qy[1], t);
        o[ef] += t * cb;
    }
    bf16x8 py[4];
#pragma unroll
    for (int pr = 0; pr < 4; ++pr) {
#pragma unroll
        for (int hh = 0; hh < 2; ++hh) {
            const int jf = 2 * pr + hh;
#pragma unroll
            for (int jj = 0; jj < 4; ++jj) {
                const int jv = 16 * jf + fq * 4 + jj; const int d = i - jv;
                float w = (d >= 0) ? __expf(lgf * (float)d) : __expf(lgb * (float)(-d));
                if (n == 0 && jv < 112) w = 0.f;
                st[jf][jj] *= w;
            }
        }
        py[pr] = pack8(st[2 * pr], st[2 * pr + 1]);
    }
    SB();
    bf16x4 vb[2][8][2];
#pragma unroll
    for (int pr = 0; pr < 2; ++pr)
#pragma unroll
        for (int ef = 0; ef < 8; ++ef) { vb[pr][ef][0] = ld4s(vbase + (size_t)ef * 16 * LP + 32 * (pr + 2)); vb[pr][ef][1] = ld4s(vbase + (size_t)ef * 16 * LP + 32 * (pr + 2) + 16); }
    u32x2 gx[8];
#pragma unroll
    for (int ef = 0; ef < 8; ++ef) gx[ef] = *(const u32x2*)(M.g_r + (size_t)rowq * 1024 + h * 128 + ef * 16 + fq * 4);
    SB();
#pragma unroll
    for (int pr = 0; pr < 2; ++pr)
#pragma unroll
        for (int ef = 0; ef < 8; ++ef) o[ef] = mfma16(cat8(va[pr][ef][0], va[pr][ef][1]), py[pr], o[ef]);
#pragma unroll
    for (int pr = 0; pr < 2; ++pr)
#pragma unroll
        for (int ef = 0; ef < 8; ++ef) o[ef] = mfma16(cat8(vb[pr][ef][0], vb[pr][ef][1]), py[pr + 2], o[ef]);
    float s = 0.f;
#pragma unroll
    for (int ef = 0; ef < 8; ++ef) s += (o[ef][0] + o[ef][1]) + (o[ef][2] + o[ef][3]);
    s += __shfl_xor(s, 16); s += __shfl_xor(s, 32);
    const float mean = s * (1.0f / 128.0f);
    float q = 0.f;
#pragma unroll
    for (int ef = 0; ef < 8; ++ef) { const f32x4 d = o[ef] - mean; q += (d[0] * d[0] + d[1] * d[1]) + (d[2] * d[2] + d[3] * d[3]); }
    q += __shfl_xor(q, 16); q += __shfl_xor(q, 32);
    const float rstd = rsqrtf(q * (1.0f / 128.0f) + EPS);
#pragma unroll
    for (int ef = 0; ef < 8; ++ef) {
        f32x4 gv; gv[0] = __uint_as_float(gx[ef].x << 16); gv[1] = __uint_as_float(gx[ef].x & 0xffff0000u); gv[2] = __uint_as_float(gx[ef].y << 16); gv[3] = __uint_as_float(gx[ef].y & 0xffff0000u);
        st4(M.ycat + (size_t)rowq * 1536 + h * 128 + ef * 16 + fq * 4, (o[ef] - mean) * rstd * gv);
    }
}

constexpr int RET_KP = 208, RET_SP = 160, RET_VP = 288;
constexpr int RET_SFOFF = 128 * RET_KP, RET_SBOFF = RET_SFOFF + 128 * RET_SP, RET_VOFF = RET_SBOFF + 128 * RET_SP;
static_assert(RET_VOFF + 128 * RET_VP <= LDS_MAIN, "lds");
struct RetPre { bf16x8 k[2], sf[2], sb[2], v[4], q[2]; };
DI void ret_decode(int t, int& bh, int& n) { if (t < 1024) { n = (t & 15) + 1; bh = t >> 4; } else { n = 0; bh = t - 1024; } }
DI void ret_prefetch(RetPre& R, const Mix& M, int t, int tid) {
    asm volatile("" : "+v"(tid));
    int bh, n; ret_decode(t, bh, n);
    const int b = bh >> 3, h = bh & 7;
    const int wid = tid >> 6, lane = tid & 63, fr = lane & 15, fq = lane >> 4;
    const bf16_t* SF = M.states + (((size_t)bh * NCH + n) * 2 + 0) * 128 * 64;
#pragma unroll
    for (int i = 0; i < 2; ++i) {
        const int c = tid + 512 * i; const int j = c >> 3;
        int jm = j - 112; jm = jm < 0 ? 0 : jm;
        const int rowk = n ? (b * 2048 + (n - 1) * 128 + j) : (RX + b * 16 + jm);
        R.k[i] = ld8(M.k_r + (size_t)rowk * 512 + h * 64 + (c & 7) * 8);
        R.sf[i] = ld8(SF + (size_t)c * 8); R.sb[i] = ld8(SF + 128 * 64 + (size_t)c * 8);
    }
#pragma unroll
    for (int i = 0; i < 4; ++i) { const int c = tid + 512 * i; R.v[i] = ld8(M.v_rT + ((size_t)bh * 128 + (c >> 4)) * LP + 128 * n + (c & 15) * 8); }
    const int rowq = n ? (b * 2048 + (n - 1) * 128 + 16 * wid + fr) : (RX + b * 16 + fr);
    R.q[0] = ld8(M.q_r + (size_t)rowq * 512 + h * 64 + fq * 8); R.q[1] = ld8(M.q_r + (size_t)rowq * 512 + h * 64 + 32 + fq * 8);
}
DI void ret_commit(const RetPre& R, LAS unsigned char* lds, int tid) {
    asm volatile("" : "+v"(tid));
#pragma unroll
    for (int i = 0; i < 2; ++i) {
        const int c = tid + 512 * i;
        *(LAS bf16x8*)(lds + (c >> 3) * RET_KP + (c & 7) * 16) = R.k[i];
        *(LAS bf16x8*)(lds + RET_SFOFF + (c >> 3) * RET_SP + (c & 7) * 16) = R.sf[i];
        *(LAS bf16x8*)(lds + RET_SBOFF + (c >> 3) * RET_SP + (c & 7) * 16) = R.sb[i];
    }
#pragma unroll
    for (int i = 0; i < 4; ++i) { const int c = tid + 512 * i; *(LAS bf16x8*)(lds + RET_VOFF + (c >> 4) * RET_VP + (c & 15) * 16) = R.v[i]; }
}
DI void ret_wave(const Mix& M, const LAS unsigned char* lds, int b, int h, int n, int w, bf16x8 q0, bf16x8 q1, int lane) {
    asm volatile("" : "+v"(lane));
    const int fr = lane & 15, fq = lane >> 4;
    if (n == 0 && w != 7) return;
    const int i = 16 * w + fr;
    const int rowq = n ? (b * 2048 + (n - 1) * 128 + i) : (RX + b * 16 + fr);
    u32x2 gx[8];
#pragma unroll
    for (int ef = 0; ef < 8; ++ef) gx[ef] = *(const u32x2*)(M.g_r + (size_t)rowq * 1024 + h * 128 + ef * 16 + fq * 4);
    const float lgf = -__expf(M.rd[h]), lgb = -__expf(M.rd[8 + h]);
    const float cf = __expf(lgf * (float)(i + 1)), cb = __expf(lgb * (float)(128 - i));
    f32x4 o[8];
    const LAS unsigned char* sfp = lds + RET_SFOFF + fr * RET_SP + fq * 16;
    const LAS unsigned char* sbp = lds + RET_SBOFF + fr * RET_SP + fq * 16;
#pragma unroll
    for (int e0 = 0; e0 < 8; e0 += 4) {
        bf16x8 xf[4][2], xb[4][2];
#pragma unroll
        for (int u = 0; u < 4; ++u) { const int ef = e0 + u;
            xf[u][0] = ldsr8(sfp + ef * 16 * RET_SP); xf[u][1] = ldsr8(sfp + ef * 16 * RET_SP + 64);
            xb[u][0] = ldsr8(sbp + ef * 16 * RET_SP); xb[u][1] = ldsr8(sbp + ef * 16 * RET_SP + 64); }
        SB();
#pragma unroll
        for (int u = 0; u < 4; ++u) {
            f32x4 t = {0.f, 0.f, 0.f, 0.f}, t2 = {0.f, 0.f, 0.f, 0.f};
            t = mfma16(xf[u][0], q0, t); t = mfma16(xf[u][1], q1, t);
            t2 = mfma16(xb[u][0], q0, t2); t2 = mfma16(xb[u][1], q1, t2);
            o[e0 + u] = t * cf + t2 * cb;
        }
        SB();
    }
    const LAS unsigned char* kb = lds + ((fr >> 2) * 8 + 2 * (fr & 3)) * RET_KP + fq * 16;
    bf16x8 py[4];
    bf16x8 kxa[4][2], kxc[4][2];
#pragma unroll
    for (int blk = 0; blk < 4; ++blk) {
        kxa[blk][0] = ldsr8(kb + blk * 32 * RET_KP); kxa[blk][1] = ldsr8(kb + blk * 32 * RET_KP + 64);
        kxc[blk][0] = ldsr8(kb + blk * 32 * RET_KP + RET_KP); kxc[blk][1] = ldsr8(kb + blk * 32 * RET_KP + RET_KP + 64);
    }
    SB();
#pragma unroll
    for (int blk = 0; blk < 4; ++blk) {
        f32x4 a = {0.f, 0.f, 0.f, 0.f}, c = {0.f, 0.f, 0.f, 0.f};
        a = mfma16(kxa[blk][0], q0, a); a = mfma16(kxa[blk][1], q1, a);
        c = mfma16(kxc[blk][0], q0, c); c = mfma16(kxc[blk][1], q1, c);
#pragma unroll
        for (int jj = 0; jj < 4; ++jj) {
            const int ja = 32 * blk + fq * 8 + 2 * jj; const int da = i - ja, db = da - 1;
            float wa = (da >= 0) ? __expf(lgf * (float)da) : __expf(lgb * (float)(-da));
            float wb = (db >= 0) ? __expf(lgf * (float)db) : __expf(lgb * (float)(-db));
            if (n == 0) { if (ja < 112) wa = 0.f; if (ja + 1 < 112) wb = 0.f; }
            a[jj] *= wa; c[jj] *= wb;
        }
        py[blk] = pack8i(a, c);
    }
    const LAS unsigned char* vp = lds + RET_VOFF + fr * RET_VP + fq * 16;
    SB();
#pragma unroll
    for (int blk = 0; blk < 4; blk += 2) {
        bf16x8 vx[2][8];
#pragma unroll
        for (int u = 0; u < 2; ++u)
#pragma unroll
            for (int ef = 0; ef < 8; ++ef) vx[u][ef] = ldsr8(vp + ef * 16 * RET_VP + (blk + u) * 64);
        SB();
#pragma unroll
        for (int u = 0; u < 2; ++u)
#pragma unroll
            for (int ef = 0; ef < 8; ++ef) o[ef] = mfma16(vx[u][ef], py[blk + u], o[ef]);
        SB();
    }
    float s = 0.f;
#pragma unroll
    for (int ef = 0; ef < 8; ++ef) s += (o[ef][0] + o[ef][1]) + (o[ef][2] + o[ef][3]);
    s += __shfl_xor(s, 16); s += __shfl_xor(s, 32);
    const float mean = s * (1.0f / 128.0f);
    float q = 0.f;
#pragma unroll
    for (int ef = 0; ef < 8; ++ef) { const f32x4 d = o[ef] - mean; q += (d[0] * d[0] + d[1] * d[1]) + (d[2] * d[2] + d[3] * d[3]); }
    q += __shfl_xor(q, 16); q += __shfl_xor(q, 32);
    const float rstd = rsqrtf(q * (1.0f / 128.0f) + EPS);
#pragma unroll
    for (int ef = 0; ef < 8; ef += 2) {
        f32x4 gv, gw;
        gv[0] = __uint_as_float(gx[ef].x << 16); gv[1] = __uint_as_float(gx[ef].x & 0xffff0000u); gv[2] = __uint_as_float(gx[ef].y << 16); gv[3] = __uint_as_float(gx[ef].y & 0xffff0000u);
        gw[0] = __uint_as_float(gx[ef + 1].x << 16); gw[1] = __uint_as_float(gx[ef + 1].x & 0xffff0000u); gw[2] = __uint_as_float(gx[ef + 1].y << 16); gw[3] = __uint_as_float(gx[ef + 1].y & 0xffff0000u);
        st_pair16(M.ycat + (size_t)rowq * 1536 + h * 128 + ef * 16, (o[ef] - mean) * rstd * gv, (o[ef + 1] - mean) * rstd * gw, fq);
    }
}
DI void ret_phase(const Mix& M, LAS unsigned char* lds) {
    const int tid = otid(), wid = __builtin_amdgcn_readfirstlane(tid >> 6), lane = tid & 63;
    const int G = gridDim.x;
    const int NIT = M.last ? 1024 : 1088;
    int t = blockIdx.x;
    RetPre R;
    if (t < NIT) ret_prefetch(R, M, t, tid);
    for (; t < NIT; t += G) {
        __syncthreads();
        ret_commit(R, lds, tid);
        const bf16x8 q0 = R.q[0], q1 = R.q[1];
        __syncthreads();
        if (t + G < NIT) ret_prefetch(R, M, t + G, tid);
        int bh, n; ret_decode(t, bh, n);
        ret_wave(M, lds, bh >> 3, bh & 7, n, wid, q0, q1, lane);
    }
    __syncthreads();
}

DI bf16_t* hrow(const Params& P, int row) { return (bf16_t*)(P.ws + WS_ST) + (size_t)row * 1024; }
template <int NB>
DI void rowpass_rows(const Params& P, const bf16_t* t, const float* gpost, const float* gpre, float* rs, int row0, int rstride, int lane) {
    f32x4 hv[NB][4]; u32x2 tr[NB][4], hr[NB][4];
#pragma unroll
    for (int r = 0; r < NB; ++r) {
        const int row = row0 + r * rstride;
        const bf16_t* hp = hrow(P, row); const bf16_t* tp = t + (size_t)row * 1024;
#pragma unroll
        for (int k = 0; k < 4; ++k) { tr[r][k] = *(const u32x2*)(tp + (k * 64 + lane) * 4); hr[r][k] = *(const u32x2*)(hp + (k * 64 + lane) * 4); }
    }
    f32x4 gp[4];
#pragma unroll
    for (int k = 0; k < 4; ++k) gp[k] = *(const f32x4*)(gpost + (k * 64 + lane) * 4);
    SB();
    float s2[NB];
#pragma unroll
    for (int r = 0; r < NB; ++r) {
        f32x4 tv[4]; float ss = 0.f;
#pragma unroll
        for (int k = 0; k < 4; ++k) {
            tv[k][0] = __uint_as_float(tr[r][k].x << 16); tv[k][1] = __uint_as_float(tr[r][k].x & 0xffff0000u); tv[k][2] = __uint_as_float(tr[r][k].y << 16); tv[k][3] = __uint_as_float(tr[r][k].y & 0xffff0000u);
            hv[r][k][0] = __uint_as_float(hr[r][k].x << 16); hv[r][k][1] = __uint_as_float(hr[r][k].x & 0xffff0000u); hv[r][k][2] = __uint_as_float(hr[r][k].y << 16); hv[r][k][3] = __uint_as_float(hr[r][k].y & 0xffff0000u);
            ss += (tv[k][0] * tv[k][0] + tv[k][1] * tv[k][1]) + (tv[k][2] * tv[k][2] + tv[k][3] * tv[k][3]);
        }
        ss = wsum(ss);
        const float sc = rsqrtf(ss * (1.0f / 1024.0f) + EPS);
        const int row = row0 + r * rstride;
        bf16_t* hp = hrow(P, row);
        float q = 0.f;
#pragma unroll
        for (int k = 0; k < 4; ++k) { hv[r][k] += tv[k] * sc * gp[k];
            if (gpre) st4(hp + (k * 64 + lane) * 4, hv[r][k]); else if (row < RX) *(f32x4*)(P.out + (size_t)row * 1024 + (k * 64 + lane) * 4) = hv[r][k];
            q += (hv[r][k][0] * hv[r][k][0] + hv[r][k][1] * hv[r][k][1]) + (hv[r][k][2] * hv[r][k][2] + hv[r][k][3] * hv[r][k][3]); }
        s2[r] = q;
    }
    if (gpre) {
#pragma unroll
        for (int r = 0; r < NB; ++r) {
            const float sc2 = rsqrtf(wsum(s2[r]) * (1.0f / 1024.0f) + EPS);
            if (lane == 0) rs[row0 + r * rstride] = sc2;
        }
    }
}
DI void rowpass(const Params& P, const bf16_t* t, const float* gpost, const float* gpre, float* u, int gw, int nw) {
    const int lane = otid() & 63;
    for (int base = gw; base < RX; base += nw * 4) {
        if (base + 3 * nw < RX) rowpass_rows<4>(P, t, gpost, gpre, u, base, nw, lane);
        else for (int row = base; row < RX; row += nw) rowpass_rows<1>(P, t, gpost, gpre, u, row, 0, lane);
    }
    for (int row = RX + gw; row < RT; row += nw) rowpass_rows<1>(P, t, gpost, gpre, u, row, 0, lane);
}
DI void rowinit(const Params& P, float* rs, int gw, int nw) {
    const int lane = otid() & 63;
    for (int row = gw; row < RT; row += nw) {
        bf16_t* hp = hrow(P, row);
        const float* src = row < RX ? P.x + (size_t)row * 1024 : P.meta + (size_t)((row - RX) & 15) * 1024;
        f32x4 hv[4]; float s2 = 0.f;
#pragma unroll
        for (int k = 0; k < 4; ++k) hv[k] = *(const f32x4*)(src + (k * 64 + lane) * 4);
        SB();
#pragma unroll
        for (int k = 0; k < 4; ++k) { st4(hp + (k * 64 + lane) * 4, hv[k]);
            s2 += (hv[k][0] * hv[k][0] + hv[k][1] * hv[k][1]) + (hv[k][2] * hv[k][2] + hv[k][3] * hv[k][3]); }
        s2 = wsum(s2);
        if (lane == 0) rs[row] = rsqrtf(s2 * (1.0f / 1024.0f) + EPS);
    }
}

DI int perm64(int mode, int w) { return mode == 1 ? ((w >> 1) + 32 * (w & 1)) : (mode == 2 ? (w < 16 ? ((w >> 1) + 8 * (w & 1)) : w) : w); }
struct ConvJob { const float* W; bf16_t* Bt; const float* gain; int ncols, k0, n0, ldb, koff, mode; };
DI ConvJob conv_decode(const Params& P, int l, int job) {
    unsigned char* wb = P.ws + WS_W;
    ConvJob J; int j = job; J.gain = nullptr;
    if (j < 1472) { J.gain = P.n_mix_pre + l * 1024; const int nt = j % 92, kt = j / 92; const int c0 = nt * 64;
        J.W = P.w_in + (size_t)l * 1024 * DIN; J.ncols = DIN; J.k0 = kt * 64; J.n0 = c0; J.Bt = (bf16_t*)(wb + W_IN); J.ldb = 1024; J.koff = 0;
        J.mode = c0 < 1024 ? 1 : ((c0 >= 3072 && c0 < 3712) ? 2 : 0); return J; }
    j -= 1472; J.mode = 0; J.koff = 0; J.ncols = 1024;
    if (j < 256) { J.W = P.w_ret_o + (size_t)l * 1024 * 1024; J.k0 = (j >> 4) * 64; J.n0 = (j & 15) * 64; J.Bt = (bf16_t*)(wb + W_CAT); J.ldb = 1536; return J; }
    j -= 256;
    if (j < 128) { J.W = P.w_att_o + (size_t)l * 512 * 1024; J.k0 = (j >> 4) * 64; J.n0 = (j & 15) * 64; J.Bt = (bf16_t*)(wb + W_CAT); J.ldb = 1536; J.koff = 1024; return J; }
    j -= 128;
    if (j < 256) { J.W = P.w_mix_o + (size_t)l * 1024 * 1024; J.k0 = (j >> 4) * 64; J.n0 = (j & 15) * 64; J.Bt = (bf16_t*)(wb + W_MIX); J.ldb = 1024; return J; }
    j -= 256;
    if (j < 1024) { J.gain = P.n_ff_pre + l * 1024; J.W = P.w_ff1 + (size_t)l * 1024 * 4096; J.ncols = 4096; J.k0 = (j >> 6) * 64; J.n0 = (j & 63) * 64; J.Bt = (bf16_t*)(wb + W_FF1); J.ldb = 1024; return J; }
    j -= 1024;
    J.W = P.w_ff2 + (size_t)l * 4096 * 1024; J.k0 = (j >> 4) * 64; J.n0 = (j & 15) * 64; J.Bt = (bf16_t*)(wb + W_FF2); J.ldb = 4096; return J;
}
DI void convert_weights(const Params& P, int l, LAS unsigned char* lds) {
    LAS float* tiles = (LAS float*)lds;
    const int t = otid();
    const int G = gridDim.x;
    for (int base = blockIdx.x; base < 4160; base += 4 * G) {
        ConvJob J[4]; f32x4 v[4][2];
#pragma unroll
        for (int q = 0; q < 4; ++q) {
            const int job = base + q * G;
            if (job < 4160) {
                J[q] = conv_decode(P, l, job);
#pragma unroll
                for (int rep = 0; rep < 2; ++rep) { const int kk = (t >> 4) + 32 * rep, nn = (t & 15) * 4; v[q][rep] = *(const f32x4*)(J[q].W + (size_t)(J[q].k0 + kk) * J[q].ncols + J[q].n0 + nn);
                    if (J[q].gain) v[q][rep] *= J[q].gain[J[q].k0 + kk]; }
            }
        }
        SB();
#pragma unroll
        for (int q = 0; q < 4; ++q) {
            if (base + q * G < 4160) {
                LAS float* tile = tiles + q * 4160;
#pragma unroll
                for (int rep = 0; rep < 2; ++rep) { const int kk = (t >> 4) + 32 * rep, nn = (t & 15) * 4;
                    tile[kk * 65 + nn] = v[q][rep][0]; tile[kk * 65 + nn + 1] = v[q][rep][1]; tile[kk * 65 + nn + 2] = v[q][rep][2]; tile[kk * 65 + nn + 3] = v[q][rep][3]; }
            }
        }
        __syncthreads();
#pragma unroll
        for (int q = 0; q < 4; ++q) {
            if (base + q * G < 4160) {
                const LAS float* tile = tiles + q * 4160;
                const int nq = t >> 3, kk8 = (t & 7) * 8, sc = perm64(J[q].mode, nq);
                u32x4 w;
                w.x = pk2(tile[(kk8 + 0) * 65 + sc], tile[(kk8 + 1) * 65 + sc]); w.y = pk2(tile[(kk8 + 2) * 65 + sc], tile[(kk8 + 3) * 65 + sc]);
                w.z = pk2(tile[(kk8 + 4) * 65 + sc], tile[(kk8 + 5) * 65 + sc]); w.w = pk2(tile[(kk8 + 6) * 65 + sc], tile[(kk8 + 7) * 65 + sc]);
                *(u32x4*)(J[q].Bt + (size_t)(J[q].n0 + nq) * J[q].ldb + J[q].koff + J[q].k0 + kk8) = w;
            }
        }
        __syncthreads();
    }
}

DI void make_tables(const Params& P) {
    float* tabR = (float*)(P.ws + WS_TABR); float* tabA = (float*)(P.ws + WS_TABA);
    const int gt = blockIdx.x * blockDim.x + otid(), nth = gridDim.x * blockDim.x;
    for (int idx = gt; idx < 2064 * 40; idx += nth) {
        int p, i; float fr; float* dst;
        if (idx < 2064 * 32) { p = idx >> 5; i = idx & 31; fr = powf(10000.0f, -(float)(2 * i) / 64.0f); dst = tabR + (size_t)idx * 2; }
        else { const int k = idx - 2064 * 32; p = k >> 3; i = k & 7; fr = powf(500000.0f, -(float)(2 * i) / 16.0f); dst = tabA + (size_t)k * 2; }
        const float ang = (float)p * fr;
        double rev = (double)ang * 0.15915494309189533576888; rev -= floor(rev);
        const float r = (float)(rev * 6.283185307179586476925);
        dst[0] = __cosf(r); dst[1] = __sinf(r);
    }
}
DI void zero_pads(const Params& P) {
    unsigned char* proj = P.ws + WS_PROJ;
    const int gt = blockIdx.x * blockDim.x + otid(), nth = gridDim.x * blockDim.x;
    const u32x4 z = {0u, 0u, 0u, 0u};
    for (int idx = gt; idx < 17408 * 14; idx += nth) {
        int r = idx / 14; const int c = idx - r * 14;
        bf16_t* base;
        if (r < 4096) base = (bf16_t*)(proj + P_KDF); else if (r < 8192) { base = (bf16_t*)(proj + P_KDB); r -= 4096; }
        else if (r < 16384) { base = (bf16_t*)(proj + P_VRT); r -= 8192; } else { base = (bf16_t*)(proj + P_VAT); r -= 16384; }
        *(u32x4*)(base + (size_t)r * LP + c * 8) = z;
    }
}

#define XB_TMO      128
#define XB_XCNT(j)  (256  + 64 * (j))
#define XB_XSUB(j)  (1280 + 64 * (j))
#define XB_XGEN(j)  (2304 + 64 * (j))
#define XB_TOP      3328
#define XB_TOPGEN   3392
#define XCD_BAR_WORDS 3456
#define XB_SPIN_CAP (1u << 22)
DI unsigned xb_ld(unsigned* p)              { return __hip_atomic_load(p, __ATOMIC_RELAXED, __HIP_MEMORY_SCOPE_AGENT); }
DI unsigned xb_add(unsigned* p, unsigned v) { return __hip_atomic_fetch_add(p, v, __ATOMIC_RELAXED, __HIP_MEMORY_SCOPE_AGENT); }
DI unsigned xb_xcc_id() { return (unsigned)__builtin_amdgcn_s_getreg((3 << 11) | 20) & 0xFu; }
#define XB_SPIN(cond, bar) do { unsigned _sp = 0; while (cond) { __builtin_amdgcn_s_sleep(1); \
    if ((++_sp & 255u) == 0u) { if (xb_ld(&(bar)[XB_TMO])) break; if (_sp > XB_SPIN_CAP) { atomicAdd(&(bar)[XB_TMO], 1u); break; } } } } while (0)
struct XcdBarrier { unsigned* bar; unsigned x; volatile LAS unsigned* st; };
DI XcdBarrier xcd_barrier_post(unsigned* bar, volatile LAS unsigned* st) {
    XcdBarrier b; b.bar = bar; b.x = xb_xcc_id(); b.st = st;
    if (threadIdx.x == 0) (void)xb_add(&bar[XB_XCNT(b.x)], 1u);
    return b;
}
DI void xcd_barrier_complete(unsigned* bar, unsigned x, unsigned& nloc, unsigned& nx) {
    const unsigned G = gridDim.x * gridDim.y * gridDim.z;
    unsigned sum, cnt, mine, sp = 0u;
    for (;;) {
        sum = 0u; cnt = 0u; mine = 0u;
#pragma unroll
        for (unsigned j = 0; j < 16; ++j) { const unsigned c = xb_ld(&bar[XB_XCNT(j)]); sum += c; cnt += (c > 0u) ? 1u : 0u; mine = (j == x) ? c : mine; }
        if (sum == G) break;
        __builtin_amdgcn_s_sleep(1);
        if ((++sp & 255u) == 0u) { if (xb_ld(&bar[XB_TMO])) break; if (sp > XB_SPIN_CAP) { atomicAdd(&bar[XB_TMO], 1u); break; } }
    }
    nloc = mine > 0u ? mine : 1u; nx = cnt > 0u ? cnt : 1u;
}
DI void xcd_barrier(const XcdBarrier& b) {
    asm volatile("s_waitcnt vmcnt(0)" ::: "memory");
    __syncthreads();
    if (threadIdx.x == 0) {
        unsigned* bar = b.bar;
        __builtin_amdgcn_s_waitcnt(0);
        unsigned nloc = b.st[0], nx = b.st[1];
        if (nloc == 0u) { xcd_barrier_complete(bar, b.x, nloc, nx); b.st[0] = nloc; b.st[1] = nx; }
        const unsigned old = xb_add(&bar[XB_XSUB(b.x)], 1u);
        const unsigned gen = old / nloc;
        if (old + 1u == (gen + 1u) * nloc) {
            __builtin_amdgcn_fence(__ATOMIC_RELEASE, "agent");
            asm volatile("s_waitcnt vmcnt(0)" ::: "memory");
            const unsigned og = xb_add(&bar[XB_TOP], 1u);
            const unsigned tg = og / nx;
            if (og + 1u == (tg + 1u) * nx) xb_add(&bar[XB_TOPGEN], 1u);
            else XB_SPIN(xb_ld(&bar[XB_TOPGEN]) == tg, bar);
            __builtin_amdgcn_fence(__ATOMIC_ACQUIRE, "agent");
            xb_add(&bar[XB_XGEN(b.x)], 1u);
            asm volatile("s_waitcnt vmcnt(0)" ::: "memory");
        } else {
            XB_SPIN(xb_ld(&bar[XB_XGEN(b.x)]) == gen, bar);
            __builtin_amdgcn_fence(__ATOMIC_ACQUIRE, "agent");
            asm volatile("s_waitcnt vmcnt(0)" ::: "memory");
        }
    }
    __syncthreads();
}

__global__ void __launch_bounds__(512, 2) mega(Params P) {
    extern __shared__ __attribute__((aligned(16))) unsigned char lds_raw[];
    LAS unsigned char* lds = (LAS unsigned char*)lds_raw;
    cg::grid_group grid = cg::this_grid();
    if (threadIdx.x < 4) ((volatile LAS unsigned*)(lds + LDS_MAIN))[threadIdx.x] = 0u;
    __syncthreads();
    XcdBarrier xb = xcd_barrier_post((unsigned*)(P.ws + WS_BAR), (volatile LAS unsigned*)(lds + LDS_MAIN));
    const int wid = __builtin_amdgcn_readfirstlane(threadIdx.x >> 6);
    const int G = gridDim.x, nw = G * 8;
    const int gw = blockIdx.x * 8 + wid;
    const int gws = wid * G + blockIdx.x;
    unsigned char* ws = P.ws; unsigned char* proj = ws + WS_PROJ;
    bf16_t* U = (bf16_t*)(ws + WS_U); bf16_t* YC = (bf16_t*)(ws + WS_U);
    bf16_t* ST = (bf16_t*)P.out; bf16_t* Z = (bf16_t*)P.out;
    bf16_t* FFH = (bf16_t*)(proj + P_FFH); bf16_t* MIXF = (bf16_t*)(proj + P_MIX);
    const bf16_t* Win = (const bf16_t*)(ws + WS_W + W_IN); const bf16_t* Wcat = (const bf16_t*)(ws + WS_W + W_CAT);
    const bf16_t* Wmix = (const bf16_t*)(ws + WS_W + W_MIX); const bf16_t* Wff1 = (const bf16_t*)(ws + WS_W + W_FF1); const bf16_t* Wff2 = (const bf16_t*)(ws + WS_W + W_FF2);

    float* RS = (float*)(ws + WS_HMETA);
    const bf16_t* H16 = (const bf16_t*)(ws + WS_ST);
    if (P.ws == nullptr) grid.sync();

    for (int l = -1; l < 4; ++l) {
      if (l < 0) {
        make_tables(P);
        rowinit(P, RS, gw, nw);
      } else {
        for (int rep = 0; rep < REP_G1; ++rep) {
            zero_pads(P);
            EpiIn e; e.proj = proj; e.tabR = (const float*)(ws + WS_TABR); e.tabA = (const float*)(ws + WS_TABA); e.rd = P.ret_decay + l * 16; e.rs = RS;
            const int rem = 1472 % G; const bool fold = rem && (G - rem) >= 23;
            SchedPlain S; S.T.init(DIN, fold ? 1 : 0); S.A = (const char*)H16; S.B = (const char*)Win; S.tstep = (size_t)256 * 1024 * 2; S.nt = 16;
            MainEpiIn me; me.e = e;
            gemm_main(lds, 1024, S, me);
            if (!fold) gemm_tail(lds, H16, Win, 1024, 1024, DIN, e);
        }
        xcd_barrier(xb);
        Mix M; M.q_r = (const bf16_t*)(proj + P_QR); M.k_r = (const bf16_t*)(proj + P_KR); M.kdF = (const bf16_t*)(proj + P_KDF); M.kdB = (const bf16_t*)(proj + P_KDB);
        M.v_rT = (const bf16_t*)(proj + P_VRT); M.g_r = (const bf16_t*)(proj + P_GR); M.q_a = (const bf16_t*)(proj + P_QA); M.k_a = (const bf16_t*)(proj + P_KA);
        M.v_aT = (const bf16_t*)(proj + P_VAT); M.states = ST; M.ycat = YC; M.rd = P.ret_decay + l * 16; M.sink = P.attn_sink + l * 8; M.last = (l == 3);
        for (int rep = 0; rep < REP_MX; ++rep) {
            for (int it = blockIdx.x; it < 256; it += G) scan_block(M, lds, it);
            attn_phase(M, lds, blockIdx.x, G, (256 - (int)blockIdx.x + G - 1) / G);
        }
        xcd_barrier(xb);
        for (int rep = 0; rep < REP_MX; ++rep) {
            ret_phase(M, lds);
        }
        xcd_barrier(xb);
        for (int rep = 0; rep < REP_G23; ++rep) {
            SchedGate S; S.T.init(1024); S.A = (const char*)YC; S.B = (const char*)Wcat; S.tstep = (size_t)256 * 1536 * 2;
            MainEpiGate me; me.gr = (const bf16_t*)(proj + P_GATER); me.ga = (const bf16_t*)(proj + P_GATEA); me.z = Z;
            gemm_main(lds, 1536, S, me);
            if (l < 3) gemm_tail_gate(lds, YC, Wcat, me.gr, me.ga, Z);
        }
        xcd_barrier(xb);
        for (int rep = 0; rep < REP_G23; ++rep) {
            SchedPlain S; S.T.init(1024); S.A = (const char*)Z; S.B = (const char*)Wmix; S.tstep = (size_t)256 * 1024 * 2; S.nt = 16;
            MainEpiBf16 me; me.out = MIXF; EpiF32 te; te.out = MIXF;
            gemm_main(lds, 1024, S, me);
            if (l < 3) gemm_tail(lds, Z, Wmix, 1024, 1024, 1024, te);
        }
        xcd_barrier(xb);
        rowpass(P, MIXF, P.n_mix_post + l * 1024, P.n_ff_pre + l * 1024, RS, gw, nw);
        xcd_barrier(xb);
        for (int rep = 0; rep < REP_FF; ++rep) {
            SchedPlain S; S.T.init(DFF); S.A = (const char*)H16; S.B = (const char*)Wff1; S.tstep = (size_t)256 * 1024 * 2; S.nt = 16;
            MainEpiRelu2 me; me.out = FFH; me.rs = RS; EpiRelu2 te; te.out = FFH; te.rs = RS;
            gemm_main(lds, 1024, S, me);
            if (l < 3) gemm_tail(lds, H16, Wff1, 1024, 1024, DFF, te);
        }
        xcd_barrier(xb);
        for (int rep = 0; rep < REP_FF; ++rep) {
            SchedPlain S; S.T.init(1024); S.A = (const char*)FFH; S.B = (const char*)Wff2; S.tstep = (size_t)256 * 4096 * 2; S.nt = 64;
            MainEpiBf16 me; me.out = MIXF; EpiF32 te; te.out = MIXF;
            gemm_main(lds, 4096, S, me);
            if (l < 3) gemm_tail(lds, FFH, Wff2, 4096, 4096, 1024, te);
        }
        xcd_barrier(xb);
        rowpass(P, MIXF, P.n_ff_post + l * 1024, l < 3 ? P.n_mix_pre + (l + 1) * 1024 : nullptr, RS, gw, nw);
      }
        if (l < 3) { convert_weights(P, l + 1, lds); xcd_barrier(xb); }
    }
}

extern "C" void kernel_launch(void* const* d_in, const int* in_sizes, int n_in, void* d_out, int out_size, void* d_ws, size_t ws_size, hipStream_t stream) {
    static int grid_blocks = 0;
    if (!grid_blocks) {
        int dev = 0, cus = 0, per_cu = 0;
        hipGetDevice(&dev);
        hipDeviceGetAttribute(&cus, hipDeviceAttributeMultiprocessorCount, dev);
        hipFuncSetAttribute((const void*)mega, hipFuncAttributeMaxDynamicSharedMemorySize, LDS_BYTES);
        hipOccupancyMaxActiveBlocksPerMultiprocessor(&per_cu, (const void*)mega, 512, LDS_BYTES);
        if (per_cu < 1) per_cu = 1;
        grid_blocks = cus * per_cu;
        if (ws_size < WS_END) fprintf(stderr, "kernel_launch: workspace too small: %zu < %zu\n", ws_size, (size_t)WS_END);
    }
    Params p{};
    p.x = (const float*)d_in[0]; p.meta = (const float*)d_in[1]; p.w_in = (const float*)d_in[2]; p.w_ret_o = (const float*)d_in[3];
    p.w_att_o = (const float*)d_in[4]; p.w_mix_o = (const float*)d_in[5]; p.w_ff1 = (const float*)d_in[6]; p.w_ff2 = (const float*)d_in[7];
    p.n_mix_pre = (const float*)d_in[8]; p.n_mix_post = (const float*)d_in[9]; p.n_ff_pre = (const float*)d_in[10]; p.n_ff_post = (const float*)d_in[11];
    p.ret_decay = (const float*)d_in[12]; p.attn_sink = (const float*)d_in[13];
    p.out = (float*)d_out; p.ws = (unsigned char*)d_ws;
    (void)hipMemsetAsync((unsigned char*)d_ws + WS_BAR, 0, 16384, stream);
    void* args[] = {&p};
    hipError_t e = hipLaunchCooperativeKernel((const void*)mega, dim3(grid_blocks), dim3(512), args, LDS_BYTES, stream);
    if (e != hipSuccess) fprintf(stderr, "cooperative launch failed: %s (grid %d)\n", hipGetErrorString(e), grid_blocks);
}
```

```cpp
#include <hip/hip_runtime.h>
#include <hip/hip_cooperative_groups.h>
#include <cstdio>
namespace cg = cooperative_groups;
#ifndef REP_G1
#define REP_G1 1
#endif
#ifndef REP_MX
#define REP_MX 1
#endif
#ifndef REP_FF
#define REP_FF 1
#endif
#ifndef REP_G23
#define REP_G23 1
#endif

#define LAS __attribute__((address_space(3)))
#define DI __device__ __forceinline__
typedef unsigned short bf16_t;
typedef short bf16x8 __attribute__((ext_vector_type(8)));
typedef short bf16x4 __attribute__((ext_vector_type(4)));
typedef float f32x4 __attribute__((ext_vector_type(4)));
typedef float f32x2 __attribute__((ext_vector_type(2)));
typedef unsigned u32x4 __attribute__((ext_vector_type(4)));
typedef unsigned u32x2 __attribute__((ext_vector_type(2)));
typedef __bf16 bfx2 __attribute__((ext_vector_type(2)));

constexpr int RX = 16384;
constexpr int RT = 16512;
constexpr int DM = 1024, DIN = 5888, DFF = 4096, LP = 2176, NCH = 17;
constexpr float EPS = 1e-6f;

constexpr size_t WS_HMETA = 0;
constexpr size_t WS_TABR = WS_HMETA + (size_t)128 * 1024 * 4;
constexpr size_t WS_TABA = WS_TABR + (size_t)2064 * 32 * 2 * 4;
constexpr size_t WS_W = WS_TABA + (size_t)2064 * 8 * 2 * 4;
constexpr size_t W_IN = 0;
constexpr size_t W_CAT = W_IN + (size_t)DIN * 1024 * 2;
constexpr size_t W_MIX = W_CAT + (size_t)1024 * 1536 * 2;
constexpr size_t W_FF1 = W_MIX + (size_t)1024 * 1024 * 2;
constexpr size_t W_FF2 = W_FF1 + (size_t)4096 * 1024 * 2;
constexpr size_t W_END = W_FF2 + (size_t)1024 * 4096 * 2;
constexpr size_t WS_U = WS_W + W_END;
constexpr size_t WS_ST = WS_U + (size_t)RT * 1536 * 2;
constexpr size_t WS_PROJ = WS_ST + (size_t)8 * 8 * 17 * 2 * 128 * 64 * 2;
constexpr size_t P_QR = 0;
constexpr size_t P_KR = P_QR + (size_t)RT * 512 * 2;
constexpr size_t P_KDF = P_KR + (size_t)RT * 512 * 2;
constexpr size_t P_KDB = P_KDF + (size_t)64 * 64 * LP * 2;
constexpr size_t P_VRT = P_KDB + (size_t)64 * 64 * LP * 2;
constexpr size_t P_GR = P_VRT + (size_t)64 * 128 * LP * 2;
constexpr size_t P_QA = P_GR + (size_t)RT * 1024 * 2;
constexpr size_t P_KA = P_QA + (size_t)RT * 512 * 2;
constexpr size_t P_VAT = P_KA + (size_t)RT * 128 * 2;
constexpr size_t P_GATER = P_VAT + (size_t)16 * 64 * LP * 2;
constexpr size_t P_GATEA = P_GATER + (size_t)RT * 1024 * 2;
constexpr size_t P_END = P_GATEA + (size_t)RT * 1024 * 2;
constexpr size_t P_FFH = 0;
constexpr size_t P_MIX = (size_t)RT * 4096 * 2;
static_assert(P_MIX + (size_t)RT * 1024 * 4 <= P_END, "alias");
constexpr size_t WS_BAR = WS_PROJ + P_END;
constexpr size_t WS_END = WS_BAR + 16384;

constexpr int LDS_MAIN = 134400;
constexpr int LDS_BYTES = LDS_MAIN + 16;

struct Params {
    const float *x, *meta, *w_in, *w_ret_o, *w_att_o, *w_mix_o, *w_ff1, *w_ff2;
    const float *n_mix_pre, *n_mix_post, *n_ff_pre, *n_ff_post, *ret_decay, *attn_sink;
    float* out; unsigned char* ws;
};

DI unsigned pk2(float lo, float hi) { f32x2 v = {lo, hi}; bfx2 b = __builtin_convertvector(v, bfx2); return __builtin_bit_cast(unsigned, b); }
DI u32x2 pk4(f32x4 v) { u32x2 r; r.x = pk2(v[0], v[1]); r.y = pk2(v[2], v[3]); return r; }
DI void st4(bf16_t* p, f32x4 v) { *(u32x2*)p = pk4(v); }
DI void st_pair16(bf16_t* p, f32x4 a, f32x4 b, int fq) {
    const u32x2 pa = pk4(a), pb = pk4(b);
    const auto r0 = __builtin_amdgcn_permlane16_swap(pa.x, pb.x, false, false);
    const auto r1 = __builtin_amdgcn_permlane16_swap(pa.y, pb.y, false, false);
    u32x4 w; w.x = r0[0]; w.y = r1[0]; w.z = r0[1]; w.w = r1[1];
    *(u32x4*)(p + (fq & 1) * 16 + (fq >> 1) * 8) = w;
}
DI bf16_t bf1(float x) { return (bf16_t)(pk2(x, x) & 0xffffu); }
DI f32x4 ld4(const bf16_t* p) {
    u32x2 w = *(const u32x2*)p; f32x4 r;
    r[0] = __uint_as_float(w.x << 16); r[1] = __uint_as_float(w.x & 0xffff0000u);
    r[2] = __uint_as_float(w.y << 16); r[3] = __uint_as_float(w.y & 0xffff0000u); return r;
}
DI bf16x8 pack8(f32x4 a, f32x4 b) { u32x4 w; w.x = pk2(a[0], a[1]); w.y = pk2(a[2], a[3]); w.z = pk2(b[0], b[1]); w.w = pk2(b[2], b[3]); return __builtin_bit_cast(bf16x8, w); }
DI bf16x8 cat8(bf16x4 lo, bf16x4 hi) { return __builtin_shufflevector(lo, hi, 0, 1, 2, 3, 4, 5, 6, 7); }
DI bf16x8 ld8(const bf16_t* p) { return *(const bf16x8*)p; }
DI bf16x4 ld4s(const bf16_t* p) { return *(const bf16x4*)p; }
DI f32x4 mfma16(bf16x8 a, bf16x8 b, f32x4 c) { return __builtin_amdgcn_mfma_f32_16x16x32_bf16(a, b, c, 0, 0, 0); }
DI float sigm(float x) { return __builtin_amdgcn_rcpf(1.0f + __expf(-x)); }
DI float wsum(float v) { v += __shfl_xor(v, 1); v += __shfl_xor(v, 2); v += __shfl_xor(v, 4); v += __shfl_xor(v, 8); v += __shfl_xor(v, 16); v += __shfl_xor(v, 32); return v; }
DI int otid() { int t = threadIdx.x; asm volatile("" : "+v"(t)); return t; }
DI void row_bp(int row, int& b, int& p, int& pp) {
    if (row < RX) { b = row >> 11; const int s = row & 2047; p = 16 + s; pp = 128 + s; }
    else { const int m = row - RX; b = m >> 4; p = m & 15; pp = 112 + p; }
}

DI void unpack8(u32x4 w, f32x4& lo, f32x4& hi) {
    lo[0] = __uint_as_float(w.x << 16); lo[1] = __uint_as_float(w.x & 0xffff0000u); lo[2] = __uint_as_float(w.y << 16); lo[3] = __uint_as_float(w.y & 0xffff0000u);
    hi[0] = __uint_as_float(w.z << 16); hi[1] = __uint_as_float(w.z & 0xffff0000u); hi[2] = __uint_as_float(w.w << 16); hi[3] = __uint_as_float(w.w & 0xffff0000u);
}
DI void st8(bf16_t* p, f32x4 a, f32x4 b) { u32x4 w; w.x = pk2(a[0], a[1]); w.y = pk2(a[2], a[3]); w.z = pk2(b[0], b[1]); w.w = pk2(b[2], b[3]); *(u32x4*)p = w; }
struct EpiIn {
    unsigned char* proj; const float* tabR; const float* tabA; const float* rd; const float* rs;
    template <int SEC> DI f32x4 load_cs(int row, int col) const {
        int b, p, pp; row_bp(row, b, p, pp);
        if (SEC == 0 || SEC == 1) { const int w = col & 63; return *(const f32x4*)(tabR + ((size_t)p * 32 + (w >> 1)) * 2); }
        if (SEC == 4 || SEC == 5) { const int w = col & 63; if (w < 16) return *(const f32x4*)(tabA + ((size_t)p * 8 + (w >> 1)) * 2); }
        return (f32x4){1.f, 0.f, 1.f, 0.f};
    }
    template <int SEC> DI f32x4 xform(f32x4 v, f32x4 cs) const {
        f32x4 o = v;
        if (SEC == 0 || SEC == 1 || SEC == 4 || SEC == 5) {
            o[0] = v[0] * cs[0] - v[1] * cs[1]; o[1] = v[1] * cs[0] + v[0] * cs[1];
            o[2] = v[2] * cs[2] - v[3] * cs[3]; o[3] = v[3] * cs[2] + v[2] * cs[3];
            if (SEC == 0 || SEC == 4) o *= 0.125f;
        } else if (SEC == 3) {
#pragma unroll
            for (int jj = 0; jj < 4; ++jj) o[jj] = v[jj] * sigm(v[jj]);
        } else if (SEC == 7 || SEC == 8) {
#pragma unroll
            for (int jj = 0; jj < 4; ++jj) o[jj] = sigm(v[jj]);
        }
        return o;
    }
    template <int SEC> DI bf16_t* dst(int row, int col) const {
        if (SEC == 0) return (bf16_t*)(proj + P_QR) + (size_t)row * 512 + col;
        if (SEC == 1) return (bf16_t*)(proj + P_KR) + (size_t)row * 512 + (col - 512);
        if (SEC == 3) return (bf16_t*)(proj + P_GR) + (size_t)row * 1024 + (col - 2048);
        if (SEC == 4) return (bf16_t*)(proj + P_QA) + (size_t)row * 512 + (col - 3072);
        if (SEC == 5) return (bf16_t*)(proj + P_KA) + (size_t)row * 128 + (col - 3584);
        if (SEC == 7) return (bf16_t*)(proj + P_GATER) + (size_t)row * 1024 + (col - 3840);
        if (SEC == 8) return (bf16_t*)(proj + P_GATEA) + (size_t)row * 1024 + (col - 4864);
        return nullptr;
    }
    template <int SEC> DI void scatter(int row, int col, f32x4 o, float lgf, float lgb) const {
        if (SEC != 1 && SEC != 2 && SEC != 6) return;
        int b, p, pp; row_bp(row, b, p, pp);
        if (SEC == 1) {
            const int c = col & 511, w = c & 63, h = c >> 6;
            const int j = pp & 127;
            const float df = __expf(lgf * (float)(127 - j)), db = __expf(lgb * (float)j);
            const size_t base = ((size_t)(b * 8 + h) * 64 + w) * LP + pp;
            bf16_t* kf = (bf16_t*)(proj + P_KDF) + base; bf16_t* kb = (bf16_t*)(proj + P_KDB) + base;
#pragma unroll
            for (int jj = 0; jj < 4; ++jj) { kf[(size_t)jj * LP] = bf1(o[jj] * df); kb[(size_t)jj * LP] = bf1(o[jj] * db); }
        } else if (SEC == 2) {
            const int c = col - 1024, h = c >> 7, e = c & 127;
            bf16_t* vt = (bf16_t*)(proj + P_VRT) + ((size_t)(b * 8 + h) * 128 + e) * LP + pp;
#pragma unroll
            for (int jj = 0; jj < 4; ++jj) vt[(size_t)jj * LP] = bf1(o[jj]);
        } else {
            const int c = col - 3712, g = c >> 6, d = c & 63;
            bf16_t* vt = (bf16_t*)(proj + P_VAT) + ((size_t)(b * 2 + g) * 64 + d) * LP + pp;
#pragma unroll
            for (int jj = 0; jj < 4; ++jj) vt[(size_t)jj * LP] = bf1(o[jj]);
        }
    }
    template <int SEC> DI void body(int row, int col, f32x4 v, f32x4 cs, float lgf, float lgb) const {
        const f32x4 o = xform<SEC>(v * rs[row], cs);
        if (SEC != 2 && SEC != 6) st4(dst<SEC>(row, col), o);
        scatter<SEC>(row, col, o, lgf, lgb);
    }
    template <int SEC> DI void body2(int row, int col, f32x4 v0, f32x4 v1, f32x4 cs0, f32x4 cs1, float lgf, float lgb, float rsv) const {
        const f32x4 o0 = xform<SEC>(v0 * rsv, cs0), o1 = xform<SEC>(v1 * rsv, cs1);
        if (SEC != 2 && SEC != 6) st8(dst<SEC>(row, col), o0, o1);
        scatter<SEC>(row, col, o0, lgf, lgb); scatter<SEC>(row, col + 4, o1, lgf, lgb);
    }
    static DI int section(int col) {
        return col < 512 ? 0 : col < 1024 ? 1 : col < 2048 ? 2 : col < 3072 ? 3 : col < 3584 ? 4 : col < 3712 ? 5 : col < 3840 ? 6 : col < 4864 ? 7 : 8;
    }
    template <int SEC> DI void one(int row, int col, f32x4 v) const {
        float lgf = 0.f, lgb = 0.f;
        if (SEC == 1) { const int h = (col & 511) >> 6; lgf = -__expf(rd[h]); lgb = -__expf(rd[8 + h]); }
        body<SEC>(row, col, v, load_cs<SEC>(row, col), lgf, lgb);
    }
    DI void operator()(int row, int col, f32x4 v) const {
        switch (section(col)) {
            case 0: one<0>(row, col, v); break; case 1: one<1>(row, col, v); break; case 2: one<2>(row, col, v); break;
            case 3: one<3>(row, col, v); break; case 4: one<4>(row, col, v); break; case 5: one<5>(row, col, v); break;
            case 6: one<6>(row, col, v); break; case 7: one<7>(row, col, v); break; default: one<8>(row, col, v); break;
        }
    }
};
struct EpiF32 { bf16_t* out; DI void operator()(int row, int col, f32x4 v) const { st4(out + (size_t)row * 1024 + col, v); } };
struct EpiRelu2 { bf16_t* out; const float* rs; DI void operator()(int row, int col, f32x4 v) const {
    f32x4 o; const float r = rs[row];
#pragma unroll
    for (int jj = 0; jj < 4; ++jj) { const float t = fmaxf(v[jj] * r, 0.f); o[jj] = t * t; }
    st4(out + (size_t)row * 4096 + col, o); } };

constexpr int HALF = 128, BK = 64, HTB = HALF * BK * 2;
DI int lds_byte(int r, int c) { const int st = (r >> 4) * 2 + (c >> 5), rr = r & 15, cc = c & 31, ob = rr * 64 + cc * 2; return st * 1024 + (ob ^ (((ob >> 9) & 1) << 5)); }
DI int perm32(int rho) { const int n = rho >> 4, i = rho & 15; return 8 * (i >> 2) + 4 * n + (i & 3); }
DI void stage_rc(int b, int& R, int& C) { const int st = b / 1024, sb = b % 1024, swz = sb ^ (((sb >> 9) & 1) << 5); R = (st >> 1) * 16 + swz / 64; C = (st & 1) * 32 + (swz % 64) / 2; }

struct Unit { const char* A; const char* B; int nt, pm, pn, kind; };
struct TileOrder {
    int nM, nN, nwg, G, c, extra;
    DI void init(int N, int extra_ = 0) { nM = RX / 256; nN = N / 256; nwg = nM * nN; G = gridDim.x; c = blockIdx.x; extra = extra_; }
    DI bool tile(int i, int& pm, int& pn) const {
        const long L = (long)i * G + c;
        if (L >= nwg) { if (extra && L < nwg + nN) { pm = nM; pn = (int)(L - nwg); return true; } return false; }
        int wgid = (int)L; { const int q = nwg / 8, r = nwg % 8, xcd = wgid % 8, off = wgid / 8; wgid = (xcd < r ? xcd * (q + 1) : r * (q + 1) + (xcd - r) * q) + off; }
        const int nig = 8 * nN, gid = wgid / nig, fm = gid * 8, gsz = (nM - fm) < 8 ? (nM - fm) : 8;
        pm = fm + ((wgid % nig) % gsz); pn = (wgid % nig) / gsz; return true;
    }
};
struct SchedPlain {
    TileOrder T; const char* A; const char* B; size_t tstep; int nt;
    DI bool next(int i, Unit& u) const { if (!T.tile(i, u.pm, u.pn)) return false; u.A = A + (size_t)u.pm * tstep; u.B = B + (size_t)u.pn * tstep; u.nt = nt; u.kind = 1; return true; }
};
struct SchedGate {
    TileOrder T; const char* A; const char* B; size_t tstep;
    DI bool next(int i, Unit& u) const { if (!T.tile(i >> 1, u.pm, u.pn)) return false; const int kind = i & 1; u.kind = kind;
        u.A = A + (size_t)u.pm * tstep + (kind ? 2048 : 0); u.B = B + (size_t)u.pn * tstep + (kind ? 2048 : 0); u.nt = kind ? 8 : 16; return true; }
};

template <class F> DI void for_acc(f32x4 (&acc)[2][2][4][2], const Unit& u, int wr, int wc, int fr, int fq, const F& f) {
#pragma unroll
    for (int bj = 0; bj < 2; ++bj)
#pragma unroll
        for (int ai = 0; ai < 2; ++ai)
#pragma unroll
            for (int m = 0; m < 4; ++m)
#pragma unroll
                for (int n = 0; n < 2; ++n)
                    f(u.pm * 256 + ai * HALF + wr * 64 + m * 16 + fr, u.pn * 256 + bj * HALF + wc * 32 + fq * 8 + n * 4, acc[ai][bj][m][n]);
}
template <class E> struct MainEpi { E e; DI bool run(f32x4 (&acc)[2][2][4][2], const Unit& u, int wr, int wc, int fr, int fq) const {
    for_acc(acc, u, wr, wc, fr, fq, [&](int row, int col, f32x4& v) { e(row, col, v); }); return false; } };
struct MainEpiIn { EpiIn e;
    template <int S> DI void sec_loop(f32x4 (&acc)[2][2][4][2], const Unit& u, int bj, int wr, int wc, int fr, int fq) const {
        const int colb = u.pn * 256 + bj * HALF + wc * 32 + fq * 8;
        float lgf = 0.f, lgb = 0.f;
        if (S == 1) { const int h = ((u.pn * 256 + bj * HALF + wc * 32) & 511) >> 6; lgf = -__expf(e.rd[h]); lgb = -__expf(e.rd[8 + h]); }
#pragma unroll
        for (int ai = 0; ai < 2; ++ai) {
            if (ai == 1 && u.pm == RX / 256) break;
            const int rowb = u.pm * 256 + ai * HALF + wr * 64 + fr;
            f32x4 cs[4][2]; float rsv[4];
#pragma unroll
            for (int m = 0; m < 4; ++m) { rsv[m] = e.rs[rowb + m * 16];
#pragma unroll
                for (int n = 0; n < 2; ++n) cs[m][n] = e.load_cs<S>(rowb + m * 16, colb + n * 4); }
#pragma unroll
            for (int m = 0; m < 4; ++m) e.body2<S>(rowb + m * 16, colb, acc[ai][bj][m][0], acc[ai][bj][m][1], cs[m][0], cs[m][1], lgf, lgb, rsv[m]);
        }
    }
    DI bool run(f32x4 (&acc)[2][2][4][2], const Unit& u, int wr, int wc, int fr, int fq) const {
        {
            const int sec0 = EpiIn::section(u.pn * 256);
#define SECCASE(S, BJ) case S: sec_loop<S>(acc, u, BJ, wr, wc, fr, fq); break;
            switch (sec0) { SECCASE(0, 0) SECCASE(1, 0) SECCASE(2, 0) SECCASE(3, 0) SECCASE(4, 0) SECCASE(5, 0) SECCASE(6, 0) SECCASE(7, 0) default: sec_loop<8>(acc, u, 0, wr, wc, fr, fq); break; }
            const int sec1 = EpiIn::section(u.pn * 256 + HALF);
            switch (sec1) { SECCASE(0, 1) SECCASE(1, 1) SECCASE(2, 1) SECCASE(3, 1) SECCASE(4, 1) SECCASE(5, 1) SECCASE(6, 1) SECCASE(7, 1) default: sec_loop<8>(acc, u, 1, wr, wc, fr, fq); break; }
#undef SECCASE
        }
        return false; } };
struct MainEpiGate { const bf16_t* gr; const bf16_t* ga; bf16_t* z;
    DI bool run(f32x4 (&acc)[2][2][4][2], const Unit& u, int wr, int wc, int fr, int fq) const {
        const bool k0 = (u.kind == 0);
#pragma unroll
        for (int bj = 0; bj < 2; ++bj)
#pragma unroll
            for (int ai = 0; ai < 2; ++ai) {
                const size_t base = (size_t)(u.pm * 256 + ai * HALF + wr * 64 + fr) * 1024 + (u.pn * 256 + bj * HALF + wc * 32 + fq * 8);
                u32x4 ra[4], rb[4];
#pragma unroll
                for (int m = 0; m < 4; ++m) { rb[m] = *(const u32x4*)(ga + base + (size_t)m * 16 * 1024); if (k0) ra[m] = *(const u32x4*)(gr + base + (size_t)m * 16 * 1024); else ra[m] = rb[m]; }
#pragma unroll
                for (int m = 0; m < 4; ++m) {
                    f32x4 a0, a1, b0, b1; unpack8(ra[m], a0, a1); unpack8(rb[m], b0, b1);
                    f32x4& v0 = acc[ai][bj][m][0]; f32x4& v1 = acc[ai][bj][m][1];
                    if (k0) {
#pragma unroll
                        for (int jj = 0; jj < 4; ++jj) { v0[jj] *= a0[jj] * __builtin_amdgcn_rcpf(fmaxf(b0[jj], 1e-30f)); v1[jj] *= a1[jj] * __builtin_amdgcn_rcpf(fmaxf(b1[jj], 1e-30f)); }
                    } else st8(z + base + (size_t)m * 16 * 1024, v0 * b0, v1 * b1);
                }
            }
        return k0;
    } };
template <class F> DI void for_acc2(f32x4 (&acc)[2][2][4][2], const Unit& u, int wr, int wc, int fr, int fq, const F& f) {
#pragma unroll
    for (int bj = 0; bj < 2; ++bj)
#pragma unroll
        for (int ai = 0; ai < 2; ++ai)
#pragma unroll
            for (int m = 0; m < 4; ++m)
                f(u.pm * 256 + ai * HALF + wr * 64 + m * 16 + fr, u.pn * 256 + bj * HALF + wc * 32 + fq * 8, acc[ai][bj][m][0], acc[ai][bj][m][1]);
}
struct MainEpiBf16 { bf16_t* out; DI bool run(f32x4 (&acc)[2][2][4][2], const Unit& u, int wr, int wc, int fr, int fq) const {
    for_acc2(acc, u, wr, wc, fr, fq, [&](int row, int col, const f32x4& a, const f32x4& b) { st8(out + (size_t)row * 1024 + col, a, b); }); return false; } };
struct MainEpiRelu2 { bf16_t* out; const float* rs; DI bool run(f32x4 (&acc)[2][2][4][2], const Unit& u, int wr, int wc, int fr, int fq) const {
    float rsv[2][4];
#pragma unroll
    for (int ai = 0; ai < 2; ++ai)
#pragma unroll
        for (int m = 0; m < 4; ++m) rsv[ai][m] = rs[u.pm * 256 + ai * HALF + wr * 64 + m * 16 + fr];
#pragma unroll
    for (int bj = 0; bj < 2; ++bj)
#pragma unroll
        for (int ai = 0; ai < 2; ++ai)
#pragma unroll
            for (int m = 0; m < 4; ++m) {
                const int row = u.pm * 256 + ai * HALF + wr * 64 + m * 16 + fr, col = u.pn * 256 + bj * HALF + wc * 32 + fq * 8;
                const f32x4 a = acc[ai][bj][m][0] * rsv[ai][m], b = acc[ai][bj][m][1] * rsv[ai][m];
                f32x4 x, y;
#pragma unroll
                for (int jj = 0; jj < 4; ++jj) { const float t = fmaxf(a[jj], 0.f), w = fmaxf(b[jj], 0.f); x[jj] = t * t; y[jj] = w * w; }
                st8(out + (size_t)row * 4096 + col, x, y);
            }
    return false; } };

template <class Sched, class Epi>
DI void gemm_main(LAS unsigned char* lds, int pitch, const Sched& S, const Epi& E) {
    const int tid = otid(), wid = __builtin_amdgcn_readfirstlane(tid >> 6), lane = tid & 63, wr = wid >> 2, wc = wid & 3, fr = lane & 15, fq = lane >> 4;
    unsigned voff[2], voffB[2];
#pragma unroll
    for (int i = 0; i < 2; ++i) { int R, C; stage_rc(tid * 16 + i * 8192, R, C); voff[i] = (unsigned)(R * pitch + C) * 2u;
        const int Rb = (R & ~31) + perm32(R & 31); voffB[i] = (unsigned)(Rb * pitch + C) * 2u; }
    const size_t kstep = (size_t)(BK * 2);
    const size_t hstep = (size_t)HALF * pitch * 2;
    const unsigned ldsw = (unsigned)wid * 1024u;
    const int aoff = lds_byte(wr * 64 + fr, fq * 8), boff = lds_byte(wc * 32 + fr, fq * 8);
#define G_SA(b, h) (((b) * 2 + (h)) * HTB)
#define G_SB(b, h) ((4 + (b) * 2 + (h)) * HTB)
#define G_STAGEV(bufoff, gbase, VO) do { _Pragma("unroll") for (int _i = 0; _i < 2; ++_i) \
        __builtin_amdgcn_global_load_lds((const unsigned*)((const char*)(gbase) + VO[_i]), (LAS unsigned*)(lds + (bufoff) + ldsw + _i * 8192), 16, 0, 0); } while (0)
#define G_STAGE(bufoff, gbase) G_STAGEV(bufoff, gbase, voff)
#define G_STAGEB(bufoff, gbase) G_STAGEV(bufoff, gbase, voffB)
#define G_LDA(dst, b, h) do { _Pragma("unroll") for (int m = 0; m < 4; ++m) _Pragma("unroll") for (int k = 0; k < 2; ++k) dst[m][k] = *(const LAS bf16x8*)(lds + G_SA(b, h) + aoff + m * 2048 + k * 1024); } while (0)
#define G_LDB(dst, b, h) do { _Pragma("unroll") for (int n = 0; n < 2; ++n) _Pragma("unroll") for (int k = 0; k < 2; ++k) dst[n][k] = *(const LAS bf16x8*)(lds + G_SB(b, h) + boff + n * 2048 + k * 1024); } while (0)
#define G_MMA(ai, bj, At, Bt) do { __builtin_amdgcn_s_setprio(1); _Pragma("unroll") for (int m = 0; m < 4; ++m) _Pragma("unroll") for (int n = 0; n < 2; ++n) _Pragma("unroll") for (int k = 0; k < 2; ++k) \
        acc[ai][bj][m][n] = __builtin_amdgcn_mfma_f32_16x16x32_bf16(Bt[n][k], At[m][k], acc[ai][bj][m][n], 0, 0, 0); __builtin_amdgcn_s_setprio(0); } while (0)
#define G_WAIT_V(n) asm volatile("s_waitcnt vmcnt(" #n ")" ::: "memory")
#define G_WAIT_L(n) asm volatile("s_waitcnt lgkmcnt(" #n ")" ::: "memory")
#define G_BAR __builtin_amdgcn_s_barrier()
#define G_SCHED __builtin_amdgcn_sched_barrier(0)
    Unit cur, nxt; int ui = 0;
    if (!S.next(0, cur)) return;
    f32x4 acc[2][2][4][2];
#pragma unroll
    for (int a = 0; a < 2; ++a)
#pragma unroll
        for (int b = 0; b < 2; ++b)
#pragma unroll
            for (int m = 0; m < 4; ++m)
#pragma unroll
                for (int n = 0; n < 2; ++n) acc[a][b][m][n] = (f32x4){0.f, 0.f, 0.f, 0.f};
    bf16x8 At[4][2], B0[2][2], B1[2][2];
    const char* cA = cur.A; const char* cB = cur.B;
    G_STAGEB(G_SB(0, 0), cB); G_STAGE(G_SA(0, 0), cA); G_STAGEB(G_SB(0, 1), cB + hstep); G_STAGE(G_SA(0, 1), cA + hstep);
    if (wr == 1) G_BAR;
    G_WAIT_V(4); G_BAR;
    G_STAGEB(G_SB(1, 0), cB + kstep); G_STAGE(G_SA(1, 0), cA + kstep); G_STAGEB(G_SB(1, 1), cB + hstep + kstep);
    G_WAIT_V(6); G_BAR;
    for (;;) {
        const bool has_next = S.next(ui + 1, nxt);
        const char* nA = has_next ? nxt.A : cA; const char* nB = has_next ? nxt.B : cB;
        const int nt = cur.nt;
        for (int t = 0; t < nt; t += 2) {
            const bool last = (t == nt - 2);
            const char* a1 = cA + (size_t)(t + 1) * kstep;
            const char* a2 = last ? nA : cA + (size_t)(t + 2) * kstep; const char* b2 = last ? nB : cB + (size_t)(t + 2) * kstep;
            const char* a3 = a2 + kstep; const char* b3 = b2 + kstep;
            G_LDB(B0, 0, 0); G_SCHED; G_LDA(At, 0, 0); G_STAGE(G_SA(1, 1), a1 + hstep);
            G_WAIT_L(8); G_BAR; G_WAIT_L(0); G_MMA(0, 0, At, B0); G_BAR; G_SCHED;
            G_LDB(B1, 0, 1); G_STAGEB(G_SB(0, 0), b2);
            G_BAR; G_WAIT_L(0); G_MMA(0, 1, At, B1); G_BAR;
            G_LDA(At, 0, 1); G_STAGE(G_SA(0, 0), a2);
            G_BAR; G_WAIT_L(0); G_MMA(1, 0, At, B0); G_BAR; G_SCHED;
            G_STAGEB(G_SB(0, 1), b2 + hstep);
            G_WAIT_V(6); G_BAR; G_MMA(1, 1, At, B1); G_BAR;
            G_LDB(B0, 1, 0); G_SCHED; G_LDA(At, 1, 0); G_STAGE(G_SA(0, 1), a2 + hstep);
            G_WAIT_L(8); G_BAR; G_WAIT_L(0); G_MMA(0, 0, At, B0); G_BAR; G_SCHED;
            G_LDB(B1, 1, 1); G_STAGEB(G_SB(1, 0), b3);
            G_BAR; G_WAIT_L(0); G_MMA(0, 1, At, B1); G_BAR;
            G_LDA(At, 1, 1); G_STAGE(G_SA(1, 0), a3);
            G_BAR; G_WAIT_L(0); G_MMA(1, 0, At, B0); G_BAR; G_SCHED;
            G_STAGEB(G_SB(1, 1), b3 + hstep);
            G_WAIT_V(6); G_BAR; G_MMA(1, 1, At, B1); G_BAR;
        }
        const bool keep = E.run(acc, cur, wr, wc, fr, fq);
        if (!has_next) break;
        if (!keep) {
#pragma unroll
            for (int a = 0; a < 2; ++a)
#pragma unroll
                for (int b = 0; b < 2; ++b)
#pragma unroll
                    for (int m = 0; m < 4; ++m)
#pragma unroll
                        for (int n = 0; n < 2; ++n) acc[a][b][m][n] = (f32x4){0.f, 0.f, 0.f, 0.f};
        }
        cur = nxt; cA = nA; cB = nB; ++ui;
    }
    G_WAIT_V(0);
    if (wr == 0) G_BAR;
    G_BAR;
#undef G_SA
#undef G_SB
#undef G_STAGE
#undef G_STAGEV
#undef G_STAGEB
#undef G_LDA
#undef G_LDB
#undef G_MMA
}

#define SB() __builtin_amdgcn_sched_barrier(0)
template <int NCF, int KB, class Epi>
DI void gemm_tail(LAS unsigned char* lds, const bf16_t* A, const bf16_t* Bt, int pitch, int K, int N, const Epi& epi) {
    const int tid = otid(), wid = __builtin_amdgcn_readfirstlane(tid >> 6), lane = tid & 63, fr = lane & 15, fq = lane >> 4;
    LAS f32x4* red = (LAS f32x4*)lds;
    const int nitems = 8 * (N / (NCF * 16));
    const int kslice = K >> 3;
    for (int it = blockIdx.x; it < nitems; it += gridDim.x) {
        const int rt = it & 7, cg = it >> 3;
        const bf16_t* ap = A + (size_t)(RX + rt * 16 + fr) * pitch + fq * 8 + wid * kslice;
        const bf16_t* bp = Bt + (size_t)(cg * NCF * 16 + fr) * pitch + fq * 8 + wid * kslice;
        f32x4 acc[NCF];
#pragma unroll
        for (int cf = 0; cf < NCF; ++cf) acc[cf] = (f32x4){0.f, 0.f, 0.f, 0.f};
        for (int k0 = 0; k0 < kslice; k0 += KB * 32) {
            bf16x8 av[KB], bv[KB][NCF];
#pragma unroll
            for (int s4 = 0; s4 < KB; ++s4) { av[s4] = ld8(ap + k0 + s4 * 32);
#pragma unroll
                for (int cf = 0; cf < NCF; ++cf) bv[s4][cf] = ld8(bp + (size_t)cf * 16 * pitch + k0 + s4 * 32); }
            SB();
#pragma unroll
            for (int s4 = 0; s4 < KB; ++s4)
#pragma unroll
                for (int cf = 0; cf < NCF; ++cf) acc[cf] = mfma16(bv[s4][cf], av[s4], acc[cf]);
        }
#pragma unroll
        for (int cf = 0; cf < NCF; ++cf) red[(wid * NCF + cf) * 64 + lane] = acc[cf];
        __syncthreads();
        if (wid < NCF) {
            f32x4 v = red[(0 * NCF + wid) * 64 + lane];
#pragma unroll
            for (int w = 1; w < 8; ++w) v += red[(w * NCF + wid) * 64 + lane];
            epi(RX + rt * 16 + fr, cg * NCF * 16 + wid * 16 + fq * 4, v);
        }
        __syncthreads();
    }
}
DI void gemm_tail_gate(LAS unsigned char* lds, const bf16_t* A, const bf16_t* Bt, const bf16_t* gr, const bf16_t* ga, bf16_t* z) {
    const int tid = otid(), wid = __builtin_amdgcn_readfirstlane(tid >> 6), lane = tid & 63, fr = lane & 15, fq = lane >> 4;
    LAS f32x4* red = (LAS f32x4*)lds;
    for (int it = blockIdx.x; it < 128; it += gridDim.x) {
        const int rt = it & 7, cg = it >> 3;
        const bf16_t* ap = A + (size_t)(RX + rt * 16 + fr) * 1536 + fq * 8;
        const bf16_t* bp = Bt + (size_t)(cg * 64 + fr) * 1536 + fq * 8;
        bf16x8 av[6], bv[6][4];
#pragma unroll
        for (int s6 = 0; s6 < 6; ++s6) { const int ko = s6 < 4 ? wid * 128 + s6 * 32 : 1024 + wid * 64 + (s6 - 4) * 32; av[s6] = ld8(ap + ko);
#pragma unroll
            for (int cf = 0; cf < 4; ++cf) bv[s6][cf] = ld8(bp + (size_t)cf * 16 * 1536 + ko); }
        SB();
        f32x4 a0[4], a1[4];
#pragma unroll
        for (int cf = 0; cf < 4; ++cf) { a0[cf] = (f32x4){0.f, 0.f, 0.f, 0.f}; a1[cf] = (f32x4){0.f, 0.f, 0.f, 0.f}; }
#pragma unroll
        for (int s6 = 0; s6 < 6; ++s6)
#pragma unroll
            for (int cf = 0; cf < 4; ++cf) { if (s6 < 4) a0[cf] = mfma16(bv[s6][cf], av[s6], a0[cf]); else a1[cf] = mfma16(bv[s6][cf], av[s6], a1[cf]); }
#pragma unroll
        for (int cf = 0; cf < 4; ++cf) { red[(wid * 4 + cf) * 64 + lane] = a0[cf]; red[2048 + (wid * 4 + cf) * 64 + lane] = a1[cf]; }
        __syncthreads();
        if (wid < 4) {
            f32x4 v0 = red[(0 * 4 + wid) * 64 + lane], v1 = red[2048 + (0 * 4 + wid) * 64 + lane];
#pragma unroll
            for (int w = 1; w < 8; ++w) { v0 += red[(w * 4 + wid) * 64 + lane]; v1 += red[2048 + (w * 4 + wid) * 64 + lane]; }
            const int row = RX + rt * 16 + fr, col = cg * 64 + wid * 16 + fq * 4;
            const f32x4 sr = ld4(gr + (size_t)row * 1024 + col), sa = ld4(ga + (size_t)row * 1024 + col);
            st4(z + (size_t)row * 1024 + col, sr * v0 + sa * v1);
        }
        __syncthreads();
    }
}

struct Mix {
    const bf16_t *q_r, *k_r, *kdF, *kdB, *v_rT, *g_r, *q_a, *k_a, *v_aT;
    bf16_t* states; bf16_t* ycat; const float* rd; const float* sink; int last;
};

DI bf16x8 ldsr8(const LAS unsigned char* p) { return *(const LAS bf16x8*)p; }
DI bf16x4 ldsr4(const LAS unsigned char* p) { return *(const LAS bf16x4*)p; }
DI bf16x8 pack8i(f32x4 a, f32x4 b) { u32x4 w; w.x = pk2(a[0], b[0]); w.y = pk2(a[1], b[1]); w.z = pk2(a[2], b[2]); w.w = pk2(a[3], b[3]); return __builtin_bit_cast(bf16x8, w); }

constexpr int ATT_KP = 208, ATT_VP = 800, ATT_VOFF = 400 * ATT_KP;
struct AttPre { bf16x8 k[7]; bf16x8 v[7]; };
template <bool DOK, bool DOV> DI void attn_prefetch(AttPre& R, const Mix& M, int t, int tid) {
    asm volatile("" : "+v"(tid));
    const int b = t & 7, qb = (t >> 3) & 15, g = t >> 7, s0 = qb * 128;
    if (DOK) {
#pragma unroll
    for (int i = 0; i < 7; ++i) {
        const int c = tid + 512 * i;
        if (c < 3200) {
            const int lk = c >> 3, c16 = c & 7;
            int row;
            if (lk < 384) { int sk = s0 - 128 + lk; sk = sk < 0 ? 0 : (sk > 2047 ? 2047 : sk); row = b * 2048 + sk; } else row = RX + b * 16 + (lk - 384);
            R.k[i] = ld8(M.k_a + (size_t)row * 128 + g * 64 + c16 * 8);
        }
    }
    }
    if (DOV) {
#pragma unroll
    for (int i = 0; i < 7; ++i) {
        const int c = tid + 512 * i;
        if (c < 3200) {
            const int e = c / 50, c16 = c - e * 50;
            int pp = (c16 < 48) ? (s0 + c16 * 8) : (112 + (c16 - 48) * 8);
            pp = pp > LP - 8 ? LP - 8 : pp;
            R.v[i] = ld8(M.v_aT + ((size_t)(b * 2 + g) * 64 + e) * LP + pp);
        }
    }
    }
}
DI void attn_commit(const AttPre& R, LAS unsigned char* lds, int tid) {
    asm volatile("" : "+v"(tid));
#pragma unroll
    for (int i = 0; i < 7; ++i) { const int c = tid + 512 * i; if (c < 3200) *(LAS bf16x8*)(lds + (c >> 3) * ATT_KP + (c & 7) * 16) = R.k[i]; }
#pragma unroll
    for (int i = 0; i < 7; ++i) { const int c = tid + 512 * i; if (c < 3200) { const int e = c / 50, c16 = c - e * 50; *(LAS bf16x8*)(lds + ATT_VOFF + e * ATT_VP + c16 * 16) = R.v[i]; } }
}
template <class Hook> DI void attn_wave(const Mix& M, const LAS unsigned char* lds, int b, int hq, int s0, int w, bf16x8 q0, bf16x8 q1, int lane, const Hook& hook) {
    asm volatile("" : "+v"(lane));
    const int fr = lane & 15, fq = lane >> 4;
    const int s = s0 + 16 * w + fr;
    const int rowq = (w >= 0) ? (b * 2048 + s) : (RX + b * 16 + fr);
    const int blk_lo = (w >= 0) ? (w >> 1) : 0;
    const LAS unsigned char* kb = lds + (32 * blk_lo + (fr >> 2) * 8 + 2 * (fr & 3)) * ATT_KP + fq * 16;
    f32x4 sa[9], sb[9], sm;
#pragma unroll
    for (int i0 = 0; i0 < 9; i0 += 3) {
        bf16x8 ka[3][2], kc[3][2];
#pragma unroll
        for (int u = 0; u < 3; ++u) {
            const int i = i0 + u;
            ka[u][0] = ldsr8(kb + i * 32 * ATT_KP); ka[u][1] = ldsr8(kb + i * 32 * ATT_KP + 64);
            kc[u][0] = ldsr8(kb + i * 32 * ATT_KP + ATT_KP); kc[u][1] = ldsr8(kb + i * 32 * ATT_KP + ATT_KP + 64);
        }
        SB();
#pragma unroll
        for (int u = 0; u < 3; ++u) {
            f32x4 a = {0.f, 0.f, 0.f, 0.f}, c = {0.f, 0.f, 0.f, 0.f};
            a = mfma16(ka[u][0], q0, a); a = mfma16(ka[u][1], q1, a);
            c = mfma16(kc[u][0], q0, c); c = mfma16(kc[u][1], q1, c);
            sa[i0 + u] = a; sb[i0 + u] = c;
        }
        SB();
    }
    {
        const LAS unsigned char* km = lds + (384 + fr) * ATT_KP + fq * 16;
        const bf16x8 k0 = ldsr8(km), k1 = ldsr8(km + 64);
        f32x4 a = {0.f, 0.f, 0.f, 0.f};
        a = mfma16(k0, q0, a); a = mfma16(k1, q1, a); sm = a;
    }
    const float sink = M.sink[hq];
    float mx = sink;
#pragma unroll
    for (int i = 0; i < 9; ++i)
#pragma unroll
        for (int jj = 0; jj < 4; ++jj) {
            const int ska = s0 - 128 + 32 * (blk_lo + i) + fq * 8 + 2 * jj; const int da = s - ska;
            const bool oka = (ska >= 0) && (ska < 2048) && (da <= 128) && (da >= -128);
            const bool okb = (ska + 1 >= 0) && (ska + 1 < 2048) && (da - 1 <= 128) && (da - 1 >= -128);
            const float va = oka ? sa[i][jj] : -1e30f, vb = okb ? sb[i][jj] : -1e30f;
            sa[i][jj] = va; sb[i][jj] = vb; mx = fmaxf(mx, fmaxf(va, vb));
        }
#pragma unroll
    for (int jj = 0; jj < 4; ++jj) mx = fmaxf(mx, sm[jj]);
    mx = fmaxf(mx, __shfl_xor(mx, 16)); mx = fmaxf(mx, __shfl_xor(mx, 32));
    float sum = 0.f;
    bf16x8 py[9], pym;
#pragma unroll
    for (int i = 0; i < 9; ++i) {
#pragma unroll
        for (int jj = 0; jj < 4; ++jj) { const float p0 = __expf(sa[i][jj] - mx), p1 = __expf(sb[i][jj] - mx); sa[i][jj] = p0; sb[i][jj] = p1; sum += p0 + p1; }
        py[i] = pack8i(sa[i], sb[i]);
    }
    {
#pragma unroll
        for (int jj = 0; jj < 4; ++jj) { const float p0 = __expf(sm[jj] - mx); sm[jj] = p0; sum += p0; }
        pym = pack8(sm, (f32x4){0.f, 0.f, 0.f, 0.f});
    }
    sum += __shfl_xor(sum, 16); sum += __shfl_xor(sum, 32);
    sum += __expf(sink - mx);
    SB(); hook(); SB();
    f32x4 o[4];
#pragma unroll
    for (int ef = 0; ef < 4; ++ef) o[ef] = (f32x4){0.f, 0.f, 0.f, 0.f};
    const LAS unsigned char* vb = lds + ATT_VOFF + fr * ATT_VP + (32 * blk_lo + fq * 8) * 2;
#pragma unroll
    for (int i0 = 0; i0 < 9; i0 += 3) {
        bf16x8 vx[3][4];
#pragma unroll
        for (int u = 0; u < 3; ++u)
#pragma unroll
            for (int ef = 0; ef < 4; ++ef) vx[u][ef] = ldsr8(vb + ef * 16 * ATT_VP + (i0 + u) * 64);
        SB();
#pragma unroll
        for (int u = 0; u < 3; ++u)
#pragma unroll
            for (int ef = 0; ef < 4; ++ef) o[ef] = mfma16(vx[u][ef], py[i0 + u], o[ef]);
        SB();
    }
    {
        const LAS unsigned char* vm = lds + ATT_VOFF + fr * ATT_VP + (384 + fq * 4) * 2;
        const bf16x4 z4 = {0, 0, 0, 0};
#pragma unroll
        for (int ef = 0; ef < 4; ++ef) o[ef] = mfma16(cat8(ldsr4(vm + ef * 16 * ATT_VP), z4), pym, o[ef]);
    }
    const float inv = 1.0f / sum;
#pragma unroll
    for (int ef = 0; ef < 4; ef += 2) st_pair16(M.ycat + (size_t)rowq * 1536 + 1024 + hq * 64 + ef * 16, o[ef] * inv, o[ef + 1] * inv, fq);
}
DI void attn_phase(const Mix& M, LAS unsigned char* lds, int first, int step, int count) {
    const int tid = otid(), wid = __builtin_amdgcn_readfirstlane(tid >> 6), lane = tid & 63, fr = lane & 15, fq = lane >> 4;
    AttPre R;
    if (count > 0) attn_prefetch<true, true>(R, M, first, tid);
    for (int k = 0; k < count; ++k) {
        const int t = first + k * step;
        const int b = t & 7, qb = (t >> 3) & 15, g = t >> 7;
        const int rowq = b * 2048 + qb * 128 + 16 * wid + fr;
        bf16x8 q[4][2];
#pragma unroll
        for (int hh = 0; hh < 4; ++hh) { q[hh][0] = ld8(M.q_a + (size_t)rowq * 512 + (g * 4 + hh) * 64 + fq * 8); q[hh][1] = ld8(M.q_a + (size_t)rowq * 512 + (g * 4 + hh) * 64 + 32 + fq * 8); }
        __syncthreads();
        attn_commit(R, lds, tid);
        __syncthreads();
        const bool more = (k + 1 < count);
        if (more) attn_prefetch<true, true>(R, M, t + step, tid);
#pragma unroll
        for (int hh = 0; hh < 4; ++hh) attn_wave(M, lds, b, g * 4 + hh, qb * 128, wid, q[hh][0], q[hh][1], lane, [] {});
        if (qb == 0 && wid < 4) {
            const int rowm = RX + b * 16 + fr; const int hq = g * 4 + wid;
            const bf16x8 m0 = ld8(M.q_a + (size_t)rowm * 512 + hq * 64 + fq * 8), m1 = ld8(M.q_a + (size_t)rowm * 512 + hq * 64 + 32 + fq * 8);
            attn_wave(M, lds, b, hq, 0, -1, m0, m1, lane, [] {});
        }
    }
    __syncthreads();
}

constexpr int SC_P = 288, SC_KB = 64 * SC_P, SC_BUF = SC_KB + 64 * SC_P;
static_assert(2 * SC_BUF <= LDS_MAIN, "lds");
struct ScanPre { bf16x8 k[2]; bf16x8 v[2]; };
DI void scan_prefetch(ScanPre& R, const bf16_t* kd, const bf16_t* vt, int n, int tid) {
    asm volatile("" : "+v"(tid));
#pragma unroll
    for (int i = 0; i < 2; ++i) { const int c = tid + 512 * i; R.k[i] = ld8(kd + (size_t)(c >> 4) * LP + 128 * n + (c & 15) * 8); R.v[i] = ld8(vt + (size_t)(c >> 4) * LP + 128 * n + (c & 15) * 8); }
}
DI void scan_commit(const ScanPre& R, LAS unsigned char* buf, int tid) {
    asm volatile("" : "+v"(tid));
#pragma unroll
    for (int i = 0; i < 2; ++i) { const int c = tid + 512 * i; *(LAS bf16x8*)(buf + (c >> 4) * SC_P + (c & 15) * 16) = R.k[i]; *(LAS bf16x8*)(buf + SC_KB + (c >> 4) * SC_P + (c & 15) * 16) = R.v[i]; }
}
DI void scan_block(const Mix& M, LAS unsigned char* lds, int item) {
    const int tid = otid(), wid = __builtin_amdgcn_readfirstlane(tid >> 6), lane = tid & 63, fr = lane & 15, fq = lane >> 4;
    const int xq = item & 7, yq = item >> 3;
    const int eh = yq & 1, dir = (yq >> 1) & 1, bh = (yq >> 2) * 8 + xq, h = bh & 7;
    const int efl = wid & 3, dh = wid >> 2;
    const bf16_t* kd = (dir ? M.kdB : M.kdF) + (size_t)bh * 64 * LP;
    const bf16_t* vt = M.v_rT + ((size_t)bh * 128 + eh * 64) * LP;
    const float lg = -__expf(M.rd[dir * 8 + h]); const float gC = __expf(lg * 128.0f);
    bf16_t* sbase = M.states + (((size_t)bh * NCH) * 2 + dir) * 128 * 64 + (size_t)(eh * 64 + efl * 16 + fr) * 64 + dh * 32 + fq * 4;
    f32x4 acc[2];
#pragma unroll
    for (int df = 0; df < 2; ++df) acc[df] = (f32x4){0.f, 0.f, 0.f, 0.f};
    ScanPre ring[4];
#pragma unroll
    for (int s0 = 0; s0 < 4; ++s0) scan_prefetch(ring[s0], kd, vt, dir ? (16 - s0) : s0, tid);
    __syncthreads();
#pragma unroll
    for (int s = 0; s < 16; ++s) {
        LAS unsigned char* buf = lds + (s & 1) * SC_BUF;
        scan_commit(ring[s & 3], buf, tid);
        if (s + 4 < 16) scan_prefetch(ring[s & 3], kd, vt, dir ? (16 - (s + 4)) : (s + 4), tid);
        __syncthreads();
        const int n = dir ? (16 - s) : s;
        bf16_t* sp = sbase + (size_t)n * 2 * 128 * 64;
        st_pair16(sp - fq * 4, acc[0], acc[1], fq);
#pragma unroll
        for (int df = 0; df < 2; ++df) acc[df] *= gC;
        const LAS unsigned char* kp = buf + (dh * 32 + fr) * SC_P + fq * 16;
        const LAS unsigned char* vp = buf + SC_KB + (efl * 16 + fr) * SC_P + fq * 16;
        bf16x8 vy[4], kx[4][2];
#pragma unroll
        for (int ks = 0; ks < 4; ++ks) { vy[ks] = ldsr8(vp + ks * 64);
#pragma unroll
            for (int df = 0; df < 2; ++df) kx[ks][df] = ldsr8(kp + df * 16 * SC_P + ks * 64); }
        SB();
#pragma unroll
        for (int ks = 0; ks < 4; ++ks)
#pragma unroll
            for (int df = 0; df < 2; ++df) acc[df] = mfma16(kx[ks][df], vy[ks], acc[df]);
        SB();
    }
    {
        bf16_t* sp = sbase + (size_t)(dir ? 0 : 16) * 2 * 128 * 64;
        st_pair16(sp - fq * 4, acc[0], acc[1], fq);
    }
    __syncthreads();
}

DI void ret_item(const Mix& M, int b, int h, int n, int iq) {
    const int lane = otid() & 63, fr = lane & 15, fq = lane >> 4;
    const int i = 16 * iq + fr;
    const int rowq = n ? (b * 2048 + (n - 1) * 128 + i) : (RX + b * 16 + (i - 112));
    bf16x8 qy[2];
#pragma unroll
    for (int ks = 0; ks < 2; ++ks) qy[ks] = ld8(M.q_r + (size_t)rowq * 512 + h * 64 + ks * 32 + fq * 8);
    const float lgf = -__expf(M.rd[h]), lgb = -__expf(M.rd[8 + h]);
    const float cf = __expf(lgf * (float)(i + 1)), cb = __expf(lgb * (float)(128 - i));
    const bf16_t* SF = M.states + (((size_t)(b * 8 + h) * NCH + n) * 2 + 0) * 128 * 64 + (size_t)fr * 64 + fq * 8;
    const bf16_t* SBk = SF + 128 * 64;
    const bf16_t* vbase = M.v_rT + ((size_t)(b * 8 + h) * 128 + fr) * LP + 128 * n + fq * 4;
    bf16x8 sfx[8][2], kx[8][2];
#pragma unroll
    for (int ef = 0; ef < 8; ++ef)
#pragma unroll
        for (int ks = 0; ks < 2; ++ks) sfx[ef][ks] = ld8(SF + (size_t)ef * 16 * 64 + ks * 32);
#pragma unroll
    for (int jf = 0; jf < 8; ++jf) {
        const int j = 16 * jf + fr;
        int jm = j - 112; jm = jm < 0 ? 0 : jm;
        const int rowk = n ? (b * 2048 + (n - 1) * 128 + j) : (RX + b * 16 + jm);
        const bf16_t* kp = M.k_r + (size_t)rowk * 512 + h * 64 + fq * 8;
        kx[jf][0] = ld8(kp); kx[jf][1] = ld8(kp + 32);
    }
    SB();
    f32x4 o[8];
#pragma unroll
    for (int ef = 0; ef < 8; ++ef) {
        f32x4 t = {0.f, 0.f, 0.f, 0.f};
        t = mfma16(sfx[ef][0], qy[0], t); t = mfma16(sfx[ef][1], qy[1], t);
        o[ef] = t * cf;
    }
    f32x4 st[8];
#pragma unroll
    for (int jf = 0; jf < 8; ++jf) {
        f32x4 t = {0.f, 0.f, 0.f, 0.f};
        t = mfma16(kx[jf][0], qy[0], t); t = mfma16(kx[jf][1], qy[1], t);
        st[jf] = t;
    }
    SB();
    bf16x8 sbx[8][2];
#pragma unroll
    for (int ef = 0; ef < 8; ++ef)
#pragma unroll
        for (int ks = 0; ks < 2; ++ks) sbx[ef][ks] = ld8(SBk + (size_t)ef * 16 * 64 + ks * 32);
    bf16x4 va[2][8][2];
#pragma unroll
    for (int pr = 0; pr < 2; ++pr)
#pragma unroll
        for (int ef = 0; ef < 8; ++ef) { va[pr][ef][0] = ld4s(vbase + (size_t)ef * 16 * LP + 32 * pr); va[pr][ef][1] = ld4s(vbase + (size_t)ef * 16 * LP + 32 * pr + 16); }
    SB();
#pragma unroll
    for (int ef = 0; ef < 8; ++ef) {
        f32x4 t = {0.f, 0.f, 0.f, 0.f};
        t = mfma16(sbx[ef][0], qy[0], t); t = mfma16(sbx[ef][1], qy[1], t);
        o[ef] += t * cb;
    }
    bf16x8 py[4];
#pragma unroll
    for (int pr = 0; pr < 4; ++pr) {
#pragma unroll
        for (int hh = 0; hh < 2; ++hh) {
            const int jf = 2 * pr + hh;
#pragma unroll
            for (int jj = 0; jj < 4; ++jj) {
                const int jv = 16 * jf + fq * 4 + jj; const int d = i - jv;
                float w = (d >= 0) ? __expf(lgf * (float)d) : __expf(lgb * (float)(-d));
                if (n == 0 && jv < 112) w = 0.f;
                st[jf][jj] *= w;
            }
        }
        py[pr] = pack8(st[2 * pr], st[2 * pr + 1]);
    }
    SB();
    bf16x4 vb[2][8][2];
#pragma unroll
    for (int pr = 0; pr < 2; ++pr)
#pragma unroll
        for (int ef = 0; ef < 8; ++ef) { vb[pr][ef][0] = ld4s(vbase + (size_t)ef * 16 * LP + 32 * (pr + 2)); vb[pr][ef][1] = ld4s(vbase + (size_t)ef * 16 * LP + 32 * (pr + 2) + 16); }
    u32x2 gx[8];
#pragma unroll
    for (int ef = 0; ef < 8; ++ef) gx[ef] = *(const u32x2*)(M.g_r + (size_t)rowq * 1024 + h * 128 + ef * 16 + fq * 4);
    SB();
#pragma unroll
    for (int pr = 0; pr < 2; ++pr)
#pragma unroll
        for (int ef = 0; ef < 8; ++ef) o[ef] = mfma16(cat8(va[pr][ef][0], va[pr][ef][1]), py[pr], o[ef]);
#pragma unroll
    for (int pr = 0; pr < 2; ++pr)
#pragma unroll
        for (int ef = 0; ef < 8; ++ef) o[ef] = mfma16(cat8(vb[pr][ef][0], vb[pr][ef][1]), py[pr + 2], o[ef]);
    float s = 0.f;
#pragma unroll
    for (int ef = 0; ef < 8; ++ef) s += (o[ef][0] + o[ef][1]) + (o[ef][2] + o[ef][3]);
    s += __shfl_xor(s, 16); s += __shfl_xor(s, 32);
    const float mean = s * (1.0f / 128.0f);
    float q = 0.f;
#pragma unroll
    for (int ef = 0; ef < 8; ++ef) { const f32x4 d = o[ef] - mean; q += (d[0] * d[0] + d[1] * d[1]) + (d[2] * d[2] + d[3] * d[3]); }
    q += __shfl_xor(q, 16); q += __shfl_xor(q, 32);
    const float rstd = rsqrtf(q * (1.0f / 128.0f) + EPS);
#pragma unroll
    for (int ef = 0; ef < 8; ++ef) {
        f32x4 gv; gv[0] = __uint_as_float(gx[ef].x << 16); gv[1] = __uint_as_float(gx[ef].x & 0xffff0000u); gv[2] = __uint_as_float(gx[ef].y << 16); gv[3] = __uint_as_float(gx[ef].y & 0xffff0000u);
        st4(M.ycat + (size_t)rowq * 1536 + h * 128 + ef * 16 + fq * 4, (o[ef] - mean) * rstd * gv);
    }
}

constexpr int RET_KP = 208, RET_SP = 160, RET_VP = 288;
constexpr int RET_SFOFF = 128 * RET_KP, RET_SBOFF = RET_SFOFF + 128 * RET_SP, RET_VOFF = RET_SBOFF + 128 * RET_SP;
static_assert(RET_VOFF + 128 * RET_VP <= LDS_MAIN, "lds");
struct RetPre { bf16x8 k[2], sf[2], sb[2], v[4], q[2]; };
DI void ret_decode(int t, int& bh, int& n) { if (t < 1024) { n = (t & 15) + 1; bh = t >> 4; } else { n = 0; bh = t - 1024; } }
DI void ret_prefetch(RetPre& R, const Mix& M, int t, int tid) {
    asm volatile("" : "+v"(tid));
    int bh, n; ret_decode(t, bh, n);
    const int b = bh >> 3, h = bh & 7;
    const int wid = tid >> 6, lane = tid & 63, fr = lane & 15, fq = lane >> 4;
    const bf16_t* SF = M.states + (((size_t)bh * NCH + n) * 2 + 0) * 128 * 64;
#pragma unroll
    for (int i = 0; i < 2; ++i) {
        const int c = tid + 512 * i; const int j = c >> 3;
        int jm = j - 112; jm = jm < 0 ? 0 : jm;
        const int rowk = n ? (b * 2048 + (n - 1) * 128 + j) : (RX + b * 16 + jm);
        R.k[i] = ld8(M.k_r + (size_t)rowk * 512 + h * 64 + (c & 7) * 8);
        R.sf[i] = ld8(SF + (size_t)c * 8); R.sb[i] = ld8(SF + 128 * 64 + (size_t)c * 8);
    }
#pragma unroll
    for (int i = 0; i < 4; ++i) { const int c = tid + 512 * i; R.v[i] = ld8(M.v_rT + ((size_t)bh * 128 + (c >> 4)) * LP + 128 * n + (c & 15) * 8); }
    const int rowq = n ? (b * 2048 + (n - 1) * 128 + 16 * wid + fr) : (RX + b * 16 + fr);
    R.q[0] = ld8(M.q_r + (size_t)rowq * 512 + h * 64 + fq * 8); R.q[1] = ld8(M.q_r + (size_t)rowq * 512 + h * 64 + 32 + fq * 8);
}
DI void ret_commit(const RetPre& R, LAS unsigned char* lds, int tid) {
    asm volatile("" : "+v"(tid));
#pragma unroll
    for (int i = 0; i < 2; ++i) {
        const int c = tid + 512 * i;
        *(LAS bf16x8*)(lds + (c >> 3) * RET_KP + (c & 7) * 16) = R.k[i];
        *(LAS bf16x8*)(lds + RET_SFOFF + (c >> 3) * RET_SP + (c & 7) * 16) = R.sf[i];
        *(LAS bf16x8*)(lds + RET_SBOFF + (c >> 3) * RET_SP + (c & 7) * 16) = R.sb[i];
    }
#pragma unroll
    for (int i = 0; i < 4; ++i) { const int c = tid + 512 * i; *(LAS bf16x8*)(lds + RET_VOFF + (c >> 4) * RET_VP + (c & 15) * 16) = R.v[i]; }
}
DI void ret_wave(const Mix& M, const LAS unsigned char* lds, int b, int h, int n, int w, bf16x8 q0, bf16x8 q1, int lane) {
    asm volatile("" : "+v"(lane));
    const int fr = lane & 15, fq = lane >> 4;
    if (n == 0 && w != 7) return;
    const int i = 16 * w + fr;
    const int rowq = n ? (b * 2048 + (n - 1) * 128 + i) : (RX + b * 16 + fr);
    u32x2 gx[8];
#pragma unroll
    for (int ef = 0; ef < 8; ++ef) gx[ef] = *(const u32x2*)(M.g_r + (size_t)rowq * 1024 + h * 128 + ef * 16 + fq * 4);
    const float lgf = -__expf(M.rd[h]), lgb = -__expf(M.rd[8 + h]);
    const float cf = __expf(lgf * (float)(i + 1)), cb = __expf(lgb * (float)(128 - i));
    f32x4 o[8];
    const LAS unsigned char* sfp = lds + RET_SFOFF + fr * RET_SP + fq * 16;
    const LAS unsigned char* sbp = lds + RET_SBOFF + fr * RET_SP + fq * 16;
#pragma unroll
    for (int e0 = 0; e0 < 8; e0 += 4) {
        bf16x8 xf[4][2], xb[4][2];
#pragma unroll
        for (int u = 0; u < 4; ++u) { const int ef = e0 + u;
            xf[u][0] = ldsr8(sfp + ef * 16 * RET_SP); xf[u][1] = ldsr8(sfp + ef * 16 * RET_SP + 64);
            xb[u][0] = ldsr8(sbp + ef * 16 * RET_SP); xb[u][1] = ldsr8(sbp + ef * 16 * RET_SP + 64); }
        SB();
#pragma unroll
        for (int u = 0; u < 4; ++u) {
            f32x4 t = {0.f, 0.f, 0.f, 0.f}, t2 = {0.f, 0.f, 0.f, 0.f};
            t = mfma16(xf[u][0], q0, t); t = mfma16(xf[u][1], q1, t);
            t2 = mfma16(xb[u][0], q0, t2); t2 = mfma16(xb[u][1], q1, t2);
            o[e0 + u] = t * cf + t2 * cb;
        }
        SB();
    }
    const LAS unsigned char* kb = lds + ((fr >> 2) * 8 + 2 * (fr & 3)) * RET_KP + fq * 16;
    bf16x8 py[4];
    bf16x8 kxa[4][2], kxc[4][2];
#pragma unroll
    for (int blk = 0; blk < 4; ++blk) {
        kxa[blk][0] = ldsr8(kb + blk * 32 * RET_KP); kxa[blk][1] = ldsr8(kb + blk * 32 * RET_KP + 64);
        kxc[blk][0] = ldsr8(kb + blk * 32 * RET_KP + RET_KP); kxc[blk][1] = ldsr8(kb + blk * 32 * RET_KP + RET_KP + 64);
    }
    SB();
#pragma unroll
    for (int blk = 0; blk < 4; ++blk) {
        f32x4 a = {0.f, 0.f, 0.f, 0.f}, c = {0.f, 0.f, 0.f, 0.f};
        a = mfma16(kxa[blk][0], q0, a); a = mfma16(kxa[blk][1], q1, a);
        c = mfma16(kxc[blk][0], q0, c); c = mfma16(kxc[blk][1], q1, c);
#pragma unroll
        for (int jj = 0; jj < 4; ++jj) {
            const int ja = 32 * blk + fq * 8 + 2 * jj; const int da = i - ja, db = da - 1;
            float wa = (da >= 0) ? __expf(lgf * (float)da) : __expf(lgb * (float)(-da));
            float wb = (db >= 0) ? __expf(lgf * (float)db) : __expf(lgb * (float)(-db));
            if (n == 0) { if (ja < 112) wa = 0.f; if (ja + 1 < 112) wb = 0.f; }
            a[jj] *= wa; c[jj] *= wb;
        }
        py[blk] = pack8i(a, c);
    }
    const LAS unsigned char* vp = lds + RET_VOFF + fr * RET_VP + fq * 16;
    SB();
#pragma unroll
    for (int blk = 0; blk < 4; blk += 2) {
        bf16x8 vx[2][8];
#pragma unroll
        for (int u = 0; u < 2; ++u)
#pragma unroll
            for (int ef = 0; ef < 8; ++ef) vx[u][ef] = ldsr8(vp + ef * 16 * RET_VP + (blk + u) * 64);
        SB();
#pragma unroll
        for (int u = 0; u < 2; ++u)
#pragma unroll
            for (int ef = 0; ef < 8; ++ef) o[ef] = mfma16(vx[u][ef], py[blk + u], o[ef]);
        SB();
    }
    float s = 0.f;
#pragma unroll
    for (int ef = 0; ef < 8; ++ef) s += (o[ef][0] + o[ef][1]) + (o[ef][2] + o[ef][3]);
    s += __shfl_xor(s, 16); s += __shfl_xor(s, 32);
    const float mean = s * (1.0f / 128.0f);
    float q = 0.f;
#pragma unroll
    for (int ef = 0; ef < 8; ++ef) { const f32x4 d = o[ef] - mean; q += (d[0] * d[0] + d[1] * d[1]) + (d[2] * d[2] + d[3] * d[3]); }
    q += __shfl_xor(q, 16); q += __shfl_xor(q, 32);
    const float rstd = rsqrtf(q * (1.0f / 128.0f) + EPS);
#pragma unroll
    for (int ef = 0; ef < 8; ef += 2) {
        f32x4 gv, gw;
        gv[0] = __uint_as_float(gx[ef].x << 16); gv[1] = __uint_as_float(gx[ef].x & 0xffff0000u); gv[2] = __uint_as_float(gx[ef].y << 16); gv[3] = __uint_as_float(gx[ef].y & 0xffff0000u);
        gw[0] = __uint_as_float(gx[ef + 1].x << 16); gw[1] = __uint_as_float(gx[ef + 1].x & 0xffff0000u); gw[2] = __uint_as_float(gx[ef + 1].y << 16); gw[3] = __uint_as_float(gx[ef + 1].y & 0xffff0000u);
        st_pair16(M.ycat + (size_t)rowq * 1536 + h * 128 + ef * 16, (o[ef] - mean) * rstd * gv, (o[ef + 1] - mean) * rstd * gw, fq);
    }
}
DI void ret_phase(const Mix& M, LAS unsigned char* lds) {
    const int tid = otid(), wid = __builtin_amdgcn_readfirstlane(tid >> 6), lane = tid & 63;
    const int G = gridDim.x;
    const int NIT = M.last ? 1024 : 1088;
    int t = blockIdx.x;
    RetPre R;
    if (t < NIT) ret_prefetch(R, M, t, tid);
    for (; t < NIT; t += G) {
        __syncthreads();
        ret_commit(R, lds, tid);
        const bf16x8 q0 = R.q[0], q1 = R.q[1];
        __syncthreads();
        if (t + G < NIT) ret_prefetch(R, M, t + G, tid);
        int bh, n; ret_decode(t, bh, n);
        ret_wave(M, lds, bh >> 3, bh & 7, n, wid, q0, q1, lane);
    }
    __syncthreads();
}

DI bf16_t* hrow(const Params& P, int row) { return (bf16_t*)(P.ws + WS_ST) + (size_t)row * 1024; }
template <int NB>
DI void rowpass_rows(const Params& P, const bf16_t* t, const float* gpost, const float* gpre, float* rs, int row0, int rstride, int lane) {
    f32x4 hv[NB][4]; u32x2 tr[NB][4], hr[NB][4];
#pragma unroll
    for (int r = 0; r < NB; ++r) {
        const int row = row0 + r * rstride;
        const bf16_t* hp = hrow(P, row); const bf16_t* tp = t + (size_t)row * 1024;
#pragma unroll
        for (int k = 0; k < 4; ++k) { tr[r][k] = *(const u32x2*)(tp + (k * 64 + lane) * 4); hr[r][k] = *(const u32x2*)(hp + (k * 64 + lane) * 4); }
    }
    f32x4 gp[4];
#pragma unroll
    for (int k = 0; k < 4; ++k) gp[k] = *(const f32x4*)(gpost + (k * 64 + lane) * 4);
    SB();
    float s2[NB];
#pragma unroll
    for (int r = 0; r < NB; ++r) {
        f32x4 tv[4]; float ss = 0.f;
#pragma unroll
        for (int k = 0; k < 4; ++k) {
            tv[k][0] = __uint_as_float(tr[r][k].x << 16); tv[k][1] = __uint_as_float(tr[r][k].x & 0xffff0000u); tv[k][2] = __uint_as_float(tr[r][k].y << 16); tv[k][3] = __uint_as_float(tr[r][k].y & 0xffff0000u);
            hv[r][k][0] = __uint_as_float(hr[r][k].x << 16); hv[r][k][1] = __uint_as_float(hr[r][k].x & 0xffff0000u); hv[r][k][2] = __uint_as_float(hr[r][k].y << 16); hv[r][k][3] = __uint_as_float(hr[r][k].y & 0xffff0000u);
            ss += (tv[k][0] * tv[k][0] + tv[k][1] * tv[k][1]) + (tv[k][2] * tv[k][2] + tv[k][3] * tv[k][3]);
        }
        ss = wsum(ss);
        const float sc = rsqrtf(ss * (1.0f / 1024.0f) + EPS);
        const int row = row0 + r * rstride;
        bf16_t* hp = hrow(P, row);
        float q = 0.f;
#pragma unroll
        for (int k = 0; k < 4; ++k) { hv[r][k] += tv[k] * sc * gp[k];
            if (gpre) st4(hp + (k * 64 + lane) * 4, hv[r][k]); else if (row < RX) *(f32x4*)(P.out + (size_t)row * 1024 + (k * 64 + lane) * 4) = hv[r][k];
            q += (hv[r][k][0] * hv[r][k][0] + hv[r][k][1] * hv[r][k][1]) + (hv[r][k][2] * hv[r][k][2] + hv[r][k][3] * hv[r][k][3]); }
        s2[r] = q;
    }
    if (gpre) {
#pragma unroll
        for (int r = 0; r < NB; ++r) {
            const float sc2 = rsqrtf(wsum(s2[r]) * (1.0f / 1024.0f) + EPS);
            if (lane == 0) rs[row0 + r * rstride] = sc2;
        }
    }
}
DI void rowpass(const Params& P, const bf16_t* t, const float* gpost, const float* gpre, float* u, int gw, int nw) {
    const int lane = otid() & 63;
    for (int base = gw; base < RX; base += nw * 4) {
        if (base + 3 * nw < RX) rowpass_rows<4>(P, t, gpost, gpre, u, base, nw, lane);
        else for (int row = base; row < RX; row += nw) rowpass_rows<1>(P, t, gpost, gpre, u, row, 0, lane);
    }
    for (int row = RX + gw; row < RT; row += nw) rowpass_rows<1>(P, t, gpost, gpre, u, row, 0, lane);
}
DI void rowinit(const Params& P, float* rs, int gw, int nw) {
    const int lane = otid() & 63;
    for (int row = gw; row < RT; row += nw) {
        bf16_t* hp = hrow(P, row);
        const float* src = row < RX ? P.x + (size_t)row * 1024 : P.meta + (size_t)((row - RX) & 15) * 1024;
        f32x4 hv[4]; float s2 = 0.f;
#pragma unroll
        for (int k = 0; k < 4; ++k) hv[k] = *(const f32x4*)(src + (k * 64 + lane) * 4);
        SB();
#pragma unroll
        for (int k = 0; k < 4; ++k) { st4(hp + (k * 64 + lane) * 4, hv[k]);
            s2 += (hv[k][0] * hv[k][0] + hv[k][1] * hv[k][1]) + (hv[k][2] * hv[k][2] + hv[k][3] * hv[k][3]); }
        s2 = wsum(s2);
        if (lane == 0) rs[row] = rsqrtf(s2 * (1.0f / 1024.0f) + EPS);
    }
}

DI int perm64(int mode, int w) { return mode == 1 ? ((w >> 1) + 32 * (w & 1)) : (mode == 2 ? (w < 16 ? ((w >> 1) + 8 * (w & 1)) : w) : w); }
struct ConvJob { const float* W; bf16_t* Bt; const float* gain; int ncols, k0, n0, ldb, koff, mode; };
DI ConvJob conv_decode(const Params& P, int l, int job) {
    unsigned char* wb = P.ws + WS_W;
    ConvJob J; int j = job; J.gain = nullptr;
    if (j < 1472) { J.gain = P.n_mix_pre + l * 1024; const int nt = j % 92, kt = j / 92; const int c0 = nt * 64;
        J.W = P.w_in + (size_t)l * 1024 * DIN; J.ncols = DIN; J.k0 = kt * 64; J.n0 = c0; J.Bt = (bf16_t*)(wb + W_IN); J.ldb = 1024; J.koff = 0;
        J.mode = c0 < 1024 ? 1 : ((c0 >= 3072 && c0 < 3712) ? 2 : 0); return J; }
    j -= 1472; J.mode = 0; J.koff = 0; J.ncols = 1024;
    if (j < 256) { J.W = P.w_ret_o + (size_t)l * 1024 * 1024; J.k0 = (j >> 4) * 64; J.n0 = (j & 15) * 64; J.Bt = (bf16_t*)(wb + W_CAT); J.ldb = 1536; return J; }
    j -= 256;
    if (j < 128) { J.W = P.w_att_o + (size_t)l * 512 * 1024; J.k0 = (j >> 4) * 64; J.n0 = (j & 15) * 64; J.Bt = (bf16_t*)(wb + W_CAT); J.ldb = 1536; J.koff = 1024; return J; }
    j -= 128;
    if (j < 256) { J.W = P.w_mix_o + (size_t)l * 1024 * 1024; J.k0 = (j >> 4) * 64; J.n0 = (j & 15) * 64; J.Bt = (bf16_t*)(wb + W_MIX); J.ldb = 1024; return J; }
    j -= 256;
    if (j < 1024) { J.gain = P.n_ff_pre + l * 1024; J.W = P.w_ff1 + (size_t)l * 1024 * 4096; J.ncols = 4096; J.k0 = (j >> 6) * 64; J.n0 = (j & 63) * 64; J.Bt = (bf16_t*)(wb + W_FF1); J.ldb = 1024; return J; }
    j -= 1024;
    J.W = P.w_ff2 + (size_t)l * 4096 * 1024; J.k0 = (j >> 4) * 64; J.n0 = (j & 15) * 64; J.Bt = (bf16_t*)(wb + W_FF2); J.ldb = 4096; return J;
}
DI void convert_weights(const Params& P, int l, LAS unsigned char* lds) {
    LAS float* tiles = (LAS float*)lds;
    const int t = otid();
    const int G = gridDim.x;
    for (int base = blockIdx.x; base < 4160; base += 4 * G) {
        ConvJob J[4]; f32x4 v[4][2];
#pragma unroll
        for (int q = 0; q < 4; ++q) {
            const int job = base + q * G;
            if (job < 4160) {
                J[q] = conv_decode(P, l, job);
#pragma unroll
                for (int rep = 0; rep < 2; ++rep) { const int kk = (t >> 4) + 32 * rep, nn = (t & 15) * 4; v[q][rep] = *(const f32x4*)(J[q].W + (size_t)(J[q].k0 + kk) * J[q].ncols + J[q].n0 + nn);
                    if (J[q].gain) v[q][rep] *= J[q].gain[J[q].k0 + kk]; }
            }
        }
        SB();
#pragma unroll
        for (int q = 0; q < 4; ++q) {
            if (base + q * G < 4160) {
                LAS float* tile = tiles + q * 4160;
#pragma unroll
                for (int rep = 0; rep < 2; ++rep) { const int kk = (t >> 4) + 32 * rep, nn = (t & 15) * 4;
                    tile[kk * 65 + nn] = v[q][rep][0]; tile[kk * 65 + nn + 1] = v[q][rep][1]; tile[kk * 65 + nn + 2] = v[q][rep][2]; tile[kk * 65 + nn + 3] = v[q][rep][3]; }
            }
        }
        __syncthreads();
#pragma unroll
        for (int q = 0; q < 4; ++q) {
            if (base + q * G < 4160) {
                const LAS float* tile = tiles + q * 4160;
                const int nq = t >> 3, kk8 = (t & 7) * 8, sc = perm64(J[q].mode, nq);
                u32x4 w;
                w.x = pk2(tile[(kk8 + 0) * 65 + sc], tile[(kk8 + 1) * 65 + sc]); w.y = pk2(tile[(kk8 + 2) * 65 + sc], tile[(kk8 + 3) * 65 + sc]);
                w.z = pk2(tile[(kk8 + 4) * 65 + sc], tile[(kk8 + 5) * 65 + sc]); w.w = pk2(tile[(kk8 + 6) * 65 + sc], tile[(kk8 + 7) * 65 + sc]);
                *(u32x4*)(J[q].Bt + (size_t)(J[q].n0 + nq) * J[q].ldb + J[q].koff + J[q].k0 + kk8) = w;
            }
        }
        __syncthreads();
    }
}

DI void make_tables(const Params& P) {
    float* tabR = (float*)(P.ws + WS_TABR); float* tabA = (float*)(P.ws + WS_TABA);
    const int gt = blockIdx.x * blockDim.x + otid(), nth = gridDim.x * blockDim.x;
    for (int idx = gt; idx < 2064 * 40; idx += nth) {
        int p, i; float fr; float* dst;
        if (idx < 2064 * 32) { p = idx >> 5; i = idx & 31; fr = powf(10000.0f, -(float)(2 * i) / 64.0f); dst = tabR + (size_t)idx * 2; }
        else { const int k = idx - 2064 * 32; p = k >> 3; i = k & 7; fr = powf(500000.0f, -(float)(2 * i) / 16.0f); dst = tabA + (size_t)k * 2; }
        const float ang = (float)p * fr;
        double rev = (double)ang * 0.15915494309189533576888; rev -= floor(rev);
        const float r = (float)(rev * 6.283185307179586476925);
        dst[0] = __cosf(r); dst[1] = __sinf(r);
    }
}
DI void zero_pads(const Params& P) {
    unsigned char* proj = P.ws + WS_PROJ;
    const int gt = blockIdx.x * blockDim.x + otid(), nth = gridDim.x * blockDim.x;
    const u32x4 z = {0u, 0u, 0u, 0u};
    for (int idx = gt; idx < 17408 * 14; idx += nth) {
        int r = idx / 14; const int c = idx - r * 14;
        bf16_t* base;
        if (r < 4096) base = (bf16_t*)(proj + P_KDF); else if (r < 8192) { base = (bf16_t*)(proj + P_KDB); r -= 4096; }
        else if (r < 16384) { base = (bf16_t*)(proj + P_VRT); r -= 8192; } else { base = (bf16_t*)(proj + P_VAT); r -= 16384; }
        *(u32x4*)(base + (size_t)r * LP + c * 8) = z;
    }
}

#define XB_TMO      128
#define XB_XCNT(j)  (256  + 64 * (j))
#define XB_XSUB(j)  (1280 + 64 * (j))
#define XB_XGEN(j)  (2304 + 64 * (j))
#define XB_TOP      3328
#define XB_TOPGEN   3392
#define XCD_BAR_WORDS 3456
#define XB_SPIN_CAP (1u << 22)
DI unsigned xb_ld(unsigned* p)              { return __hip_atomic_load(p, __ATOMIC_RELAXED, __HIP_MEMORY_SCOPE_AGENT); }
DI unsigned xb_add(unsigned* p, unsigned v) { return __hip_atomic_fetch_add(p, v, __ATOMIC_RELAXED, __HIP_MEMORY_SCOPE_AGENT); }
DI unsigned xb_xcc_id() { return (unsigned)__builtin_amdgcn_s_getreg((3 << 11) | 20) & 0xFu; }
#define XB_SPIN(cond, bar) do { unsigned _sp = 0; while (cond) { __builtin_amdgcn_s_sleep(1); \
    if ((++_sp & 255u) == 0u) { if (xb_ld(&(bar)[XB_TMO])) break; if (_sp > XB_SPIN_CAP) { atomicAdd(&(bar)[XB_TMO], 1u); break; } } } } while (0)
struct XcdBarrier { unsigned* bar; unsigned x; volatile LAS unsigned* st; };
DI XcdBarrier xcd_barrier_post(unsigned* bar, volatile LAS unsigned* st) {
    XcdBarrier b; b.bar = bar; b.x = xb_xcc_id(); b.st = st;
    if (threadIdx.x == 0) (void)xb_add(&bar[XB_XCNT(b.x)], 1u);
    return b;
}
DI void xcd_barrier_complete(unsigned* bar, unsigned x, unsigned& nloc, unsigned& nx) {
    const unsigned G = gridDim.x * gridDim.y * gridDim.z;
    unsigned sum, cnt, mine, sp = 0u;
    for (;;) {
        sum = 0u; cnt = 0u; mine = 0u;
#pragma unroll
        for (unsigned j = 0; j < 16; ++j) { const unsigned c = xb_ld(&bar[XB_XCNT(j)]); sum += c; cnt += (c > 0u) ? 1u : 0u; mine = (j == x) ? c : mine; }
        if (sum == G) break;
        __builtin_amdgcn_s_sleep(1);
        if ((++sp & 255u) == 0u) { if (xb_ld(&bar[XB_TMO])) break; if (sp > XB_SPIN_CAP) { atomicAdd(&bar[XB_TMO], 1u); break; } }
    }
    nloc = mine > 0u ? mine : 1u; nx = cnt > 0u ? cnt : 1u;
}
DI void xcd_barrier(const XcdBarrier& b) {
    asm volatile("s_waitcnt vmcnt(0)" ::: "memory");
    __syncthreads();
    if (threadIdx.x == 0) {
        unsigned* bar = b.bar;
        __builtin_amdgcn_s_waitcnt(0);
        unsigned nloc = b.st[0], nx = b.st[1];
        if (nloc == 0u) { xcd_barrier_complete(bar, b.x, nloc, nx); b.st[0] = nloc; b.st[1] = nx; }
        const unsigned old = xb_add(&bar[XB_XSUB(b.x)], 1u);
        const unsigned gen = old / nloc;
        if (old + 1u == (gen + 1u) * nloc) {
            __builtin_amdgcn_fence(__ATOMIC_RELEASE, "agent");
            asm volatile("s_waitcnt vmcnt(0)" ::: "memory");
            const unsigned og = xb_add(&bar[XB_TOP], 1u);
            const unsigned tg = og / nx;
            if (og + 1u == (tg + 1u) * nx) xb_add(&bar[XB_TOPGEN], 1u);
            else XB_SPIN(xb_ld(&bar[XB_TOPGEN]) == tg, bar);
            __builtin_amdgcn_fence(__ATOMIC_ACQUIRE, "agent");
            xb_add(&bar[XB_XGEN(b.x)], 1u);
            asm volatile("s_waitcnt vmcnt(0)" ::: "memory");
        } else {
            XB_SPIN(xb_ld(&bar[XB_XGEN(b.x)]) == gen, bar);
            __builtin_amdgcn_fence(__ATOMIC_ACQUIRE, "agent");
            asm volatile("s_waitcnt vmcnt(0)" ::: "memory");
        }
    }
    __syncthreads();
}

__global__ void __launch_bounds__(512, 2) mega(Params P) {
    extern __shared__ __attribute__((aligned(16))) unsigned char lds_raw[];
    LAS unsigned char* lds = (LAS unsigned char*)lds_raw;
    cg::grid_group grid = cg::this_grid();
    if (threadIdx.x < 4) ((volatile LAS unsigned*)(lds + LDS_MAIN))[threadIdx.x] = 0u;
    __syncthreads();
    XcdBarrier xb = xcd_barrier_post((unsigned*)(P.ws + WS_BAR), (volatile LAS unsigned*)(lds + LDS_MAIN));
    const int wid = __builtin_amdgcn_readfirstlane(threadIdx.x >> 6);
    const int G = gridDim.x, nw = G * 8;
    const int gw = blockIdx.x * 8 + wid;
    const int gws = wid * G + blockIdx.x;
    unsigned char* ws = P.ws; unsigned char* proj = ws + WS_PROJ;
    bf16_t* U = (bf16_t*)(ws + WS_U); bf16_t* YC = (bf16_t*)(ws + WS_U);
    bf16_t* ST = (bf16_t*)P.out; bf16_t* Z = (bf16_t*)P.out;
    bf16_t* FFH = (bf16_t*)(proj + P_FFH); bf16_t* MIXF = (bf16_t*)(proj + P_MIX);
    const bf16_t* Win = (const bf16_t*)(ws + WS_W + W_IN); const bf16_t* Wcat = (const bf16_t*)(ws + WS_W + W_CAT);
    const bf16_t* Wmix = (const bf16_t*)(ws + WS_W + W_MIX); const bf16_t* Wff1 = (const bf16_t*)(ws + WS_W + W_FF1); const bf16_t* Wff2 = (const bf16_t*)(ws + WS_W + W_FF2);

    float* RS = (float*)(ws + WS_HMETA);
    const bf16_t* H16 = (const bf16_t*)(ws + WS_ST);
    if (P.ws == nullptr) grid.sync();

    for (int l = -1; l < 4; ++l) {
      if (l < 0) {
        make_tables(P);
        rowinit(P, RS, gw, nw);
      } else {
        for (int rep = 0; rep < REP_G1; ++rep) {
            zero_pads(P);
            EpiIn e; e.proj = proj; e.tabR = (const float*)(ws + WS_TABR); e.tabA = (const float*)(ws + WS_TABA); e.rd = P.ret_decay + l * 16; e.rs = RS;
            const int rem = 1472 % G; const bool fold = rem && (G - rem) >= 23;
            SchedPlain S; S.T.init(DIN, fold ? 1 : 0); S.A = (const char*)H16; S.B = (const char*)Win; S.tstep = (size_t)256 * 1024 * 2; S.nt = 16;
            MainEpiIn me; me.e = e;
            gemm_main(lds, 1024, S, me);
            if (!fold) gemm_tail<4, 4>(lds, H16, Win, 1024, 1024, DIN, e);
        }
        xcd_barrier(xb);
        Mix M; M.q_r = (const bf16_t*)(proj + P_QR); M.k_r = (const bf16_t*)(proj + P_KR); M.kdF = (const bf16_t*)(proj + P_KDF); M.kdB = (const bf16_t*)(proj + P_KDB);
        M.v_rT = (const bf16_t*)(proj + P_VRT); M.g_r = (const bf16_t*)(proj + P_GR); M.q_a = (const bf16_t*)(proj + P_QA); M.k_a = (const bf16_t*)(proj + P_KA);
        M.v_aT = (const bf16_t*)(proj + P_VAT); M.states = ST; M.ycat = YC; M.rd = P.ret_decay + l * 16; M.sink = P.attn_sink + l * 8; M.last = (l == 3);
        for (int rep = 0; rep < REP_MX; ++rep) {
            for (int it = blockIdx.x; it < 256; it += G) scan_block(M, lds, it);
            attn_phase(M, lds, blockIdx.x, G, (256 - (int)blockIdx.x + G - 1) / G);
        }
        xcd_barrier(xb);
        for (int rep = 0; rep < REP_MX; ++rep) {
            ret_phase(M, lds);
        }
        xcd_barrier(xb);
        for (int rep = 0; rep < REP_G23; ++rep) {
            SchedGate S; S.T.init(1024); S.A = (const char*)YC; S.B = (const char*)Wcat; S.tstep = (size_t)256 * 1536 * 2;
            MainEpiGate me; me.gr = (const bf16_t*)(proj + P_GATER); me.ga = (const bf16_t*)(proj + P_GATEA); me.z = Z;
            gemm_main(lds, 1536, S, me);
            if (l < 3) gemm_tail_gate(lds, YC, Wcat, me.gr, me.ga, Z);
        }
        xcd_barrier(xb);
        for (int rep = 0; rep < REP_G23; ++rep) {
            SchedPlain S; S.T.init(1024); S.A = (const char*)Z; S.B = (const char*)Wmix; S.tstep = (size_t)256 * 1024 * 2; S.nt = 16;
            MainEpiBf16 me; me.out = MIXF; EpiF32 te; te.out = MIXF;
            gemm_main(lds, 1024, S, me);
            if (l < 3) gemm_tail<4, 4>(lds, Z, Wmix, 1024, 1024, 1024, te);
        }
        xcd_barrier(xb);
        rowpass(P, MIXF, P.n_mix_post + l * 1024, P.n_ff_pre + l * 1024, RS, gw, nw);
        xcd_barrier(xb);
        for (int rep = 0; rep < REP_FF; ++rep) {
            SchedPlain S; S.T.init(DFF); S.A = (const char*)H16; S.B = (const char*)Wff1; S.tstep = (size_t)256 * 1024 * 2; S.nt = 16;
            MainEpiRelu2 me; me.out = FFH; me.rs = RS; EpiRelu2 te; te.out = FFH; te.rs = RS;
            gemm_main(lds, 1024, S, me);
            if (l < 3) gemm_tail<8, 4>(lds, H16, Wff1, 1024, 1024, DFF, te);
        }
        xcd_barrier(xb);
        for (int rep = 0; rep < REP_FF; ++rep) {
            SchedPlain S; S.T.init(1024); S.A = (const char*)FFH; S.B = (const char*)Wff2; S.tstep = (size_t)256 * 4096 * 2; S.nt = 64;
            MainEpiBf16 me; me.out = MIXF; EpiF32 te; te.out = MIXF;
            gemm_main(lds, 4096, S, me);
            if (l < 3) gemm_tail<4, 8>(lds, FFH, Wff2, 4096, 4096, 1024, te);
        }
        xcd_barrier(xb);
        rowpass(P, MIXF, P.n_ff_post + l * 1024, l < 3 ? P.n_mix_pre + (l + 1) * 1024 : nullptr, RS, gw, nw);
      }
        if (l < 3) { convert_weights(P, l + 1, lds); xcd_barrier(xb); }
    }
}

extern "C" void kernel_launch(void* const* d_in, const int* in_sizes, int n_in, void* d_out, int out_size, void* d_ws, size_t ws_size, hipStream_t stream) {
    static int grid_blocks = 0;
    if (!grid_blocks) {
        int dev = 0, cus = 0, per_cu = 0;
        hipGetDevice(&dev);
        hipDeviceGetAttribute(&cus, hipDeviceAttributeMultiprocessorCount, dev);
        hipFuncSetAttribute((const void*)mega, hipFuncAttributeMaxDynamicSharedMemorySize, LDS_BYTES);
        hipOccupancyMaxActiveBlocksPerMultiprocessor(&per_cu, (const void*)mega, 512, LDS_BYTES);
        if (per_cu < 1) per_cu = 1;
        grid_blocks = cus * per_cu;
        if (ws_size < WS_END) fprintf(stderr, "kernel_launch: workspace too small: %zu < %zu\n", ws_size, (size_t)WS_END);
    }
    Params p{};
    p.x = (const float*)d_in[0]; p.meta = (const float*)d_in[1]; p.w_in = (const float*)d_in[2]; p.w_ret_o = (const float*)d_in[3];
    p.w_att_o = (const float*)d_in[4]; p.w_mix_o = (const float*)d_in[5]; p.w_ff1 = (const float*)d_in[6]; p.w_ff2 = (const float*)d_in[7];
    p.n_mix_pre = (const float*)d_in[8]; p.n_mix_post = (const float*)d_in[9]; p.n_ff_pre = (const float*)d_in[10]; p.n_ff_post = (const float*)d_in[11];
    p.ret_decay = (const float*)d_in[12]; p.attn_sink = (const float*)d_in[13];
    p.out = (float*)d_out; p.ws = (unsigned char*)d_ws;
    (void)hipMemsetAsync((unsigned char*)d_ws + WS_BAR, 0, 16384, stream);
    void* args[] = {&p};
    hipError_t e = hipLaunchCooperativeKernel((const void*)mega, dim3(grid_blocks), dim3(512), args, LDS_BYTES, stream);
    if (e != hipSuccess) fprintf(stderr, "cooperative launch failed: %s (grid %d)\n", hipGetErrorString(e), grid_blocks);
}
```
